# Optimizing an MI355X kernel written in HIP

```python
import math
import jax, jax.numpy as jnp
from jax import lax
import numpy as np

D_MODEL = 1024
BATCH = 4
SEQ = 4096
DEPTH = 1

NSA_HEADS = 16
NSA_KV_GROUPS = 2
NSA_HEADS_PER_GROUP = NSA_HEADS // NSA_KV_GROUPS
NSA_HEAD_DIM = 64
CMP_BLOCK = 32
CMP_STRIDE = 16
CMP_HIDDEN = 256
SLC_BLOCK = 64
SLC_TOPN = 16
WINDOW = 512
Q_BLOCK = 128
ROPE_THETA = 500000.0
ROPE_DIM = NSA_HEAD_DIM // 4
FORCED_SCORE = 1.0e4

RET_HEADS = 8
RET_KEY_DIM = 64
RET_VAL_DIM = 128
RET_CHUNK = 128
RET_ROPE_THETA = 10000.0

D_FF = 2816
EPS = 1e-6
GN_EPS = 1e-5
NEG_INF = -1e30

NSA_Q_W = NSA_HEADS * NSA_HEAD_DIM
NSA_KV_W = NSA_KV_GROUPS * NSA_HEAD_DIM
NSA_GATE_W = 3 * NSA_HEADS
RET_QK_W = RET_HEADS * RET_KEY_DIM
RET_V_W = RET_HEADS * RET_VAL_DIM
IN_WIDTHS = (NSA_Q_W, NSA_KV_W, NSA_KV_W, NSA_KV_W, NSA_KV_W, NSA_KV_W, NSA_KV_W,
             NSA_GATE_W, RET_QK_W, RET_QK_W, RET_V_W, RET_V_W, 2 * D_MODEL)
D_IN = sum(IN_WIDTHS)

kernel_name = "hybrid_nsa_retention_macaron"


def _rmsnorm(x, g):
    xf = x.astype(jnp.float32)
    y = xf * lax.rsqrt(jnp.mean(xf * xf, axis=-1, keepdims=True) + EPS)
    return (y * g.astype(jnp.float32)).astype(x.dtype)


def _swiglu(x, w_gate, w_up, w_down):
    return (jax.nn.silu(x @ w_gate) * (x @ w_up)) @ w_down


def _rope(x, pos, rot_dim, theta):
    half = rot_dim // 2
    freqs = theta ** (-(jnp.arange(half, dtype=jnp.float32) * 2.0 / rot_dim))
    ang = pos.astype(jnp.float32)[:, None] * freqs[None, :]
    cos = jnp.cos(ang).astype(x.dtype)
    sin = jnp.sin(ang).astype(x.dtype)
    x1 = x[..., :half]
    x2 = x[..., half:rot_dim]
    return jnp.concatenate([x1 * cos - x2 * sin, x2 * cos + x1 * sin, x[..., rot_dim:]], axis=-1)


def _masked_softmax(s, mask):
    s = jnp.where(mask, s.astype(jnp.float32), NEG_INF)
    m = jnp.max(s, axis=-1, keepdims=True)
    p = jnp.where(mask, jnp.exp(s - m), 0.0)
    return p / jnp.maximum(jnp.sum(p, axis=-1, keepdims=True), 1e-20)


def _nsa(q, k_cmp, v_cmp, k_slc, v_slc, k_win, v_win, gates, pos_emb, ck_w1, ck_w2, cv_w1, cv_w2):
    B, G, Hg, S, dh = q.shape
    scale = dh ** -0.5
    pos = jnp.arange(S)
    q = _rope(q, pos, ROPE_DIM, ROPE_THETA)
    k_slc = _rope(k_slc, pos, ROPE_DIM, ROPE_THETA)
    k_win = _rope(k_win, pos, ROPE_DIM, ROPE_THETA)

    n_cmp = (S - CMP_BLOCK) // CMP_STRIDE + 1
    cmp_start = jnp.arange(n_cmp) * CMP_STRIDE
    cmp_end = cmp_start + CMP_BLOCK - 1
    cmp_idx = cmp_start[:, None] + jnp.arange(CMP_BLOCK)[None, :]

    def compress(tok, w1, w2):
        blk = tok[:, :, cmp_idx] + pos_emb
        blk = blk.reshape(B, G, n_cmp, CMP_BLOCK * dh)
        return jax.nn.gelu(blk @ w1) @ w2

    kc = _rope(compress(k_cmp, ck_w1, ck_w2), cmp_end, ROPE_DIM, ROPE_THETA)
    vc = compress(v_cmp, cv_w1, cv_w2)

    n_slc = S // SLC_BLOCK
    s_start = jnp.arange(n_slc) * SLC_BLOCK
    overlap = jnp.clip(jnp.minimum(cmp_start[:, None] + CMP_BLOCK, s_start[None, :] + SLC_BLOCK)
                       - jnp.maximum(cmp_start[:, None], s_start[None, :]), 0, None)
    cmp_to_slc = overlap.astype(jnp.float32) / CMP_BLOCK
    top_n = min(SLC_TOPN, n_slc)

    k_blocks = k_slc.reshape(B, G, n_slc, SLC_BLOCK, dh)
    v_blocks = v_slc.reshape(B, G, n_slc, SLC_BLOCK, dh)
    k_pad = jnp.pad(k_win, ((0, 0), (0, 0), (WINDOW, 0), (0, 0)))
    v_pad = jnp.pad(v_win, ((0, 0), (0, 0), (WINDOW, 0), (0, 0)))
    b_ix = jnp.arange(B)[:, None, None, None]
    g_ix = jnp.arange(G)[None, :, None, None]
    sb = jnp.arange(n_slc)

    def one_block(c):
        q0 = c * Q_BLOCK
        qc = lax.dynamic_slice_in_dim(q, q0, Q_BLOCK, axis=3)
        gc = lax.dynamic_slice_in_dim(gates, q0, Q_BLOCK, axis=3)
        t = q0 + jnp.arange(Q_BLOCK)

        s_c = jnp.einsum('bghqd,bgnd->bghqn', qc, kc) * scale
        p_c = _masked_softmax(s_c, cmp_end[None, :] <= t[:, None])
        o_c = jnp.einsum('bghqn,bgnd->bghqd', p_c.astype(vc.dtype), vc)

        imp = jnp.einsum('bghqn,ns->bgqs', p_c, cmp_to_slc)
        cur = t // SLC_BLOCK
        forced = (sb[None, :] == 0) | (sb[None, :] == cur[:, None]) | (sb[None, :] == cur[:, None] - 1)
        future = sb[None, :] > cur[:, None]
        imp = jnp.where(forced, FORCED_SCORE, jnp.where(future, -FORCED_SCORE, imp))
        _, sel = lax.top_k(imp, top_n)
        k_sel = k_blocks[b_ix, g_ix, sel]
        v_sel = v_blocks[b_ix, g_ix, sel]
        kpos = sel[..., None] * SLC_BLOCK + jnp.arange(SLC_BLOCK)
        s_s = jnp.einsum('bghqd,bgqnkd->bghqnk', qc, k_sel) * scale
        s_s = s_s.reshape(B, G, Hg, Q_BLOCK, top_n * SLC_BLOCK)
        mask_s = (kpos <= t[:, None, None]).reshape(B, G, 1, Q_BLOCK, top_n * SLC_BLOCK)
        p_s = _masked_softmax(s_s, mask_s).reshape(B, G, Hg, Q_BLOCK, top_n, SLC_BLOCK)
        o_s = jnp.einsum('bghqnk,bgqnkd->bghqd', p_s.astype(v_sel.dtype), v_sel)

        kw = lax.dynamic_slice_in_dim(k_pad, q0, WINDOW + Q_BLOCK, axis=2)
        vw = lax.dynamic_slice_in_dim(v_pad, q0, WINDOW + Q_BLOCK, axis=2)
        wpos = q0 - WINDOW + jnp.arange(WINDOW + Q_BLOCK)
        dist = t[:, None] - wpos[None, :]
        mask_w = (wpos[None, :] >= 0) & (dist >= 0) & (dist < WINDOW)
        s_w = jnp.einsum('bghqd,bgkd->bghqk', qc, kw) * scale
        p_w = _masked_softmax(s_w, mask_w)
        o_w = jnp.einsum('bghqk,bgkd->bghqd', p_w.astype(vw.dtype), vw)

        return gc[..., 0:1] * o_c + gc[..., 1:2] * o_s + gc[..., 2:3] * o_w

    out = lax.map(one_block, jnp.arange(S // Q_BLOCK))
    return out.transpose(1, 0, 4, 2, 3, 5).reshape(B, S, G * Hg * dh)


def _retention(q, k, v, gn_gain):
    B, H, S, dk = q.shape
    dv = v.shape[-1]
    C = RET_CHUNK
    N = S // C
    dt = q.dtype
    pos = jnp.arange(S)
    q = _rope(q, pos, dk, RET_ROPE_THETA) * (dk ** -0.5)
    k = _rope(k, pos, dk, RET_ROPE_THETA)
    log_g = jnp.log(1.0 - 2.0 ** (-5.0 - jnp.arange(H, dtype=jnp.float32)))
    i = jnp.arange(C, dtype=jnp.float32)
    diff = i[:, None] - i[None, :]
    decay = jnp.where(diff >= 0, jnp.exp(jnp.maximum(diff, 0.0) * log_g[:, None, None]), 0.0)
    zeta = jnp.exp((C - 1.0 - i)[None, :] * log_g[:, None])
    xi = jnp.exp((i + 1.0)[None, :] * log_g[:, None])
    g_chunk = jnp.exp(C * log_g)

    qc = q.reshape(B, H, N, C, dk)
    kc = k.reshape(B, H, N, C, dk)
    vc = v.reshape(B, H, N, C, dv)
    inner = jnp.einsum('bhncd,bhnkd->bhnck', qc, kc) * decay[None, :, None].astype(dt)
    o_inner = jnp.einsum('bhnck,bhnke->bhnce', inner, vc)
    kv = jnp.einsum('bhncd,bhnce->nbhde', kc * zeta[None, :, None, :, None].astype(dt), vc)
    kv = kv.astype(jnp.float32)

    def step(R, kv_n):
        return g_chunk[None, :, None, None] * R + kv_n, R

    _, R_prev = lax.scan(step, jnp.zeros((B, H, dk, dv), jnp.float32), kv)
    o_cross = jnp.einsum('bhncd,nbhde->bhnce',
                         (qc * xi[None, :, None, :, None].astype(dt)).astype(jnp.float32), R_prev)
    o = (o_inner.astype(jnp.float32) + o_cross).reshape(B, H, S, dv)
    mu = jnp.mean(o, axis=-1, keepdims=True)
    var = jnp.mean(jnp.square(o - mu), axis=-1, keepdims=True)
    on = (o - mu) * lax.rsqrt(var + GN_EPS) * gn_gain.astype(jnp.float32)[None, :, None, :]
    return on.astype(dt).transpose(0, 2, 1, 3).reshape(B, S, H * dv)


def setup_inputs(seed: int = 0) -> dict:
    key = jax.random.key(seed)
    ks = jax.random.split(key, 24)
    f32 = jnp.float32

    def w(k, shape, fan_in):
        return jax.random.normal(k, shape, f32) * (fan_in ** -0.5)

    def gain(k, shape):
        return 1.0 + 0.02 * jax.random.normal(k, shape, f32)

    L = DEPTH
    return {
        "x": jax.random.normal(ks[0], (BATCH, SEQ, D_MODEL), f32),
        "ffn1_norm": gain(ks[1], (L, D_MODEL)),
        "ffn1_w_gate": w(ks[2], (L, D_MODEL, D_FF), D_MODEL),
        "ffn1_w_up": w(ks[3], (L, D_MODEL, D_FF), D_MODEL),
        "ffn1_w_down": w(ks[4], (L, D_FF, D_MODEL), D_FF),
        "mix_norm": gain(ks[5], (L, D_MODEL)),
        "w_in": w(ks[6], (L, D_MODEL, D_IN), D_MODEL),
        "cmp_pos_emb": 0.1 * jax.random.normal(ks[7], (L, CMP_BLOCK, NSA_HEAD_DIM), f32),
        "cmp_k_w1": w(ks[8], (L, CMP_BLOCK * NSA_HEAD_DIM, CMP_HIDDEN), CMP_BLOCK * NSA_HEAD_DIM),
        "cmp_k_w2": w(ks[9], (L, CMP_HIDDEN, NSA_HEAD_DIM), CMP_HIDDEN),
        "cmp_v_w1": w(ks[10], (L, CMP_BLOCK * NSA_HEAD_DIM, CMP_HIDDEN), CMP_BLOCK * NSA_HEAD_DIM),
        "cmp_v_w2": w(ks[11], (L, CMP_HIDDEN, NSA_HEAD_DIM), CMP_HIDDEN),
        "ret_gn_gain": gain(ks[12], (L, RET_HEADS, RET_VAL_DIM)),
        "w_branch_nsa": w(ks[13], (L, NSA_Q_W, D_MODEL), NSA_Q_W),
        "w_branch_ret": w(ks[14], (L, RET_V_W, D_MODEL), RET_V_W),
        "w_out": w(ks[15], (L, D_MODEL, D_MODEL), D_MODEL),
        "ffn2_norm": gain(ks[16], (L, D_MODEL)),
        "ffn2_w_gate": w(ks[17], (L, D_MODEL, D_FF), D_MODEL),
        "ffn2_w_up": w(ks[18], (L, D_MODEL, D_FF), D_MODEL),
        "ffn2_w_down": w(ks[19], (L, D_FF, D_MODEL), D_FF),
        "final_norm": gain(ks[20], (D_MODEL,)),
    }


def reference(x, ffn1_norm, ffn1_w_gate, ffn1_w_up, ffn1_w_down, mix_norm, w_in,
              cmp_pos_emb, cmp_k_w1, cmp_k_w2, cmp_v_w1, cmp_v_w2, ret_gn_gain,
              w_branch_nsa, w_branch_ret, w_out, ffn2_norm, ffn2_w_gate, ffn2_w_up,
              ffn2_w_down, final_norm):
    B, S, _ = x.shape
    G, Hg, dh = NSA_KV_GROUPS, NSA_HEADS_PER_GROUP, NSA_HEAD_DIM
    split_points = [int(p) for p in np.cumsum(IN_WIDTHS)[:-1]]

    def nsa_heads(t):
        return t.reshape(B, S, G, Hg, dh).transpose(0, 2, 3, 1, 4)

    def nsa_kv(t):
        return t.reshape(B, S, G, dh).transpose(0, 2, 1, 3)

    def ret_heads(t, d):
        return t.reshape(B, S, RET_HEADS, d).transpose(0, 2, 1, 3)

    for layer in range(DEPTH):
        h = _rmsnorm(x, ffn1_norm[layer])
        x = x + 0.5 * _swiglu(h, ffn1_w_gate[layer], ffn1_w_up[layer], ffn1_w_down[layer])

        h = _rmsnorm(x, mix_norm[layer])
        proj = h @ w_in[layer]
        (q_a, kc_a, vc_a, ks_a, vs_a, kw_a, vw_a, g_a,
         q_r, k_r, v_r, g_r, g_merge) = jnp.split(proj, split_points, axis=-1)

        nsa_gates = jax.nn.sigmoid(g_a.reshape(B, S, G, Hg, 3).transpose(0, 2, 3, 1, 4))
        a_out = _nsa(nsa_heads(q_a), nsa_kv(kc_a), nsa_kv(vc_a), nsa_kv(ks_a), nsa_kv(vs_a),
                     nsa_kv(kw_a), nsa_kv(vw_a), nsa_gates, cmp_pos_emb[layer],
                     cmp_k_w1[layer], cmp_k_w2[layer], cmp_v_w1[layer], cmp_v_w2[layer])
        r_out = _retention(ret_heads(q_r, RET_KEY_DIM), ret_heads(k_r, RET_KEY_DIM),
                           ret_heads(v_r, RET_VAL_DIM), ret_gn_gain[layer])
        r_out = jax.nn.silu(g_r) * r_out

        gate_a, gate_r = jnp.split(jax.nn.sigmoid(g_merge), 2, axis=-1)
        mixed = gate_a * (a_out @ w_branch_nsa[layer]) + gate_r * (r_out @ w_branch_ret[layer])
        x = x + mixed @ w_out[layer]

        h = _rmsnorm(x, ffn2_norm[layer])
        x = x + 0.5 * _swiglu(h, ffn2_w_gate[layer], ffn2_w_up[layer], ffn2_w_down[layer])

    return _rmsnorm(x, final_norm)
```

```cpp
#include <hip/hip_runtime.h>
#include <hip/hip_cooperative_groups.h>
#include <cstdio>
#include <cstdint>
namespace cg = cooperative_groups;

#define LAS __attribute__((address_space(3)))
#define DI __device__ __forceinline__
typedef unsigned short bf16_t;
typedef short bf16x8 __attribute__((ext_vector_type(8)));
typedef short s16x4 __attribute__((ext_vector_type(4)));
typedef float f32x4 __attribute__((ext_vector_type(4)));
typedef float f32x16 __attribute__((ext_vector_type(16)));
typedef unsigned u32x4 __attribute__((ext_vector_type(4)));
typedef unsigned u32x2 __attribute__((ext_vector_type(2)));

constexpr int T = 16384, SEQ = 4096, DM = 1024, FF = 2816, DIN = 6960;
constexpr float EPS = 1e-6f, GN_EPS = 1e-5f;
constexpr float C2 = 0.125f * 1.4426950408889634f;

constexpr size_t MiB = 1u << 20, KiB = 1u << 10;
constexpr size_t WS_SS1 = 0, WS_SS2 = 64 * KiB, WS_SS3 = 128 * KiB, WS_CBIAS = 192 * KiB;
constexpr size_t WS_BAR = 208 * KiB;
constexpr size_t WS_COSN = 256 * KiB, WS_SINN = 384 * KiB, WS_COSR = 512 * KiB, WS_SINR = 1024 * KiB;
constexpr size_t WS_KC = 1536 * KiB, WS_VC = 1792 * KiB;
constexpr size_t WS_BPART = 2 * MiB + 128 * KiB;
constexpr size_t WS_W2K = 2 * MiB, WS_W2V = 2 * MiB + 32 * KiB, WS_W1K = 3 * MiB, WS_W1V = 4 * MiB;
constexpr size_t WS_WGU1 = 5 * MiB, WS_WD1 = 16 * MiB, WS_RP = 5 * MiB;
constexpr size_t WS_WIN = 22 * MiB, WS_WGM = 32 * MiB, WS_WN = 36 * MiB, WS_WR = 38 * MiB, WS_WO = 40 * MiB;
constexpr size_t WS_WGU2 = 42 * MiB, WS_WD2 = 53 * MiB;
constexpr size_t WS_XB = 59 * MiB;
constexpr size_t WS_QA = 91 * MiB, WS_KV = 123 * MiB, WS_QKR = 155 * MiB, WS_VR = 187 * MiB, WS_GR = 219 * MiB, WS_END = 251 * MiB;
constexpr size_t WS_ACT = WS_QA, WS_GATEA = WS_QKR, WS_GATER = WS_GR, WS_MIX = WS_KV;

constexpr int LDS_BYTES = 147456;

DI unsigned f2bf(float f) { unsigned u = __builtin_bit_cast(unsigned, f); return (u + 0x7fffu + ((u >> 16) & 1u)) >> 16; }
typedef float f32x2_t __attribute__((ext_vector_type(2))); typedef __bf16 bf16x2_t __attribute__((ext_vector_type(2)));
DI unsigned pk2(float lo, float hi) { f32x2_t v = {lo, hi}; bf16x2_t b = __builtin_convertvector(v, bf16x2_t); return __builtin_bit_cast(unsigned, b); }
DI float bf2f(unsigned short h) { return __builtin_bit_cast(float, (unsigned)h << 16); }
DI float bflo(unsigned w) { return __builtin_bit_cast(float, w << 16); }
DI float bfhi(unsigned w) { return __builtin_bit_cast(float, w & 0xffff0000u); }
DI int crow(int r, int hi) { return (r & 3) + 8 * (r >> 2) + 4 * hi; }
DI float wave_sum(float v) {
#pragma unroll
    for (int o = 1; o < 64; o <<= 1) v += __shfl_xor(v, o);
    return v;
}
DI float xhalf(float v) {
    unsigned w = __builtin_bit_cast(unsigned, v); asm volatile("" : "+v"(w));
    const auto rr = __builtin_amdgcn_permlane32_swap(__builtin_bit_cast(unsigned, v), w, false, false);
    return __builtin_bit_cast(float, (threadIdx.x & 32) ? rr[0] : rr[1]);
}
DI bf16x8 pack8(const f32x16& x, int s) {
    u32x4 p; p.x = pk2(x[8 * s], x[8 * s + 1]); p.y = pk2(x[8 * s + 2], x[8 * s + 3]); p.z = pk2(x[8 * s + 4], x[8 * s + 5]); p.w = pk2(x[8 * s + 6], x[8 * s + 7]);
    return __builtin_bit_cast(bf16x8, p);
}
#define MFMA32(a, b, c) __builtin_amdgcn_mfma_f32_32x32x16_bf16((a), (b), (c), 0, 0, 0)
typedef short v4i16_t __attribute__((ext_vector_type(4)));
DI s16x4 vtr(const LAS char* p) { return __builtin_bit_cast(s16x4, __builtin_amdgcn_ds_read_tr16_b64_v4i16((LAS v4i16_t*)p)); }
DI bf16x8 cat8(s16x4 lo, s16x4 hi) { return (bf16x8){lo[0], lo[1], lo[2], lo[3], hi[0], hi[1], hi[2], hi[3]}; }
DI float sigmoidf_(float x) { return __builtin_amdgcn_rcpf(1.f + __expf(-x)); }
DI float xsum(float v) { return v + xhalf(v); }
DI float xmax(float v) { return fmaxf(v, xhalf(v)); }
DI int ldim(int p) { return p < 8 ? p : (p < 32 ? p + 8 : (p < 40 ? p - 24 : p)); }

namespace pg8 {
constexpr int BM = 256, BK = 64, HALF = 128, HTB = HALF * BK * 2, STAGE_BYTES = 8 * HTB, NXCD = 8, WGM = 8;
__host__ __device__ __forceinline__ int lds_byte(int r, int c) { const int st = (r >> 4) * 2 + (c >> 5), rr = r & 15, cc = c & 31, ob = rr * 64 + cc * 2; return st * 1024 + (ob ^ (((ob >> 9) & 1) << 5)); }
__host__ __device__ __forceinline__ void stage_rc(int b, int& R, int& C) { const int st = b / 1024, sb = b % 1024, swz = sb ^ (((sb >> 9) & 1) << 5); R = (st >> 1) * 16 + swz / 64; C = (st & 1) * 32 + (swz % 64) / 2; }
__host__ __device__ __forceinline__ int perm32(int rho) { const int n = rho >> 4, i = rho & 15; return 8 * (i >> 2) + 4 * n + (i & 3); }
struct Unit { int pm, pn; };
struct Gemm { const bf16_t* A; const bf16_t* Bt; int lda, K; };
struct StaticOrder {
    int nM, nN, nwg, G, c;
    DI void init(int M, int N, int G_, int c_) { nM = M / BM; nN = N / BM; nwg = nM * nN; G = G_; c = c_; }
    DI bool map(long L, Unit& u) const {
        if (L >= nwg) return false;
        int wgid = (int)L; { const int q = nwg / NXCD, r = nwg % NXCD, xcd = wgid % NXCD, off = wgid / NXCD; wgid = (xcd < r ? xcd * (q + 1) : r * (q + 1) + (xcd - r) * q) + off; }
        const int nig = WGM * nN, gid = wgid / nig, fm = gid * WGM, gsz = (nM - fm) < WGM ? (nM - fm) : WGM;
        u.pm = fm + ((wgid % nig) % gsz); u.pn = (wgid % nig) / gsz; return true;
    }
    DI bool next(int i, Unit& u) const { return map((long)i * G + c, u); }
};
struct GateOrder {
    StaticOrder S;
    DI bool next(int i, Unit& u) const { if (!S.map((long)(i >> 1) * S.G + S.c, u)) return false; u.pn += 4 * (i & 1); return true; }
};

template <class Epi, class Sched>
__device__ __forceinline__ void gemm_phase(LAS unsigned char* lds, const Gemm g, const Sched& S, const Epi& E) {
    const int tid = threadIdx.x, wid = __builtin_amdgcn_readfirstlane(tid >> 6), lane = tid & 63, wr = wid >> 2, wc = wid & 3, fr = lane & 15, fq = lane >> 4;
    const int K = g.K, nt = K / BK, lda = g.lda;
    unsigned voffA[2], voffB[2];
#pragma unroll
    for (int i = 0; i < 2; ++i) { int R, C; stage_rc(tid * 16 + i * 8192, R, C); const int Rb = (R & ~31) + perm32(R & 31);
        voffA[i] = (unsigned)(R * lda + C) * 2u; voffB[i] = (unsigned)(Rb * K + C) * 2u; }
    const size_t kstep = (size_t)(BK * 2);
    const size_t hstepA = (size_t)HALF * lda * 2, hstepB = (size_t)HALF * K * 2;
    const size_t tstepA = 2 * hstepA, tstepB = 2 * hstepB;
    const unsigned ldsw = (unsigned)wid * 1024u;
    const int aoff = lds_byte(wr * 64 + fr, fq * 8), boff = lds_byte(wc * 32 + fr, fq * 8);
#define PG8_SA(b, h) (((b) * 2 + (h)) * HTB)
#define PG8_SB(b, h) ((4 + (b) * 2 + (h)) * HTB)
#define PG8_STAGE(bufoff, gbase, voff) do { _Pragma("unroll") for (int _i = 0; _i < 2; ++_i) \
        __builtin_amdgcn_global_load_lds((const unsigned*)((const char*)(gbase) + (voff)[_i]), (LAS unsigned*)(lds + (bufoff) + ldsw + _i * 8192), 16, 0, 0); } while (0)
#define PG8_LDA(dst, b, h) do { _Pragma("unroll") for (int m = 0; m < 4; ++m) _Pragma("unroll") for (int k = 0; k < 2; ++k) dst[m][k] = *(const LAS bf16x8*)(lds + PG8_SA(b, h) + aoff + m * 2048 + k * 1024); } while (0)
#define PG8_LDB(dst, b, h) do { _Pragma("unroll") for (int n = 0; n < 2; ++n) _Pragma("unroll") for (int k = 0; k < 2; ++k) dst[n][k] = *(const LAS bf16x8*)(lds + PG8_SB(b, h) + boff + n * 2048 + k * 1024); } while (0)
#define PG8_MMA(ai, bj, At, Bt) do { __builtin_amdgcn_s_setprio(1); _Pragma("unroll") for (int m = 0; m < 4; ++m) _Pragma("unroll") for (int n = 0; n < 2; ++n) _Pragma("unroll") for (int k = 0; k < 2; ++k) \
        acc[ai][bj][m][n] = __builtin_amdgcn_mfma_f32_16x16x32_bf16(Bt[n][k], At[m][k], acc[ai][bj][m][n], 0, 0, 0); __builtin_amdgcn_s_setprio(0); } while (0)
#define PG8_WAIT_V(n) asm volatile("s_waitcnt vmcnt(" #n ")" ::: "memory")
#define PG8_WAIT_L(n) asm volatile("s_waitcnt lgkmcnt(" #n ")" ::: "memory")
#define PG8_BAR __builtin_amdgcn_s_barrier()
#define PG8_SCHED __builtin_amdgcn_sched_barrier(0)
    Unit cur, nxt; int ui = 0;
    if (!S.next(0, cur)) return;
    f32x4 acc[2][2][4][2];
#pragma unroll
    for (int a = 0; a < 2; ++a)
#pragma unroll
        for (int b = 0; b < 2; ++b)
#pragma unroll
            for (int m = 0; m < 4; ++m)
#pragma unroll
                for (int n = 0; n < 2; ++n) acc[a][b][m][n] = (f32x4){0.f, 0.f, 0.f, 0.f};
    bf16x8 At[4][2], B0[2][2], B1[2][2];
    const char* cA = (const char*)g.A + (size_t)cur.pm * tstepA; const char* cB = (const char*)g.Bt + (size_t)cur.pn * tstepB;
    PG8_STAGE(PG8_SB(0, 0), cB, voffB); PG8_STAGE(PG8_SB(0, 1), cB + hstepB, voffB); PG8_STAGE(PG8_SA(0, 0), cA, voffA); PG8_STAGE(PG8_SA(0, 1), cA + hstepA, voffA);
    if (wr == 1) PG8_BAR;
    PG8_WAIT_V(2); PG8_BAR;
    PG8_STAGE(PG8_SB(1, 0), cB + kstep, voffB); PG8_STAGE(PG8_SA(1, 0), cA + kstep, voffA); PG8_STAGE(PG8_SB(1, 1), cB + hstepB + kstep, voffB);
    PG8_WAIT_V(6); PG8_BAR;
    for (;;) {
        const bool has_next = S.next(ui + 1, nxt);
        const char* nA = has_next ? (const char*)g.A + (size_t)nxt.pm * tstepA : cA; const char* nB = has_next ? (const char*)g.Bt + (size_t)nxt.pn * tstepB : cB;
        for (int t = 0; t < nt; t += 2) {
            const bool last = (t == nt - 2);
            const char* a1 = cA + (size_t)(t + 1) * kstep;
            const char* a2 = last ? nA : cA + (size_t)(t + 2) * kstep; const char* b2 = last ? nB : cB + (size_t)(t + 2) * kstep;
            const char* a3 = a2 + kstep; const char* b3 = b2 + kstep;
            PG8_LDB(B0, 0, 0); PG8_LDB(B1, 0, 1); PG8_SCHED; PG8_LDA(At, 0, 0); PG8_STAGE(PG8_SA(1, 1), a1 + hstepA, voffA);
            PG8_WAIT_V(8); PG8_WAIT_L(0); PG8_BAR; PG8_MMA(0, 0, At, B0); PG8_MMA(0, 1, At, B1); PG8_BAR; PG8_SCHED;
            PG8_LDA(At, 0, 1); PG8_STAGE(PG8_SB(0, 0), b2, voffB); PG8_STAGE(PG8_SB(0, 1), b2 + hstepB, voffB); PG8_STAGE(PG8_SA(0, 0), a2, voffA);
            PG8_WAIT_V(8); PG8_WAIT_L(0); PG8_BAR; PG8_MMA(1, 0, At, B0); PG8_MMA(1, 1, At, B1); PG8_BAR; PG8_SCHED;
            PG8_LDB(B0, 1, 0); PG8_LDB(B1, 1, 1); PG8_SCHED; PG8_LDA(At, 1, 0); PG8_STAGE(PG8_SA(0, 1), a2 + hstepA, voffA);
            PG8_WAIT_V(8); PG8_WAIT_L(0); PG8_BAR; PG8_MMA(0, 0, At, B0); PG8_MMA(0, 1, At, B1); PG8_BAR; PG8_SCHED;
            PG8_LDA(At, 1, 1); PG8_STAGE(PG8_SB(1, 0), b3, voffB); PG8_STAGE(PG8_SB(1, 1), b3 + hstepB, voffB); PG8_STAGE(PG8_SA(1, 0), a3, voffA);
            PG8_WAIT_V(8); PG8_WAIT_L(0); PG8_BAR; PG8_MMA(1, 0, At, B0); PG8_MMA(1, 1, At, B1); PG8_BAR; PG8_SCHED;
        }
        if (wr == 0) PG8_BAR;
        E(acc, cur, wr, wc, fr, fq);
        if (!has_next) break;
#pragma unroll
        for (int a = 0; a < 2; ++a)
#pragma unroll
            for (int b = 0; b < 2; ++b)
#pragma unroll
                for (int m = 0; m < 4; ++m)
#pragma unroll
                    for (int n = 0; n < 2; ++n) acc[a][b][m][n] = (f32x4){0.f, 0.f, 0.f, 0.f};
        cur = nxt; cA = nA; cB = nB; ++ui;
        if (wr == 1) PG8_BAR;
    }
    PG8_WAIT_V(0);
    PG8_BAR;
#undef PG8_SA
#undef PG8_SB
#undef PG8_STAGE
#undef PG8_LDA
#undef PG8_LDB
#undef PG8_MMA
#undef PG8_WAIT_V
#undef PG8_WAIT_L
#undef PG8_BAR
#undef PG8_SCHED
}
typedef f32x4 Acc[2][2][4][2];
DI void st16(bf16_t* p, f32x4 a, f32x4 b) { u32x4 w; w.x = pk2(a[0], a[1]); w.y = pk2(a[2], a[3]); w.z = pk2(b[0], b[1]); w.w = pk2(b[2], b[3]); *(u32x4*)p = w; }

struct EpiSwiGLU {
    bf16_t* ACT; const float* ss;
    DI void operator()(const Acc& acc, const Unit& u, int wr, int wc, int fr, int fq) const {
        float ssv[8];
#pragma unroll
        for (int i = 0; i < 8; ++i) ssv[i] = ss[u.pm * BM + (i >> 2) * HALF + wr * 64 + (i & 3) * 16 + fr];
        __builtin_amdgcn_sched_barrier(0);
#pragma unroll
        for (int ai = 0; ai < 2; ++ai)
#pragma unroll
            for (int m = 0; m < 4; ++m) {
                const int row = u.pm * BM + ai * HALF + wr * 64 + m * 16 + fr;
                const float rs = rsqrtf(ssv[ai * 4 + m] * (1.f / DM) + EPS);
                f32x4 o[2];
#pragma unroll
                for (int n = 0; n < 2; ++n)
#pragma unroll
                    for (int j = 0; j < 4; ++j) { const float gv = acc[ai][0][m][n][j] * rs, uv = acc[ai][1][m][n][j] * rs; o[n][j] = gv * sigmoidf_(gv) * uv; }
                st16(ACT + (size_t)row * FF + u.pn * 128 + wc * 32 + fq * 8, o[0], o[1]);
            }
    }
};
template <bool WB, bool SS> struct EpiResid {
    const float* xin; float* xout; bf16_t* xb; float* ss; float scale;
    DI void operator()(const Acc& acc, const Unit& u, int wr, int wc, int fr, int fq) const {
#pragma unroll
        for (int ai = 0; ai < 2; ++ai) {
            f32x4 xv[4][2][2];
#pragma unroll
            for (int m = 0; m < 4; ++m)
#pragma unroll
                for (int bj = 0; bj < 2; ++bj) { const size_t off = (size_t)(u.pm * BM + ai * HALF + wr * 64 + m * 16 + fr) * DM + u.pn * BM + bj * HALF + wc * 32 + fq * 8;
                    xv[m][bj][0] = *(const f32x4*)(xin + off); xv[m][bj][1] = *(const f32x4*)(xin + off + 4); }
            __builtin_amdgcn_sched_barrier(0);
#pragma unroll
            for (int m = 0; m < 4; ++m) {
                const int row = u.pm * BM + ai * HALF + wr * 64 + m * 16 + fr;
                float sq = 0.f;
#pragma unroll
                for (int bj = 0; bj < 2; ++bj) {
                    const size_t off = (size_t)row * DM + u.pn * BM + bj * HALF + wc * 32 + fq * 8;
                    f32x4 x0 = xv[m][bj][0], x1 = xv[m][bj][1];
                    x0 = x0 + acc[ai][bj][m][0] * scale; x1 = x1 + acc[ai][bj][m][1] * scale;
                    *(f32x4*)(xout + off) = x0; *(f32x4*)(xout + off + 4) = x1;
                    if (WB) st16(xb + off, x0, x1);
                    if (SS) sq += (x0[0] * x0[0] + x0[1] * x0[1]) + (x0[2] * x0[2] + x0[3] * x0[3]) + (x1[0] * x1[0] + x1[1] * x1[1]) + (x1[2] * x1[2] + x1[3] * x1[3]);
                }
                if (SS) { sq += __shfl_xor(sq, 16); sq += __shfl_xor(sq, 32); if (fq == 0) atomicAdd(ss + row, sq); }
            }
        }
    }
};
struct EpiProj {
    bf16_t *QA, *KV, *QKR, *VR, *GR; const float* ss; const float *cosN, *sinN, *cosR, *sinR;
    DI void operator()(const Acc& acc, const Unit& u, int wr, int wc, int fr, int fq) const {
        const int t = u.pn;
        float ssv[8];
#pragma unroll
        for (int i = 0; i < 8; ++i) ssv[i] = ss[u.pm * BM + (i >> 2) * HALF + wr * 64 + (i & 3) * 16 + fr];
        __builtin_amdgcn_sched_barrier(0);
#pragma unroll
        for (int ai = 0; ai < 2; ++ai)
#pragma unroll
          for (int mp = 0; mp < 2; ++mp) {
            f32x4 csv[2][2], snv[2][2];
            if (t <= 4) { if (fq == 0) {
#pragma unroll
                for (int r2 = 0; r2 < 2; ++r2)
#pragma unroll
                    for (int n = 0; n < 2; ++n) { const int pos2 = (u.pm * BM + ai * HALF + wr * 64 + (2 * mp + r2) * 16 + fr) & (SEQ - 1); csv[r2][n] = *(const f32x4*)(cosN + pos2 * 8 + 4 * n); snv[r2][n] = *(const f32x4*)(sinN + pos2 * 8 + 4 * n); } }
            } else if (t >= 7 && t < 11) {
#pragma unroll
                for (int r2 = 0; r2 < 2; ++r2)
#pragma unroll
                    for (int n = 0; n < 2; ++n) { const int pos2 = (u.pm * BM + ai * HALF + wr * 64 + (2 * mp + r2) * 16 + fr) & (SEQ - 1); csv[r2][n] = *(const f32x4*)(cosR + pos2 * 32 + 8 * fq + 4 * n); snv[r2][n] = *(const f32x4*)(sinR + pos2 * 32 + 8 * fq + 4 * n); }
            }
            __builtin_amdgcn_sched_barrier(0);
#pragma unroll
            for (int r2 = 0; r2 < 2; ++r2) {
                const int m = 2 * mp + r2;
                const int row = u.pm * BM + ai * HALF + wr * 64 + m * 16 + fr;
                const float rs = rsqrtf(ssv[ai * 4 + m] * (1.f / DM) + EPS);
                const int pos = row & (SEQ - 1);
                f32x4 v[2][2];
#pragma unroll
                for (int bj = 0; bj < 2; ++bj)
#pragma unroll
                    for (int n = 0; n < 2; ++n) v[bj][n] = acc[ai][bj][m][n] * rs;
                bf16_t* dst; int c0, c1;
                if (t <= 4) {
                    if (fq == 0) {
#pragma unroll
                        for (int n = 0; n < 2; ++n) { const f32x4 cs = csv[r2][n], sn = snv[r2][n];
                            const f32x4 lo = v[0][n], hi = v[1][n]; v[0][n] = lo * cs - hi * sn; v[1][n] = hi * cs + lo * sn; }
                    }
                    if (t < 4) {
#pragma unroll
                        for (int bj = 0; bj < 2; ++bj)
#pragma unroll
                            for (int n = 0; n < 2; ++n) v[bj][n] = v[bj][n] * C2;
                        dst = QA; c0 = 256 * t + 64 * wc + 8 * fq; c1 = c0 + 32;
                    } else { dst = KV; c0 = 64 * wc + 8 * fq; c1 = c0 + 32; }
                } else if (t >= 7 && t < 11) {
                    const bool isq = t < 9; const int head = 4 * ((t - 7) & 1) + wc; const int c = pos & 127;
                    const float lg = __log2f(1.f - exp2f(-5.f - (float)head));
                    const float f = isq ? 0.125f * exp2f((float)c * lg) : exp2f(-(float)c * lg);
#pragma unroll
                    for (int n = 0; n < 2; ++n) { const f32x4 cs = csv[r2][n], sn = snv[r2][n];
                        const f32x4 lo = v[0][n], hi = v[1][n]; v[0][n] = (lo * cs - hi * sn) * f; v[1][n] = (hi * cs + lo * sn) * f; }
                    dst = QKR; c0 = (isq ? 0 : 512) + 256 * ((t - 7) & 1) + 64 * wc + 8 * fq; c1 = c0 + 32;
                } else {
                    const int cc = 32 * wc + 8 * fq;
                    if (t == 5 || t == 6) { dst = KV; c0 = 256 * (t - 4) + cc; }
                    else if (t < 15) { dst = VR; c0 = 256 * (t - 11) + cc; }
                    else if (t < 19) { dst = GR; c0 = 256 * (t - 15) + cc;
#pragma unroll
                        for (int bj = 0; bj < 2; ++bj)
#pragma unroll
                            for (int n = 0; n < 2; ++n)
#pragma unroll
                                for (int j = 0; j < 4; ++j) { const float x = v[bj][n][j]; v[bj][n][j] = x * sigmoidf_(x); }
                    } else { dst = KV; c0 = 768 + cc;
#pragma unroll
                        for (int bj = 0; bj < 2; ++bj)
#pragma unroll
                            for (int n = 0; n < 2; ++n)
#pragma unroll
                                for (int j = 0; j < 4; ++j) v[bj][n][j] = sigmoidf_(v[bj][n][j]);
                    }
                    c1 = c0 + 128;
                }
                st16(dst + (size_t)row * DM + c0, v[0][0], v[0][1]);
                st16(dst + (size_t)row * DM + c1, v[1][0], v[1][1]);
            }
          }
    }
};
struct EpiGate {
    bf16_t *GA_, *GR_; const float* ss;
    DI void operator()(const Acc& acc, const Unit& u, int wr, int wc, int fr, int fq) const {
        bf16_t* dst = u.pn < 4 ? GA_ : GR_; const int ct = (u.pn & 3) * BM;
        float ssv[8];
#pragma unroll
        for (int i = 0; i < 8; ++i) ssv[i] = ss[u.pm * BM + (i >> 2) * HALF + wr * 64 + (i & 3) * 16 + fr];
        __builtin_amdgcn_sched_barrier(0);
#pragma unroll
        for (int ai = 0; ai < 2; ++ai)
#pragma unroll
            for (int m = 0; m < 4; ++m) {
                const int row = u.pm * BM + ai * HALF + wr * 64 + m * 16 + fr;
                const float rs = rsqrtf(ssv[ai * 4 + m] * (1.f / DM) + EPS);
#pragma unroll
                for (int bj = 0; bj < 2; ++bj) { f32x4 o[2];
#pragma unroll
                    for (int n = 0; n < 2; ++n)
#pragma unroll
                        for (int j = 0; j < 4; ++j) o[n][j] = sigmoidf_(acc[ai][bj][m][n][j] * rs);
                    st16(dst + (size_t)row * DM + ct + bj * HALF + wc * 32 + fq * 8, o[0], o[1]); }
            }
    }
};
template <bool ADD> struct EpiMix {
    const bf16_t* G_; bf16_t* MIX;
    DI void operator()(const Acc& acc, const Unit& u, int wr, int wc, int fr, int fq) const {
#pragma unroll
        for (int ai = 0; ai < 2; ++ai) {
            u32x4 gv[4][2], pv[4][2];
#pragma unroll
            for (int m = 0; m < 4; ++m)
#pragma unroll
                for (int bj = 0; bj < 2; ++bj) { const size_t off = (size_t)(u.pm * BM + ai * HALF + wr * 64 + m * 16 + fr) * DM + u.pn * BM + bj * HALF + wc * 32 + fq * 8;
                    gv[m][bj] = *(const u32x4*)(G_ + off); pv[m][bj] = (u32x4){0u, 0u, 0u, 0u}; if (ADD) pv[m][bj] = *(const u32x4*)(MIX + off); }
            __builtin_amdgcn_sched_barrier(0);
#pragma unroll
            for (int m = 0; m < 4; ++m) {
                const int row = u.pm * BM + ai * HALF + wr * 64 + m * 16 + fr;
#pragma unroll
                for (int bj = 0; bj < 2; ++bj) {
                    const size_t off = (size_t)row * DM + u.pn * BM + bj * HALF + wc * 32 + fq * 8;
                    const u32x4 gw = gv[m][bj];
                    const u32x4 pw = pv[m][bj];
                    f32x4 o0, o1;
                    o0[0] = bflo(gw.x) * acc[ai][bj][m][0][0]; o0[1] = bfhi(gw.x) * acc[ai][bj][m][0][1]; o0[2] = bflo(gw.y) * acc[ai][bj][m][0][2]; o0[3] = bfhi(gw.y) * acc[ai][bj][m][0][3];
                    o1[0] = bflo(gw.z) * acc[ai][bj][m][1][0]; o1[1] = bfhi(gw.z) * acc[ai][bj][m][1][1]; o1[2] = bflo(gw.w) * acc[ai][bj][m][1][2]; o1[3] = bfhi(gw.w) * acc[ai][bj][m][1][3];
                    if (ADD) { o0[0] += bflo(pw.x); o0[1] += bfhi(pw.x); o0[2] += bflo(pw.y); o0[3] += bfhi(pw.y); o1[0] += bflo(pw.z); o1[1] += bfhi(pw.z); o1[2] += bflo(pw.w); o1[3] += bfhi(pw.w); }
                    st16(MIX + off, o0, o1);
                }
            }
        }
    }
};
}

struct Args { const float* in[21]; float* out; unsigned char* ws; int ph_lo, ph_hi; };

DI void tr_item(const float* W, int ldw, int K, bf16_t* WT, int drow0, int scol4, const float* ksc, int k0, LAS float* scr, int lane) {
    const int kq = lane >> 4, n4 = 4 * (lane & 15);
    f32x4 v[16];
#pragma unroll
    for (int i = 0; i < 16; ++i) v[i] = scol4 >= 0 ? *(const f32x4*)(W + (size_t)(k0 + 4 * i + kq) * ldw + scol4) : (f32x4){0.f, 0.f, 0.f, 0.f};
#pragma unroll
    for (int i = 0; i < 16; ++i) { LAS float* d = scr + (4 * i + kq) * 65 + n4; d[0] = v[i].x; d[1] = v[i].y; d[2] = v[i].z; d[3] = v[i].w; }
    asm volatile("s_waitcnt lgkmcnt(0)" ::: "memory");
    const int c = lane & 7, nl = lane >> 3;
    f32x4 s0 = (f32x4){1.f, 1.f, 1.f, 1.f}, s1 = s0;
    if (ksc) { s0 = *(const f32x4*)(ksc + k0 + 8 * c); s1 = *(const f32x4*)(ksc + k0 + 8 * c + 4); }
#pragma unroll
    for (int j = 0; j < 8; ++j) { const int n = nl + 8 * j; const LAS float* p = scr + (8 * c) * 65 + n;
        u32x4 o; o.x = pk2(p[0 * 65] * s0.x, p[1 * 65] * s0.y); o.y = pk2(p[2 * 65] * s0.z, p[3 * 65] * s0.w); o.z = pk2(p[4 * 65] * s1.x, p[5 * 65] * s1.y); o.w = pk2(p[6 * 65] * s1.z, p[7 * 65] * s1.w);
        *(u32x4*)(WT + (size_t)(drow0 + n) * K + k0 + 8 * c) = o; }
    asm volatile("s_waitcnt lgkmcnt(0)" ::: "memory");
}
DI int win_src(int nrow) {
    const int t = nrow >> 8, rr = nrow & 255, bj = rr >> 7, wc = (rr >> 5) & 3, c = rr & 31;
    if (t < 4) return (4 * t + wc) * 64 + ldim(32 * bj + c);
    if (t == 4) return (wc < 2 ? 1280 + wc * 64 : 1536 + (wc - 2) * 64) + ldim(32 * bj + c);
    if (t == 5) return rr < 128 ? 1024 + rr : 1152 + rr - 128;
    if (t == 6) return rr < 128 ? 1408 + rr : 1664 + rr - 128;
    if (t < 9) return 1840 + (4 * (t - 7) + wc) * 64 + 32 * bj + c;
    if (t < 11) return 2352 + (4 * (t - 9) + wc) * 64 + 32 * bj + c;
    if (t < 15) return 2864 + (t - 11) * 256 + rr;
    if (t < 19) return 3888 + (t - 15) * 256 + rr;
    return rr < 48 ? 1792 + rr : -1;
}
template <int SET>
DI void prep_transposes(const Args& a, LAS unsigned char* lds, int gw, int NGW, int wave, int lane) {
    unsigned char* ws = a.ws;
    LAS float* scr = (LAS float*)(lds + wave * 18432);
    constexpr int I0 = (5632 / 64) * 16, I1 = (1024 / 64) * (2816 / 64), I2 = (5120 / 64) * 16, I3 = (2048 / 64) * 16, I4 = 16 * 16, I9 = 4 * 32, I11 = 4;
    constexpr int NIT = SET == 0 ? I0 + I1 + I2 + I3 + 2 * I9 + 2 * I11 : I0 + I1 + 3 * I4;
    constexpr int L = SET;
    const int l4 = 4 * (lane & 15);
    for (int it = gw; it < NIT; it += NGW) {
        int r = it;
        if (r < I0) { const int nb = r / 16, kb = r % 16, nrow = nb * 64 + l4; const int tile = nrow >> 8, rr = nrow & 255;
            tr_item(a.in[(rr >> 7) ? (L ? 18 : 3) : (L ? 17 : 2)], FF, DM, (bf16_t*)(ws + (L ? WS_WGU2 : WS_WGU1)), nb * 64, 128 * tile + (rr & 127), a.in[L ? 16 : 1], kb * 64, scr, lane); continue; } r -= I0;
        if (r < I1) { const int nb = r / 44, kb = r % 44;
            tr_item(a.in[L ? 19 : 4], DM, FF, (bf16_t*)(ws + (L ? WS_WD2 : WS_WD1)), nb * 64, nb * 64 + l4, nullptr, kb * 64, scr, lane); continue; } r -= I1;
        if (SET == 1) { const int w = r / I4; r -= w * I4; const int nb = r / 16, kb = r % 16;
            tr_item(a.in[13 + w], DM, DM, (bf16_t*)(ws + (w == 0 ? WS_WN : (w == 1 ? WS_WR : WS_WO))), nb * 64, nb * 64 + l4, nullptr, kb * 64, scr, lane); continue; }
        if (r < I2) { const int nb = r / 16, kb = r % 16; tr_item(a.in[6], DIN, DM, (bf16_t*)(ws + WS_WIN), nb * 64, win_src(nb * 64 + l4), a.in[5], kb * 64, scr, lane); continue; } r -= I2;
        if (r < I3) { const int nb = r / 16, kb = r % 16; tr_item(a.in[6], DIN, DM, (bf16_t*)(ws + WS_WGM), nb * 64, 4912 + nb * 64 + l4, a.in[5], kb * 64, scr, lane); continue; } r -= I3;
        if (r < 2 * I9) { const int w = r / I9; r -= w * I9; const int nb = r / 32, kb = r % 32;
            tr_item(a.in[w ? 10 : 8], 256, 2048, (bf16_t*)(ws + (w ? WS_W1V : WS_W1K)), nb * 64, nb * 64 + l4, nullptr, kb * 64, scr, lane); continue; } r -= 2 * I9;
        { const int w = r / I11; r -= w * I11; const int kb = r;
            tr_item(a.in[w ? 11 : 9], 64, 256, (bf16_t*)(ws + (w ? WS_W2V : WS_W2K)), 0, w ? l4 : ldim(l4), nullptr, kb * 64, scr, lane); }
    }
}
DI void phase_prep(const Args& a, LAS unsigned char* lds, int gw, int NGW, int wave, int lane) {
    unsigned char* ws = a.ws;
    prep_transposes<0>(a, lds, gw, NGW, wave, lane);
    const float* x = a.in[0]; bf16_t* xb = (bf16_t*)(ws + WS_XB); float* ss1 = (float*)(ws + WS_SS1);
    for (int m0 = gw; m0 < T; m0 += 2 * NGW) {
        const int m1 = m0 + NGW;
        const bool two = m1 < T;
        const f32x4* xr0 = (const f32x4*)(x + (size_t)m0 * DM) + lane; const f32x4* xr1 = (const f32x4*)(x + (size_t)(two ? m1 : m0) * DM) + lane;
        f32x4 v0[4], v1[4]; float s0 = 0.f, s1 = 0.f;
#pragma unroll
        for (int j = 0; j < 4; ++j) { v0[j] = xr0[64 * j]; v1[j] = xr1[64 * j]; }
#pragma unroll
        for (int j = 0; j < 4; ++j) { s0 += (v0[j].x * v0[j].x + v0[j].y * v0[j].y) + (v0[j].z * v0[j].z + v0[j].w * v0[j].w); s1 += (v1[j].x * v1[j].x + v1[j].y * v1[j].y) + (v1[j].z * v1[j].z + v1[j].w * v1[j].w); }
        s0 = wave_sum(s0); s1 = wave_sum(s1);
        u32x2* o0 = (u32x2*)(xb + (size_t)m0 * DM) + lane; u32x2* o1 = (u32x2*)(xb + (size_t)m1 * DM) + lane;
#pragma unroll
        for (int j = 0; j < 4; ++j) { o0[64 * j] = (u32x2){pk2(v0[j].x, v0[j].y), pk2(v0[j].z, v0[j].w)}; if (two) o1[64 * j] = (u32x2){pk2(v1[j].x, v1[j].y), pk2(v1[j].z, v1[j].w)}; }
        if (lane == 0) { ss1[m0] = s0; ((float*)(ws + WS_SS2))[m0] = 0.f; ((float*)(ws + WS_SS3))[m0] = 0.f;
            if (two) { ss1[m1] = s1; ((float*)(ws + WS_SS2))[m1] = 0.f; ((float*)(ws + WS_SS3))[m1] = 0.f; } }
    }
    const int gt = gw * 64 + lane, NGT = NGW * 64;
    for (int e = gt; e < SEQ * 8; e += NGT) { const int pos = e >> 3, i = e & 7; const float fr = powf(500000.0f, -(float)i * 2.0f / 16.0f); const float ang = (float)pos * fr;
        ((float*)(ws + WS_COSN))[e] = cosf(ang); ((float*)(ws + WS_SINN))[e] = sinf(ang); }
    for (int e = gt; e < SEQ * 32; e += NGT) { const int pos = e >> 5, i = e & 31; const float fr = powf(10000.0f, -(float)i * 2.0f / 64.0f); const float ang = (float)pos * fr;
        ((float*)(ws + WS_COSR))[e] = cosf(ang); ((float*)(ws + WS_SINR))[e] = sinf(ang); }
    for (int o = gw; o < 256; o += NGW) { const int w = o >> 7, jg = (o >> 5) & 3, kc = o & 31; const float* W1 = a.in[w ? 10 : 8]; const float* pe = a.in[7]; float s = 0.f;
#pragma unroll 16
        for (int k = 0; k < 64; ++k) s += pe[kc * 64 + k] * W1[(size_t)(kc * 64 + k) * 256 + jg * 64 + lane];
        ((float*)(ws + WS_BPART))[(w * 32 + kc) * 256 + jg * 64 + lane] = s; }
    for (int e = gt; e < 2 * 8 * 64; e += NGT) { const int w = e >> 9, bg = (e >> 6) & 7, d = e & 63; ((bf16_t*)(ws + (w ? WS_VC : WS_KC)))[(bg * 256 + 255) * 64 + d] = 0; }
}

DI float gelu_tanh(float x) { const float u = 0.7978845608028654f * (x + 0.044715f * x * x * x); const float e = __expf(2.f * u); const float th = 1.f - 2.f * __builtin_amdgcn_rcpf(e + 1.f); return 0.5f * x * (1.f + th); }
DI void compress_item(const Args& a, LAS unsigned char* lds, int item, int tid, int wave, int lane) {
    unsigned char* ws = a.ws; const int r32 = lane & 31, hi = lane >> 5;
    const int mt = item & 63, kv = item >> 6;
    const bf16_t* KV = (const bf16_t*)(ws + WS_KV);
    const bf16_t* W1T = (const bf16_t*)(ws + (kv ? WS_W1V : WS_W1K)); const bf16_t* W2T = (const bf16_t*)(ws + (kv ? WS_W2V : WS_W2K));
    int m = mt * 32 + r32; if (m > 2039) m = 2039;
    const int bg = m / 255, nc = m % 255, b = bg >> 1, g = bg & 1;
    __syncthreads();
#pragma unroll
    for (int i = 0; i < 16; ++i) {
        const int e = i * 512 + tid, seg = e >> 3, ch = e & 7, mrow = seg >> 5, l = seg & 31;
        int m3 = mt * 32 + mrow; if (m3 > 2039) m3 = 2039;
        const int bg3 = m3 / 255, nc3 = m3 % 255;
        const u32x4 v = *(const u32x4*)(KV + (size_t)((bg3 >> 1) * SEQ + nc3 * 16 + l) * DM + 256 + kv * 128 + (bg3 & 1) * 64 + 8 * ch);
        *(LAS u32x4*)(lds + mrow * 4112 + l * 128 + ch * 16) = v;
    }
    const bf16_t* wsrc = W1T + (size_t)(32 * wave + r32) * 2048 + 8 * hi;
    const LAS unsigned char* bsrc = lds + r32 * 4112 + 16 * hi;
    __syncthreads();
    f32x16 h = {};
#pragma unroll 1
    for (int s0 = 0; s0 < 128; s0 += 16) {
        bf16x8 af[16], bfr[16];
#pragma unroll
        for (int j = 0; j < 16; ++j) af[j] = *(const bf16x8*)(wsrc + 16 * (s0 + j));
#pragma unroll
        for (int j = 0; j < 16; ++j) bfr[j] = *(const LAS bf16x8*)(bsrc + 32 * (s0 + j));
        __builtin_amdgcn_sched_barrier(0);
#pragma unroll
        for (int j = 0; j < 16; ++j) h = MFMA32(af[j], bfr[j], h);
    }
    LAS float* red = (LAS float*)lds;
    LAS float* biasL = (LAS float*)(lds + 65536);
    __syncthreads();
    if (tid < 256) { const float* bp = (const float*)(ws + WS_BPART) + kv * 32 * 256 + tid; float b = 0.f;
#pragma unroll
        for (int c = 0; c < 32; ++c) b += bp[c * 256];
        biasL[tid] = b; }
    __syncthreads();
#pragma unroll
    for (int i = 0; i < 16; ++i) h[i] = gelu_tanh(h[i] + biasL[32 * wave + crow(i, hi)]);
#pragma unroll
    for (int dt = 0; dt < 2; ++dt) {
        f32x16 o = {};
#pragma unroll
        for (int ks = 0; ks < 2; ++ks) {
            const bf16_t* wp = W2T + (size_t)(32 * dt + r32) * 256 + 32 * wave + 16 * ks + 4 * hi;
            const s16x4 lo = *(const s16x4*)wp, hh = *(const s16x4*)(wp + 8);
            o = MFMA32(cat8(lo, hh), pack8(h, ks), o);
        }
#pragma unroll
        for (int i = 0; i < 16; ++i) red[(wave * 64 + 32 * dt + crow(i, hi)) * 32 + r32] = o[i];
    }
    __syncthreads();
    {
        const int mm = tid & 31, dq = tid >> 5; const int d0 = 4 * dq;
        float s[4] = {0.f, 0.f, 0.f, 0.f}, ps[4] = {0.f, 0.f, 0.f, 0.f};
        const bool rot = (kv == 0) && (dq < 2 || dq == 8 || dq == 9);
#pragma unroll
        for (int w = 0; w < 8; ++w)
#pragma unroll
            for (int j = 0; j < 4; ++j) { s[j] += red[(w * 64 + d0 + j) * 32 + mm]; ps[j] += red[(w * 64 + ((d0 + j) ^ 32)) * 32 + mm]; }
        const int m2 = mt * 32 + mm;
        if (m2 < 2040) {
            const int bg2 = m2 / 255, nc2 = m2 % 255;
            if (rot) { const int pos = 16 * nc2 + 31; const float* cs = (const float*)(ws + WS_COSN) + pos * 8; const float* sn = (const float*)(ws + WS_SINN) + pos * 8;
#pragma unroll
                for (int j = 0; j < 4; ++j) { const int i = (d0 + j) & 7; s[j] = (d0 < 8) ? s[j] * cs[i] - ps[j] * sn[i] : s[j] * cs[i] + ps[j] * sn[i]; } }
            bf16_t* dst = (bf16_t*)(ws + (kv ? WS_VC : WS_KC)) + (size_t)(bg2 * 256 + nc2) * 64 + d0;
            *(u32x2*)dst = (u32x2){pk2(s[0], s[1]), pk2(s[2], s[3])};
        }
    }
    __syncthreads();
}

DI void retstate_item(const Args& a, LAS unsigned char* lds, int item, int tid, int wave, int lane) {
    unsigned char* ws = a.ws; const int r32 = lane & 31, hi = lane >> 5;
    const int bh = item >> 2, dvs = item & 3, b = bh >> 3, h = bh & 7;
    const bf16_t* Kp = (const bf16_t*)(ws + WS_QKR) + (size_t)b * SEQ * DM + 512 + 64 * h;
    const bf16_t* Vp = (const bf16_t*)(ws + WS_VR) + (size_t)b * SEQ * DM + 128 * h + 32 * dvs;
    bf16_t* Rp = (bf16_t*)(ws + WS_RP) + (size_t)bh * 32 * 8192;
    const float lg = __log2f(1.f - exp2f(-5.f - (float)h));
    const float g127 = exp2f(127.f * lg), g128 = exp2f(128.f * lg);
    struct RS { u32x4 k0, k1, v; };
    auto gload = [&](RS& r, int n) __attribute__((always_inline)) {
        { const int e = tid, row = e >> 3, ch = e & 7; r.k0 = *(const u32x4*)(Kp + (size_t)(n * 128 + row) * DM + 8 * ch); }
        { const int e = tid + 512, row = e >> 3, ch = e & 7; r.k1 = *(const u32x4*)(Kp + (size_t)(n * 128 + row) * DM + 8 * ch); }
        { const int row = tid >> 2, ch = tid & 3; r.v = *(const u32x4*)(Vp + (size_t)(n * 128 + row) * DM + 8 * ch); }
    };
    auto lwrite = [&](const RS& r, int buf) __attribute__((always_inline)) {
        LAS unsigned char* kb = lds + buf * 24576; LAS unsigned char* vb = kb + 16384;
        { const int e = tid, row = e >> 3, ch = e & 7; *(LAS u32x4*)(kb + ((ch >> 2) * 8 + (row >> 4)) * 1024 + (row & 15) * 64 + (ch & 3) * 16) = r.k0; }
        { const int e = tid + 512, row = e >> 3, ch = e & 7; *(LAS u32x4*)(kb + ((ch >> 2) * 8 + (row >> 4)) * 1024 + (row & 15) * 64 + (ch & 3) * 16) = r.k1; }
        { const int row = tid >> 2, ch = tid & 3; *(LAS u32x4*)(vb + (row >> 4) * 1024 + (row & 15) * 64 + ch * 16) = r.v; }
    };
    f32x16 R = {};
    const int troff = ((lane >> 4) & 1) * 32 + (lane & 3) * 8 + (4 * hi + ((lane & 15) >> 2)) * 64;
    auto body = [&](RS& r, const int n) __attribute__((always_inline)) {
        const int buf = n & 1;
        lwrite(r, buf);
        if (n + 4 < 32) gload(r, n + 4);
        __syncthreads();
        if (wave < 2) {
            bf16_t* rp = Rp + (size_t)n * 8192 + (size_t)(32 * dvs + r32) * 64 + 32 * wave + 4 * hi;
#pragma unroll
            for (int q = 0; q < 4; ++q) *(u32x2*)(rp + 8 * q) = (u32x2){pk2(R[4 * q], R[4 * q + 1]), pk2(R[4 * q + 2], R[4 * q + 3])};
            const LAS char* kb = (const LAS char*)(lds + buf * 24576) + troff; const LAS char* vb = (const LAS char*)(lds + buf * 24576 + 16384) + troff;
            f32x16 kvn = {};
#pragma unroll
            for (int ks = 0; ks < 8; ++ks) {
                const bf16x8 af = cat8(vtr(kb + (wave * 8 + ks) * 1024), vtr(kb + (wave * 8 + ks) * 1024 + 512));
                const bf16x8 bfv = cat8(vtr(vb + ks * 1024), vtr(vb + ks * 1024 + 512));
                kvn = MFMA32(af, bfv, kvn);
            }
#pragma unroll
            for (int i = 0; i < 16; ++i) R[i] = g128 * R[i] + g127 * kvn[i];
        }
    };
    RS r0, r1, r2, r3;
    __syncthreads();
    gload(r0, 0); gload(r1, 1); gload(r2, 2); gload(r3, 3);
#pragma unroll 1
    for (int n = 0; n < 32; n += 4) { body(r0, n); body(r1, n + 1); body(r2, n + 2); body(r3, n + 3); }
    __syncthreads();
}

constexpr int AT_K = 0, AT_V = 16384, AT_IMP = 32768, AT_SLAB = 64 * 33, AT_SEL = 32768 + 8 * AT_SLAB * 4;
struct TileRegs { u32x4 k, v; };
DI void at_gload(TileRegs& r, const bf16_t* Kb, const bf16_t* Vb, int pitch, int kt, int wave, int lane) {
    r.k = *(const u32x4*)(Kb + (size_t)(kt * 64 + lane) * pitch + wave * 8);
    r.v = *(const u32x4*)(Vb + (size_t)(kt * 64 + 16 * (wave & 3) + (lane >> 2)) * pitch + (wave >> 2) * 32 + (lane & 3) * 8);
}
DI void at_lwrite(const TileRegs& r, LAS unsigned char* lds, int buf, int wave, int lane) {
    *(LAS u32x4*)(lds + AT_K + buf * 8192 + wave * 1024 + lane * 16) = r.k;
    *(LAS u32x4*)(lds + AT_V + buf * 8192 + wave * 1024 + lane * 16) = r.v;
}
DI void at_qk(f32x16& p0, f32x16& p1, const LAS unsigned char* kslot, const bf16x8* qr, const f32x16& cinit, int r32, int hi) {
    const LAS unsigned char* kb = kslot + hi * 1024 + r32 * 16;
#pragma unroll
    for (int d0 = 0; d0 < 4; ++d0) {
        const bf16x8 b0 = *(const LAS bf16x8*)(kb + d0 * 2048), b1 = *(const LAS bf16x8*)(kb + d0 * 2048 + 512);
        if (d0 == 0) { p0 = MFMA32(b0, qr[0], cinit); p1 = MFMA32(b1, qr[0], cinit); }
        else { p0 = MFMA32(b0, qr[d0], p0); p1 = MFMA32(b1, qr[d0], p1); }
    }
}
DI void at_pv(f32x16* o, const LAS unsigned char* vslot, const f32x16& p0, const f32x16& p1, int lane, int hi) {
    const LAS char* vp = (const LAS char*)vslot + ((lane >> 4) & 1) * 32 + (lane & 3) * 8 + (4 * hi + ((lane & 15) >> 2)) * 64;
    const bf16x8 pa[4] = {pack8(p0, 0), pack8(p0, 1), pack8(p1, 0), pack8(p1, 1)};
#pragma unroll
    for (int dt = 0; dt < 2; ++dt)
#pragma unroll
        for (int ks = 0; ks < 4; ++ks) {
            const bf16x8 vf = cat8(vtr(vp + dt * 4096 + ks * 1024), vtr(vp + dt * 4096 + ks * 1024 + 512));
            o[dt] = MFMA32(vf, pa[ks], o[dt]);
        }
}
DI void at_pv2(f32x16* o, const s16x4* vl, const s16x4* vh, const f32x16& p0, const f32x16& p1) {
    const bf16x8 pa[4] = {pack8(p0, 0), pack8(p0, 1), pack8(p1, 0), pack8(p1, 1)};
    __builtin_amdgcn_sched_barrier(0);
#pragma unroll
    for (int ks = 0; ks < 4; ++ks) { o[0] = MFMA32(cat8(vl[ks], vh[ks]), pa[ks], o[0]); o[1] = MFMA32(cat8(vl[4 + ks], vh[4 + ks]), pa[ks], o[1]); }
}
DI float max32(const f32x16& p0, const f32x16& p1) {
    float a = fmaxf(fmaxf(p0[0], p0[1]), p1[0]), b = fmaxf(fmaxf(p0[2], p0[3]), p1[1]); a = fmaxf(fmaxf(a, p1[2]), p1[3]);
#pragma unroll
    for (int i = 4; i < 16; i += 4) { a = fmaxf(fmaxf(a, p0[i]), p0[i + 1]); b = fmaxf(fmaxf(b, p0[i + 2]), p0[i + 3]); a = fmaxf(fmaxf(a, p1[i]), p1[i + 1]); b = fmaxf(fmaxf(b, p1[i + 2]), p1[i + 3]); }
    const float mx = fmaxf(a, b);
    return xmax(mx);
}
DI float sum32(const f32x16& p0, const f32x16& p1) {
    const f32x16 sv = p0 + p1;
    const float a = (sv[0] + sv[1]) + (sv[2] + sv[3]), b = (sv[4] + sv[5]) + (sv[6] + sv[7]), c = (sv[8] + sv[9]) + (sv[10] + sv[11]), d = (sv[12] + sv[13]) + (sv[14] + sv[15]);
    const float t = (a + b) + (c + d);
    return xsum(t);
}
#ifndef PEXP
#define PEXP 7
#endif
template <int MODE, int EXP = 0>
DI void at_loop(LAS unsigned char* lds, const bf16_t* Kb, const bf16_t* Vb, int pitch, int first, int last, const bf16x8* qr, f32x16* o, float& mrun, float& lrun,
                int t0, unsigned long long selm, int tid, int wave, int lane, TileRegs& trA) {
    const int r32 = lane & 31, hi = lane >> 5; const int t = t0 + r32;
    const float NINF = -__builtin_inff(); constexpr float THR = 8.f;
    __syncthreads();
    float cref = -mrun; if (MODE == 1) cref = lrun > 0.f ? -(mrun + __log2f(lrun)) : 0.f;
    float carry = 0.f;
    f32x16 osum = (f32x16){};
    const bf16x8 ones = (bf16x8){16256, 16256, 16256, 16256, 16256, 16256, 16256, 16256};
    auto step = [&](const int kt, TileRegs& tr, const int buf) __attribute__((always_inline)) {
        if (EXP != 3) at_lwrite(tr, lds, buf, wave, lane);
        if (kt + 1 <= last) at_gload(tr, Kb, Vb, pitch, kt + 1, wave, lane);
        if (EXP != 3) __syncthreads();
        f32x16 p0, p1;
        {
            float c = cref; if (MODE == 2) { const bool sel = (selm >> kt) & 1ull; c = sel ? cref : NINF; }
            f32x16 ci;
#pragma unroll
            for (int i = 0; i < 16; ++i) ci[i] = c;
            const LAS unsigned char* kb = lds + AT_K + buf * 8192 + hi * 1024 + r32 * 16;
            bf16x8 kf[8];
#pragma unroll
            for (int d0 = 0; d0 < 4; ++d0) { kf[2 * d0] = *(const LAS bf16x8*)(kb + d0 * 2048); kf[2 * d0 + 1] = *(const LAS bf16x8*)(kb + d0 * 2048 + 512); }
            __builtin_amdgcn_sched_barrier(0);
            if (EXP == 4) { p0 = ci; p1 = ci; p0[0] += __builtin_bit_cast(float, (int)kf[0][0] + (int)kf[7][3]); } else {
            p0 = MFMA32(kf[0], qr[0], ci); p1 = MFMA32(kf[1], qr[0], ci);
#pragma unroll
            for (int d0 = 1; d0 < 4; ++d0) { p0 = MFMA32(kf[2 * d0], qr[d0], p0); p1 = MFMA32(kf[2 * d0 + 1], qr[d0], p1); } }
            __builtin_amdgcn_sched_barrier(0);
        }
        s16x4 vl[8], vh[8];
        if (MODE != 0 && EXP != 2) {
            const LAS char* vp = (const LAS char*)(lds + AT_V + buf * 8192) + ((lane >> 4) & 1) * 32 + (lane & 3) * 8 + (4 * hi + ((lane & 15) >> 2)) * 64;
#pragma unroll
            for (int i = 0; i < 8; ++i) { vl[i] = vtr(vp + (i >> 2) * 4096 + (i & 3) * 1024); vh[i] = vtr(vp + (i >> 2) * 4096 + (i & 3) * 1024 + 512); }
            __builtin_amdgcn_sched_barrier(0);
        }
        if (MODE <= 1) {
            if (16 * (64 * kt + 63) + 31 > t0) {
#pragma unroll
                for (int i = 0; i < 16; ++i) { const int n0 = 64 * kt + crow(i, hi); if (16 * n0 + 31 > t) p0[i] = NINF; if (16 * (n0 + 32) + 31 > t) p1[i] = NINF; }
            }
        } else if (MODE == 2) {
            if (kt == last) {
#pragma unroll
                for (int i = 0; i < 16; ++i) { const int k0 = 64 * kt + crow(i, hi); if (k0 > t) p0[i] = NINF; if (k0 + 32 > t) p1[i] = NINF; }
            }
        } else {
            if (kt == last || 64 * kt + 512 <= t0 + 31) {
#pragma unroll
                for (int i = 0; i < 16; ++i) { const int k0 = 64 * kt + crow(i, hi); if (k0 > t || t - k0 >= 512) p0[i] = NINF; if (k0 + 32 > t || t - k0 - 32 >= 512) p1[i] = NINF; }
            }
        }
        if (MODE == 1) {
#pragma unroll
            for (int i = 0; i < 16; ++i) { p0[i] = __builtin_amdgcn_exp2f(p0[i]); p1[i] = __builtin_amdgcn_exp2f(p1[i]); }
            LAS float* slab = (LAS float*)(lds + AT_IMP) + wave * AT_SLAB + r32;
            float av[2][4], rb[2][4];
#pragma unroll
            for (int hf = 0; hf < 2; ++hf)
#pragma unroll
                for (int gq = 0; gq < 4; ++gq) {
                    const f32x16& x = hf ? p1 : p0;
                    const float bb = 0.5f * x[4 * gq + 3]; av[hf][gq] = x[4 * gq] + x[4 * gq + 1] + x[4 * gq + 2] + bb; rb[hf][gq] = xhalf(bb);
                }
#pragma unroll
            for (int hf = 0; hf < 2; ++hf)
#pragma unroll
                for (int gq = 0; gq < 4; ++gq) {
                    const float prevrb = gq > 0 ? rb[hf][gq - 1] : (hf == 1 ? rb[0][3] : carry);
                    const int s = 16 * kt + 8 * hf + 2 * gq + hi;
                    slab[s * 33] = av[hf][gq] + (hi ? rb[hf][gq] : prevrb);
                }
            carry = rb[1][3];
            at_pv2(o, vl, vh, p0, p1);
        } else {
            const float tm = max32(p0, p1);
            const float lcur = (MODE >= 2) ? osum[0] : lrun;
            const bool mv = (tm > THR) || (lcur == 0.f && tm > NINF);
            if (__any(mv)) {
                const float d = mv ? tm : 0.f;
                const float alpha = (lcur == 0.f) ? 1.f : __builtin_amdgcn_exp2f(-d);
                mrun += d; lrun *= alpha;
                if (MODE >= 2) {
#pragma unroll
                    for (int i = 0; i < 16; ++i) osum[i] *= alpha;
                }
#pragma unroll
                for (int i = 0; i < 16; ++i) { p0[i] -= d; p1[i] -= d; }
                cref = -mrun;
                if (MODE != 0) {
#pragma unroll
                    for (int i = 0; i < 16; ++i) { o[0][i] *= alpha; o[1][i] *= alpha; }
                }
            }
            if (MODE == 0) {
#pragma unroll
                for (int i = 0; i < 16; ++i) { p0[i] = __builtin_amdgcn_exp2f(p0[i]); p1[i] = __builtin_amdgcn_exp2f(p1[i]); }
                lrun += sum32(p0, p1);
            } else {
#pragma unroll
                for (int ks = 0; ks < 4; ++ks) {
                    f32x16& x = (ks < 2) ? p0 : p1; const int r0 = 8 * (ks & 1);
#pragma unroll
                    for (int i = 0; i < 8; ++i) x[r0 + i] = __builtin_amdgcn_exp2f(x[r0 + i]);
                    const bf16x8 pa = pack8(x, ks & 1);
                    o[0] = MFMA32(cat8(vl[ks], vh[ks]), pa, o[0]); o[1] = MFMA32(cat8(vl[4 + ks], vh[4 + ks]), pa, o[1]);
                    osum = MFMA32(ones, pa, osum);
                }
            }
        }
    };
    for (int kt = first; kt <= last; kt += 2) {
        step(kt, trA, 0);
        if (kt + 1 <= last) step(kt + 1, trA, 1);
    }
    if (MODE >= 2) lrun = osum[0];
}
template <bool ADD> DI void nsa_accum(bf16_t* aout, const f32x16* o, float f) {
    u32x2 wv[8];
    if (ADD) {
#pragma unroll
        for (int i = 0; i < 8; ++i) wv[i] = *(const u32x2*)(aout + 32 * (i >> 2) + 8 * (i & 3));
        __builtin_amdgcn_sched_barrier(0);
    }
#pragma unroll
    for (int dt = 0; dt < 2; ++dt)
#pragma unroll
        for (int q = 0; q < 4; ++q) {
            u32x2* p = (u32x2*)(aout + 32 * dt + 8 * q);
            float v0 = f * o[dt][4 * q], v1 = f * o[dt][4 * q + 1], v2 = f * o[dt][4 * q + 2], v3 = f * o[dt][4 * q + 3];
            if (ADD) { const u32x2 w = wv[dt * 4 + q]; v0 += bflo(w.x); v1 += bfhi(w.x); v2 += bflo(w.y); v3 += bfhi(w.y); }
            *p = (u32x2){pk2(v0, v1), pk2(v2, v3)};
        }
}
template <int EXP = 0> DI void nsa_item(const Args& a, LAS unsigned char* lds, int item, int tid, int wave, int lane, bool dry = false) {
    unsigned char* ws = a.ws; const int r32 = lane & 31, hi = lane >> 5;
    const int bg = item >> 7, qt = item & 127, b = bg >> 1, g = bg & 1; const int t0 = qt * 32, cur = t0 >> 6;
    bf16_t* QA = (bf16_t*)(ws + WS_QA); const bf16_t* KV = (const bf16_t*)(ws + WS_KV);
    const size_t tokrow = (size_t)(b * SEQ + t0 + r32) * DM; const int head = g * 8 + wave;
    bf16x8 qr[4];
#pragma unroll
    for (int d0 = 0; d0 < 4; ++d0) qr[d0] = *(const bf16x8*)(QA + tokrow + head * 64 + 16 * d0 + 8 * hi);
    float gate[3];
#pragma unroll
    for (int j = 0; j < 3; ++j) gate[j] = bf2f(KV[tokrow + 768 + head * 3 + j]);
    { LAS float* z = (LAS float*)(lds + AT_IMP) + wave * AT_SLAB;
#pragma unroll
      for (int i = 0; i < 33; ++i) z[lane + 64 * i] = 0.f; }
    f32x16 o[2];
    bf16_t* aout = QA + tokrow + head * 64 + 4 * hi;
    const bf16_t* KC = (const bf16_t*)(ws + WS_KC) + (size_t)bg * 256 * 64; const bf16_t* VC = (const bf16_t*)(ws + WS_VC) + (size_t)bg * 256 * 64;
    const int lastc = (t0 >> 4) >> 6;
    float mrun = 0.f, lrun = 0.f;
    TileRegs tr0;
    at_gload(tr0, KC, VC, 64, 0, wave, lane);
    if (EXP != 7) at_loop<0>(lds, KC, VC, 64, 0, lastc, qr, o, mrun, lrun, t0, 0ull, tid, wave, lane, tr0);
    o[0] = (f32x16){}; o[1] = (f32x16){};
    at_gload(tr0, KC, VC, 64, 0, wave, lane);
    if (EXP != 7 && EXP != 8) at_loop<1>(lds, KC, VC, 64, 0, lastc, qr, o, mrun, lrun, t0, 0ull, tid, wave, lane, tr0);
    const bf16_t* Ks = KV + (size_t)b * SEQ * DM + 64 * g; const bf16_t* Vs = KV + (size_t)b * SEQ * DM + 512 + 64 * g;
    at_gload(tr0, Ks, Vs, DM, 0, wave, lane);
    if (!(dry && a.ph_lo != 12345)) nsa_accum<false>(aout, o, gate[0]);
    __syncthreads();
    if (EXP >= 6) { if (lane == 0) { for (int qi = 0; qi < 4; ++qi) *(LAS unsigned long long*)(lds + AT_SEL + (4 * wave + qi) * 8) = ~0ull; } }
    else {
        const LAS float* imp = (const LAS float*)(lds + AT_IMP);
#pragma unroll 1
        for (int qi = 0; qi < 4; ++qi) {
            const int q = 4 * wave + qi; float v = 0.f;
#pragma unroll
            for (int w = 0; w < 8; ++w) v += imp[w * AT_SLAB + lane * 33 + q];
            const int s = lane;
            if (s == 0 || s == cur || s == cur - 1) v = 1.0e4f; else if (s > cur) v = -1.0e4f;
            typedef unsigned long long u64x2_t __attribute__((ext_vector_type(2)));
            const unsigned vb = __builtin_bit_cast(unsigned, v); const unsigned key = (vb >> 31) ? ~vb : (vb | 0x80000000u);
            const unsigned long long K = ((unsigned long long)key << 32) | (unsigned)(63 - lane);
            LAS unsigned long long* tk = (LAS unsigned long long*)(lds + AT_SEL + 256) + wave * 64;
            tk[lane] = K;
            u64x2_t rr[32];
#pragma unroll
            for (int j = 0; j < 32; ++j) rr[j] = *(const LAS u64x2_t*)(tk + 2 * j);
            int rank = 0;
#pragma unroll
            for (int j = 0; j < 32; ++j) { rank += (rr[j].x > K) ? 1 : 0; rank += (rr[j].y > K) ? 1 : 0; }
            const unsigned long long mk = __ballot(rank < 16 && s <= cur);
            if (lane == 0) *(LAS unsigned long long*)(lds + AT_SEL + q * 8) = mk;
        }
    }
    __syncthreads();
    const unsigned long long selm = *(const LAS unsigned long long*)(lds + AT_SEL + r32 * 8);
    const bf16_t* Kw = KV + (size_t)b * SEQ * DM + 128 + 64 * g; const bf16_t* Vw = KV + (size_t)b * SEQ * DM + 640 + 64 * g;
    const int firstw = t0 >= 511 ? (t0 - 511) >> 6 : 0;
    {
        mrun = 0.f; lrun = 0.f; o[0] = (f32x16){}; o[1] = (f32x16){};
        if (EXP < 5) at_loop<2, EXP>(lds, Ks, Vs, DM, 0, cur, qr, o, mrun, lrun, t0, selm, tid, wave, lane, tr0);
        const float f = gate[1] * (lrun > 0.f ? 1.f / lrun : 0.f);
        at_gload(tr0, Kw, Vw, DM, firstw, wave, lane);
        if (!(dry && a.ph_lo != 12345)) nsa_accum<true>(aout, o, f);
    }
    {
        mrun = 0.f; lrun = 0.f; o[0] = (f32x16){}; o[1] = (f32x16){};
        if (EXP < 5) at_loop<3, EXP>(lds, Kw, Vw, DM, firstw, cur, qr, o, mrun, lrun, t0, 0ull, tid, wave, lane, tr0);
        const float f = gate[2] * (lrun > 0.f ? 1.f / lrun : 0.f);
        if (!(dry && a.ph_lo != 12345)) nsa_accum<true>(aout, o, f);
    }
}

DI void retout_item(const Args& a, LAS unsigned char* lds, int item, int tid, int wave, int lane, bool dry = false) {
    unsigned char* ws = a.ws; const int r32 = lane & 31, hi = lane >> 5;
    const int half = wave >> 2, ww = wave & 3, tl = tid & 255;
    const int chunk = item * 2 + half;
    const int bh = chunk >> 5, n = chunk & 31, b = bh >> 3, h = bh & 7;
    const size_t row0 = (size_t)b * SEQ + n * 128;
    const bf16_t* QKR = (const bf16_t*)(ws + WS_QKR); bf16_t* VR = (bf16_t*)(ws + WS_VR); const bf16_t* GR = (const bf16_t*)(ws + WS_GR);
    const bf16_t* Rp = (const bf16_t*)(ws + WS_RP) + (size_t)chunk * 8192;
    LAS unsigned char* vimg = lds + half * 32768;
    __syncthreads();
    { u32x4 vv[8];
#pragma unroll
      for (int it = 0; it < 8; ++it) { const int e = it * 256 + tl, key = e >> 4, ch = e & 15; vv[it] = *(const u32x4*)(VR + (row0 + key) * DM + 128 * h + 8 * ch); }
      __builtin_amdgcn_sched_barrier(0);
#pragma unroll
      for (int it = 0; it < 8; ++it) { const int e = it * 256 + tl, key = e >> 4, ch = e & 15;
        *(LAS u32x4*)(vimg + ((ch >> 2) * 8 + (key >> 4)) * 1024 + (key & 15) * 64 + (ch & 3) * 16) = vv[it]; } }
    const float lg = __log2f(1.f - exp2f(-5.f - (float)h)); const float gam = exp2f(lg);
    bf16x8 qr[4];
    const bf16_t* qp = QKR + (row0 + 32 * ww + r32) * DM + 64 * h + 8 * hi;
#pragma unroll
    for (int d0 = 0; d0 < 4; ++d0) qr[d0] = *(const bf16x8*)(qp + 16 * d0);
    f32x16 o[4];
#pragma unroll
    for (int dh = 0; dh < 2; ++dh) { bf16x8 rf[8];
#pragma unroll
      for (int i = 0; i < 8; ++i) rf[i] = *(const bf16x8*)(Rp + (size_t)(32 * (2 * dh + (i >> 2)) + r32) * 64 + 8 * hi + 16 * (i & 3));
      __builtin_amdgcn_sched_barrier(0);
#pragma unroll
      for (int d2 = 0; d2 < 2; ++d2) { const int dt = 2 * dh + d2; o[dt] = (f32x16){};
#pragma unroll
        for (int d0 = 0; d0 < 4; ++d0) o[dt] = MFMA32(rf[d2 * 4 + d0], qr[d0], o[dt]);
#pragma unroll
        for (int i = 0; i < 16; ++i) o[dt][i] *= gam; } }
    __syncthreads();
    const LAS char* vp = (const LAS char*)vimg + ((lane >> 4) & 1) * 32 + (lane & 3) * 8 + (4 * hi + ((lane & 15) >> 2)) * 64;
    for (int jt = 0; jt <= ww; ++jt) {
        f32x16 p = {};
        const bf16_t* kp = QKR + (row0 + 32 * jt + r32) * DM + 512 + 64 * h + 8 * hi;
        bf16x8 kfr[4];
#pragma unroll
        for (int d0 = 0; d0 < 4; ++d0) kfr[d0] = *(const bf16x8*)(kp + 16 * d0);
        __builtin_amdgcn_sched_barrier(0);
#pragma unroll
        for (int d0 = 0; d0 < 4; ++d0) p = MFMA32(kfr[d0], qr[d0], p);
        if (jt == ww) {
#pragma unroll
            for (int i = 0; i < 16; ++i) if (crow(i, hi) > r32) p[i] = 0.f;
        }
        const bf16x8 pa0 = pack8(p, 0), pa1 = pack8(p, 1);
#pragma unroll
        for (int dt = 0; dt < 4; ++dt) {
            const LAS char* v0 = vp + (dt * 8 + 2 * jt) * 1024;
            o[dt] = MFMA32(cat8(vtr(v0), vtr(v0 + 512)), pa0, o[dt]);
            o[dt] = MFMA32(cat8(vtr(v0 + 1024), vtr(v0 + 1536)), pa1, o[dt]);
        }
    }
    float s = 0.f;
#pragma unroll
    for (int dt = 0; dt < 4; ++dt)
#pragma unroll
        for (int i = 0; i < 16; ++i) s += o[dt][i];
    s = xsum(s); const float mu = s * (1.f / 128.f); float q2 = 0.f;
#pragma unroll
    for (int dt = 0; dt < 4; ++dt)
#pragma unroll
        for (int i = 0; i < 16; ++i) { const float d = o[dt][i] - mu; q2 += d * d; }
    q2 = xsum(q2); const float rstd = rsqrtf(q2 * (1.f / 128.f) + GN_EPS);
    const float* gn = a.in[12] + 128 * h;
    const size_t orow = (row0 + 32 * ww + r32) * DM + 128 * h;
    __syncthreads();
    if (dry && a.ph_lo != 12345) return;
#pragma unroll
    for (int dh = 0; dh < 2; ++dh) {
        f32x4 ggv[8]; u32x2 gwv[8];
#pragma unroll
        for (int i = 0; i < 8; ++i) { const int dv = 32 * (2 * dh + (i >> 2)) + 8 * (i & 3) + 4 * hi; ggv[i] = *(const f32x4*)(gn + dv); gwv[i] = *(const u32x2*)(GR + orow + dv); }
        __builtin_amdgcn_sched_barrier(0);
#pragma unroll
        for (int d2 = 0; d2 < 2; ++d2)
#pragma unroll
            for (int q = 0; q < 4; ++q) {
                const int dt = 2 * dh + d2; const int dv = 32 * dt + 8 * q + 4 * hi;
                const f32x4 gg = ggv[d2 * 4 + q]; const u32x2 gw = gwv[d2 * 4 + q];
                const float r0 = (o[dt][4 * q] - mu) * rstd * gg[0] * bflo(gw.x), r1 = (o[dt][4 * q + 1] - mu) * rstd * gg[1] * bfhi(gw.x);
                const float r2 = (o[dt][4 * q + 2] - mu) * rstd * gg[2] * bflo(gw.y), r3 = (o[dt][4 * q + 3] - mu) * rstd * gg[3] * bfhi(gw.y);
                *(u32x2*)(VR + orow + dv) = (u32x2){pk2(r0, r1), pk2(r2, r3)};
            }
    }
}

#define XB_TMO      128
#define XB_XCNT(j)  (256  + 64 * (j))
#define XB_XSUB(j)  (1280 + 64 * (j))
#define XB_XGEN(j)  (2304 + 64 * (j))
#define XB_TOP      3328
#define XB_TOPGEN   3392
#define XCD_BAR_WORDS 3456
#define XB_SPIN_CAP (1u << 22)
DI unsigned xb_ld(unsigned* p)              { return __hip_atomic_load(p, __ATOMIC_RELAXED, __HIP_MEMORY_SCOPE_AGENT); }
DI unsigned xb_add(unsigned* p, unsigned v) { return __hip_atomic_fetch_add(p, v, __ATOMIC_RELAXED, __HIP_MEMORY_SCOPE_AGENT); }
DI unsigned xb_xcc_id() { return (unsigned)__builtin_amdgcn_s_getreg((3 << 11) | 20) & 0xFu; }
#define XB_SPIN(cond, bar) do { unsigned _sp = 0; while (cond) { __builtin_amdgcn_s_sleep(1); \
    if ((++_sp & 255u) == 0u) { if (xb_ld(&(bar)[XB_TMO])) break; if (_sp > XB_SPIN_CAP) { atomicAdd(&(bar)[XB_TMO], 1u); break; } } } } while (0)
struct XcdBarrier { unsigned* bar; unsigned x; volatile LAS unsigned* st; };
DI XcdBarrier xcd_barrier_post(unsigned* bar, volatile LAS unsigned* st) {
    XcdBarrier b; b.bar = bar; b.x = xb_xcc_id(); b.st = st;
    if (threadIdx.x == 0) (void)xb_add(&bar[XB_XCNT(b.x)], 1u);
    return b;
}
DI void xcd_barrier_complete(unsigned* bar, unsigned x, unsigned& nloc, unsigned& nx) {
    const unsigned G = gridDim.x * gridDim.y * gridDim.z;
    unsigned sum, cnt, mine, sp = 0u;
    for (;;) {
        sum = 0u; cnt = 0u; mine = 0u;
#pragma unroll
        for (unsigned j = 0; j < 16; ++j) { const unsigned c = xb_ld(&bar[XB_XCNT(j)]); sum += c; cnt += (c > 0u) ? 1u : 0u; mine = (j == x) ? c : mine; }
        if (sum == G) break;
        __builtin_amdgcn_s_sleep(1);
        if ((++sp & 255u) == 0u) { if (xb_ld(&bar[XB_TMO])) break; if (sp > XB_SPIN_CAP) { atomicAdd(&bar[XB_TMO], 1u); break; } }
    }
    nloc = mine > 0u ? mine : 1u; nx = cnt > 0u ? cnt : 1u;
}
DI void xcd_barrier(const XcdBarrier& b) {
    asm volatile("s_waitcnt vmcnt(0)" ::: "memory");
    __syncthreads();
    if (threadIdx.x == 0) {
        unsigned* bar = b.bar;
        __builtin_amdgcn_s_waitcnt(0);
        unsigned nloc = b.st[0], nx = b.st[1];
        if (nloc == 0u) { xcd_barrier_complete(bar, b.x, nloc, nx); b.st[0] = nloc; b.st[1] = nx; }
        const unsigned old = xb_add(&bar[XB_XSUB(b.x)], 1u);
        const unsigned gen = old / nloc;
        if (old + 1u == (gen + 1u) * nloc) {
            __builtin_amdgcn_fence(__ATOMIC_RELEASE, "agent");
            asm volatile("s_waitcnt vmcnt(0)" ::: "memory");
            const unsigned og = xb_add(&bar[XB_TOP], 1u);
            const unsigned tg = og / nx;
            if (og + 1u == (tg + 1u) * nx) xb_add(&bar[XB_TOPGEN], 1u);
            else XB_SPIN(xb_ld(&bar[XB_TOPGEN]) == tg, bar);
            __builtin_amdgcn_fence(__ATOMIC_ACQUIRE, "agent");
            xb_add(&bar[XB_XGEN(b.x)], 1u);
            asm volatile("s_waitcnt vmcnt(0)" ::: "memory");
        } else {
            XB_SPIN(xb_ld(&bar[XB_XGEN(b.x)]) == gen, bar);
            __builtin_amdgcn_fence(__ATOMIC_ACQUIRE, "agent");
            asm volatile("s_waitcnt vmcnt(0)" ::: "memory");
        }
    }
    __syncthreads();
}

__global__ void __launch_bounds__(512, 2) fwd_mega(Args args) {
    extern __shared__ __attribute__((aligned(16))) unsigned char lds_raw[];
    LAS unsigned char* lds = (LAS unsigned char*)lds_raw;
    cg::grid_group grid = cg::this_grid();
    const int tid = threadIdx.x, lane = tid & 63, wave = __builtin_amdgcn_readfirstlane(tid >> 6);
    const int G = gridDim.x, bx = blockIdx.x;
    const int gw = bx * 8 + wave, NGW = G * 8;
    unsigned char* ws = args.ws;
    const int lo = args.ph_lo, hi_ = args.ph_hi;
#define IN(k) (lo <= (k) && (k) < hi_)
    volatile LAS unsigned* bst = (volatile LAS unsigned*)(lds + LDS_BYTES - 64);
    if (tid < 16) bst[tid] = 0u;
    __syncthreads();
    XcdBarrier xbar = xcd_barrier_post((unsigned*)(ws + WS_BAR), bst);
    if (args.ph_lo == 12345) grid.sync();
#define SEAM(k) do { if (IN(k) && IN((k) + 1)) xcd_barrier(xbar); } while (0)
    float* ss1 = (float*)(ws + WS_SS1); float* ss2 = (float*)(ws + WS_SS2); float* ss3 = (float*)(ws + WS_SS3);
    bf16_t* XB = (bf16_t*)(ws + WS_XB); bf16_t* ACT = (bf16_t*)(ws + WS_ACT);

#ifndef PROBE
#define PROBE 0
#endif
    if (IN(0)) phase_prep(args, lds, gw, NGW, wave, lane);
    if (PROBE == 5) { xcd_barrier(xbar); phase_prep(args, lds, gw, NGW, wave, lane); }
    if (PROBE == 4) { for (int i = 0; i < 10; ++i) xcd_barrier(xbar); }
    SEAM(0);

    if (IN(1)) {
#pragma unroll 1
        for (int rep = 0; rep < (PROBE == 1 ? 2 : 1); ++rep) {
        pg8::Gemm g{XB, (const bf16_t*)(ws + WS_WGU1), DM, DM}; pg8::StaticOrder S; S.init(T, 2 * FF, G, bx);
        pg8::EpiSwiGLU E{ACT, ss1}; pg8::gemm_phase(lds, g, S, E);
        }
        { const int nfull = (22 * 64) % G;
          if (nfull > 0 && nfull < G) { if (bx >= nfull) prep_transposes<1>(args, lds, (bx - nfull) * 8 + wave, (G - nfull) * 8, wave, lane); }
          else prep_transposes<1>(args, lds, gw, NGW, wave, lane); }
    }
    SEAM(1);
    if (IN(2)) {
        pg8::Gemm g{ACT, (const bf16_t*)(ws + WS_WD1), FF, FF}; pg8::StaticOrder S; S.init(T, DM, G, bx);
        pg8::EpiResid<true, true> E{args.in[0], args.out, XB, ss2, 0.5f}; pg8::gemm_phase(lds, g, S, E);
    }
    SEAM(2);
    if (IN(3)) {
        pg8::Gemm g{XB, (const bf16_t*)(ws + WS_WIN), DM, DM}; pg8::StaticOrder S; S.init(T, 5120, G, bx);
        pg8::EpiProj E{(bf16_t*)(ws + WS_QA), (bf16_t*)(ws + WS_KV), (bf16_t*)(ws + WS_QKR), (bf16_t*)(ws + WS_VR), (bf16_t*)(ws + WS_GR), ss2,
                       (const float*)(ws + WS_COSN), (const float*)(ws + WS_SINN), (const float*)(ws + WS_COSR), (const float*)(ws + WS_SINR)};
        pg8::gemm_phase(lds, g, S, E);
    }
    SEAM(3);
    if (IN(4)) {
        if (PROBE == 2) { for (int it = bx; it < 256; it += G) { if (it < 128) compress_item(args, lds, it, tid, wave, lane); else retstate_item(args, lds, it - 128, tid, wave, lane); } }
        for (int it = bx; it < 256; it += G) { if (it < 128) compress_item(args, lds, it, tid, wave, lane); else retstate_item(args, lds, it - 128, tid, wave, lane); }
    }
    SEAM(4);
    if (IN(5)) {
        for (int vc = bx; vc < 256; vc += G) {
            const int bg = vc >> 5, j = vc & 31;
            const int qts[4] = {127 - j, 64 + j, 63 - j, j};
            if (PROBE == 3) {
#pragma unroll 1
                for (int i = 0; i < 4; ++i) nsa_item<PEXP>(args, lds, bg * 128 + qts[i], tid, wave, lane, true);
            }
#pragma unroll 1
            for (int i = 0; i < 4; ++i) nsa_item(args, lds, bg * 128 + qts[i], tid, wave, lane);
            if (PROBE == 6) {
#pragma unroll 1
                for (int i = 0; i < 2; ++i) retout_item(args, lds, vc * 2 + i, tid, wave, lane, true);
            }
#pragma unroll 1
            for (int i = 0; i < 2; ++i) retout_item(args, lds, vc * 2 + i, tid, wave, lane);
        }
    }
    SEAM(5);
    if (IN(6)) {
        { pg8::Gemm g{XB, (const bf16_t*)(ws + WS_WGM), DM, DM}; pg8::GateOrder S; S.S.init(T, DM, G, bx);
          pg8::EpiGate E{(bf16_t*)(ws + WS_GATEA), (bf16_t*)(ws + WS_GATER), ss2}; pg8::gemm_phase(lds, g, S, E); }
        { pg8::Gemm g{(const bf16_t*)(ws + WS_QA), (const bf16_t*)(ws + WS_WN), DM, DM}; pg8::StaticOrder S; S.init(T, DM, G, bx);
          pg8::EpiMix<false> E{(const bf16_t*)(ws + WS_GATEA), (bf16_t*)(ws + WS_MIX)}; pg8::gemm_phase(lds, g, S, E); }
        { pg8::Gemm g{(const bf16_t*)(ws + WS_VR), (const bf16_t*)(ws + WS_WR), DM, DM}; pg8::StaticOrder S; S.init(T, DM, G, bx);
          pg8::EpiMix<true> E{(const bf16_t*)(ws + WS_GATER), (bf16_t*)(ws + WS_MIX)}; pg8::gemm_phase(lds, g, S, E); }
    }
    SEAM(6);
    if (IN(7)) {
        pg8::Gemm g{(const bf16_t*)(ws + WS_MIX), (const bf16_t*)(ws + WS_WO), DM, DM}; pg8::StaticOrder S; S.init(T, DM, G, bx);
        pg8::EpiResid<true, true> E{args.out, args.out, XB, ss3, 1.0f}; pg8::gemm_phase(lds, g, S, E);
    }
    SEAM(7);
    if (IN(8)) {
        pg8::Gemm g{XB, (const bf16_t*)(ws + WS_WGU2), DM, DM}; pg8::StaticOrder S; S.init(T, 2 * FF, G, bx);
        pg8::EpiSwiGLU E{ACT, ss3}; pg8::gemm_phase(lds, g, S, E);
    }
    SEAM(8);
    if (IN(9)) {
        pg8::Gemm g{ACT, (const bf16_t*)(ws + WS_WD2), FF, FF}; pg8::StaticOrder S; S.init(T, DM, G, bx);
        pg8::EpiResid<false, false> E{args.out, args.out, nullptr, nullptr, 0.5f}; pg8::gemm_phase(lds, g, S, E);
    }
    SEAM(9);
    if (IN(10)) {
        const float* gf = args.in[20];
        for (int m0 = gw; m0 < T; m0 += 2 * NGW) {
            const int m1 = (m0 + NGW < T) ? m0 + NGW : m0;
            f32x4* xr0 = (f32x4*)(args.out + (size_t)m0 * DM) + lane; f32x4* xr1 = (f32x4*)(args.out + (size_t)m1 * DM) + lane;
            f32x4 v0[4], v1[4]; float s0 = 0.f, s1 = 0.f;
#pragma unroll
            for (int j = 0; j < 4; ++j) { v0[j] = xr0[64 * j]; v1[j] = xr1[64 * j]; }
#pragma unroll
            for (int j = 0; j < 4; ++j) { s0 += (v0[j].x * v0[j].x + v0[j].y * v0[j].y) + (v0[j].z * v0[j].z + v0[j].w * v0[j].w); s1 += (v1[j].x * v1[j].x + v1[j].y * v1[j].y) + (v1[j].z * v1[j].z + v1[j].w * v1[j].w); }
            const float rs0 = rsqrtf(wave_sum(s0) * (1.f / DM) + EPS), rs1 = rsqrtf(wave_sum(s1) * (1.f / DM) + EPS);
#pragma unroll
            for (int j = 0; j < 4; ++j) { const f32x4 gg = *((const f32x4*)gf + lane + 64 * j); xr0[64 * j] = v0[j] * rs0 * gg; if (m1 != m0) xr1[64 * j] = v1[j] * rs1 * gg; }
        }
    }
#undef IN
#undef SEAM
}

#ifndef N_LAUNCH_SPLIT
#define N_LAUNCH_SPLIT 0
#endif
extern "C" void kernel_launch(void* const* d_in, const int* in_sizes, int n_in, void* d_out, int out_size, void* d_ws, size_t ws_size, hipStream_t stream) {
    static int grid = 0;
    if (grid == 0) {
        int dev = 0, cus = 0, per_cu = 0;
        if (n_in != 21 || ws_size < WS_END) { fprintf(stderr, "kernel_launch: unexpected inputs (n_in %d, ws %zu)\n", n_in, ws_size); grid = -1; return; }
        hipGetDevice(&dev); hipDeviceGetAttribute(&cus, hipDeviceAttributeMultiprocessorCount, dev);
        if (hipFuncSetAttribute((const void*)fwd_mega, hipFuncAttributeMaxDynamicSharedMemorySize, LDS_BYTES) != hipSuccess) { fprintf(stderr, "hipFuncSetAttribute failed\n"); grid = -1; return; }
        if (hipOccupancyMaxActiveBlocksPerMultiprocessor(&per_cu, (const void*)fwd_mega, 512, LDS_BYTES) != hipSuccess || per_cu < 1) { fprintf(stderr, "occupancy query: %d\n", per_cu); per_cu = 1; }
        (void)hipGetLastError();
        grid = cus * 1;
    }
    if (grid < 0) return;
    Args a{};
    for (int i = 0; i < 21; ++i) a.in[i] = (const float*)d_in[i];
    a.out = (float*)d_out; a.ws = (unsigned char*)d_ws;
#if N_LAUNCH_SPLIT
    for (int p = 0; p < 11; ++p) { a.ph_lo = p; a.ph_hi = p + 1; hipLaunchKernelGGL(fwd_mega, dim3(grid), dim3(512), LDS_BYTES, stream, a); }
#else
    a.ph_lo = 0; a.ph_hi = 11;
    if (hipMemsetAsync((char*)d_ws + WS_BAR, 0, XCD_BAR_WORDS * 4, stream) != hipSuccess) { fprintf(stderr, "memset of barrier words failed\n"); return; }
    void* kargs[] = {&a};
    hipError_t e = hipLaunchCooperativeKernel((const void*)fwd_mega, dim3(grid), dim3(512), kargs, LDS_BYTES, stream);
    if (e != hipSuccess) fprintf(stderr, "cooperative launch failed: %s (grid %d)\n", hipGetErrorString(e), grid);
#endif
}
```

```cpp
#include <hip/hip_runtime.h>
#include <hip/hip_cooperative_groups.h>
#include <cstdio>
#include <cstdint>
namespace cg = cooperative_groups;

#define LAS __attribute__((address_space(3)))
#define DI __device__ __forceinline__
typedef unsigned short bf16_t;
typedef short bf16x8 __attribute__((ext_vector_type(8)));
typedef short s16x4 __attribute__((ext_vector_type(4)));
typedef float f32x4 __attribute__((ext_vector_type(4)));
typedef float f32x16 __attribute__((ext_vector_type(16)));
typedef unsigned u32x4 __attribute__((ext_vector_type(4)));
typedef unsigned u32x2 __attribute__((ext_vector_type(2)));

constexpr int T = 16384, SEQ = 4096, DM = 1024, FF = 2816, DIN = 6960;
constexpr float EPS = 1e-6f, GN_EPS = 1e-5f;
constexpr float C2 = 0.125f * 1.4426950408889634f;

constexpr size_t MiB = 1u << 20, KiB = 1u << 10;
constexpr size_t WS_SS1 = 0, WS_SS2 = 64 * KiB, WS_SS3 = 128 * KiB, WS_CBIAS = 192 * KiB;
constexpr size_t WS_BAR = 208 * KiB;
constexpr size_t WS_COSN = 256 * KiB, WS_SINN = 384 * KiB, WS_COSR = 512 * KiB, WS_SINR = 1024 * KiB;
constexpr size_t WS_KC = 1536 * KiB, WS_VC = 1792 * KiB;
constexpr size_t WS_BPART = 2 * MiB + 128 * KiB;
constexpr size_t WS_W2K = 2 * MiB, WS_W2V = 2 * MiB + 32 * KiB, WS_W1K = 3 * MiB, WS_W1V = 4 * MiB;
constexpr size_t WS_WGU1 = 5 * MiB, WS_WD1 = 16 * MiB, WS_RP = 5 * MiB;
constexpr size_t WS_WIN = 22 * MiB, WS_WGM = 32 * MiB, WS_WN = 36 * MiB, WS_WR = 38 * MiB, WS_WO = 40 * MiB;
constexpr size_t WS_WGU2 = 42 * MiB, WS_WD2 = 53 * MiB;
constexpr size_t WS_XB = 59 * MiB;
constexpr size_t WS_QA = 91 * MiB, WS_KV = 123 * MiB, WS_QKR = 155 * MiB, WS_VR = 187 * MiB, WS_GR = 219 * MiB, WS_END = 251 * MiB;
constexpr size_t WS_ACT = WS_QA, WS_GATEA = WS_QKR, WS_GATER = WS_GR, WS_MIX = WS_KV;

constexpr int LDS_BYTES = 147456;

DI unsigned f2bf(float f) { unsigned u = __builtin_bit_cast(unsigned, f); return (u + 0x7fffu + ((u >> 16) & 1u)) >> 16; }
typedef float f32x2_t __attribute__((ext_vector_type(2))); typedef __bf16 bf16x2_t __attribute__((ext_vector_type(2)));
DI unsigned pk2(float lo, float hi) { f32x2_t v = {lo, hi}; bf16x2_t b = __builtin_convertvector(v, bf16x2_t); return __builtin_bit_cast(unsigned, b); }
DI float bf2f(unsigned short h) { return __builtin_bit_cast(float, (unsigned)h << 16); }
DI float bflo(unsigned w) { return __builtin_bit_cast(float, w << 16); }
DI float bfhi(unsigned w) { return __builtin_bit_cast(float, w & 0xffff0000u); }
DI int crow(int r, int hi) { return (r & 3) + 8 * (r >> 2) + 4 * hi; }
DI float wave_sum(float v) {
#pragma unroll
    for (int o = 1; o < 64; o <<= 1) v += __shfl_xor(v, o);
    return v;
}
DI float xhalf(float v) {
    unsigned w = __builtin_bit_cast(unsigned, v); asm volatile("" : "+v"(w));
    const auto rr = __builtin_amdgcn_permlane32_swap(__builtin_bit_cast(unsigned, v), w, false, false);
    return __builtin_bit_cast(float, (threadIdx.x & 32) ? rr[0] : rr[1]);
}
DI bf16x8 pack8(const f32x16& x, int s) {
    u32x4 p; p.x = pk2(x[8 * s], x[8 * s + 1]); p.y = pk2(x[8 * s + 2], x[8 * s + 3]); p.z = pk2(x[8 * s + 4], x[8 * s + 5]); p.w = pk2(x[8 * s + 6], x[8 * s + 7]);
    return __builtin_bit_cast(bf16x8, p);
}
#define MFMA32(a, b, c) __builtin_amdgcn_mfma_f32_32x32x16_bf16((a), (b), (c), 0, 0, 0)
typedef short v4i16_t __attribute__((ext_vector_type(4)));
DI s16x4 vtr(const LAS char* p) { return __builtin_bit_cast(s16x4, __builtin_amdgcn_ds_read_tr16_b64_v4i16((LAS v4i16_t*)p)); }
DI bf16x8 cat8(s16x4 lo, s16x4 hi) { return (bf16x8){lo[0], lo[1], lo[2], lo[3], hi[0], hi[1], hi[2], hi[3]}; }
DI float sigmoidf_(float x) { return __builtin_amdgcn_rcpf(1.f + __expf(-x)); }
DI float xsum(float v) { return v + xhalf(v); }
DI float xmax(float v) { return fmaxf(v, xhalf(v)); }
DI int ldim(int p) { return p < 8 ? p : (p < 32 ? p + 8 : (p < 40 ? p - 24 : p)); }

namespace pg8 {
constexpr int BM = 256, BK = 64, HALF = 128, HTB = HALF * BK * 2, STAGE_BYTES = 8 * HTB, NXCD = 8, WGM = 8;
__host__ __device__ __forceinline__ int lds_byte(int r, int c) { const int st = (r >> 4) * 2 + (c >> 5), rr = r & 15, cc = c & 31, ob = rr * 64 + cc * 2; return st * 1024 + (ob ^ (((ob >> 9) & 1) << 5)); }
__host__ __device__ __forceinline__ void stage_rc(int b, int& R, int& C) { const int st = b / 1024, sb = b % 1024, swz = sb ^ (((sb >> 9) & 1) << 5); R = (st >> 1) * 16 + swz / 64; C = (st & 1) * 32 + (swz % 64) / 2; }
__host__ __device__ __forceinline__ int perm32(int rho) { const int n = rho >> 4, i = rho & 15; return 8 * (i >> 2) + 4 * n + (i & 3); }
struct Unit { int pm, pn; };
struct Gemm { const bf16_t* A; const bf16_t* Bt; int lda, K; };
struct StaticOrder {
    int nM, nN, nwg, G, c;
    DI void init(int M, int N, int G_, int c_) { nM = M / BM; nN = N / BM; nwg = nM * nN; G = G_; c = c_; }
    DI bool map(long L, Unit& u) const {
        if (L >= nwg) return false;
        int wgid = (int)L; { const int q = nwg / NXCD, r = nwg % NXCD, xcd = wgid % NXCD, off = wgid / NXCD; wgid = (xcd < r ? xcd * (q + 1) : r * (q + 1) + (xcd - r) * q) + off; }
        const int nig = WGM * nN, gid = wgid / nig, fm = gid * WGM, gsz = (nM - fm) < WGM ? (nM - fm) : WGM;
        u.pm = fm + ((wgid % nig) % gsz); u.pn = (wgid % nig) / gsz; return true;
    }
    DI bool next(int i, Unit& u) const { return map((long)i * G + c, u); }
};
struct GateOrder {
    StaticOrder S;
    DI bool next(int i, Unit& u) const { if (!S.map((long)(i >> 1) * S.G + S.c, u)) return false; u.pn += 4 * (i & 1); return true; }
};

template <class Epi, class Sched>
__device__ __forceinline__ void gemm_phase(LAS unsigned char* lds, const Gemm g, const Sched& S, const Epi& E) {
    const int tid = threadIdx.x, wid = __builtin_amdgcn_readfirstlane(tid >> 6), lane = tid & 63, wr = wid >> 2, wc = wid & 3, fr = lane & 15, fq = lane >> 4;
    const int K = g.K, nt = K / BK, lda = g.lda;
    unsigned voffA[2], voffB[2];
#pragma unroll
    for (int i = 0; i < 2; ++i) { int R, C; stage_rc(tid * 16 + i * 8192, R, C); const int Rb = (R & ~31) + perm32(R & 31);
        voffA[i] = (unsigned)(R * lda + C) * 2u; voffB[i] = (unsigned)(Rb * K + C) * 2u; }
    const size_t kstep = (size_t)(BK * 2);
    const size_t hstepA = (size_t)HALF * lda * 2, hstepB = (size_t)HALF * K * 2;
    const size_t tstepA = 2 * hstepA, tstepB = 2 * hstepB;
    const unsigned ldsw = (unsigned)wid * 1024u;
    const int aoff = lds_byte(wr * 64 + fr, fq * 8), boff = lds_byte(wc * 32 + fr, fq * 8);
#define PG8_SA(b, h) (((b) * 2 + (h)) * HTB)
#define PG8_SB(b, h) ((4 + (b) * 2 + (h)) * HTB)
#define PG8_STAGE(bufoff, gbase, voff) do { _Pragma("unroll") for (int _i = 0; _i < 2; ++_i) \
        __builtin_amdgcn_global_load_lds((const unsigned*)((const char*)(gbase) + (voff)[_i]), (LAS unsigned*)(lds + (bufoff) + ldsw + _i * 8192), 16, 0, 0); } while (0)
#define PG8_LDA(dst, b, h) do { _Pragma("unroll") for (int m = 0; m < 4; ++m) _Pragma("unroll") for (int k = 0; k < 2; ++k) dst[m][k] = *(const LAS bf16x8*)(lds + PG8_SA(b, h) + aoff + m * 2048 + k * 1024); } while (0)
#define PG8_LDB(dst, b, h) do { _Pragma("unroll") for (int n = 0; n < 2; ++n) _Pragma("unroll") for (int k = 0; k < 2; ++k) dst[n][k] = *(const LAS bf16x8*)(lds + PG8_SB(b, h) + boff + n * 2048 + k * 1024); } while (0)
#define PG8_MMA(ai, bj, At, Bt) do { __builtin_amdgcn_s_setprio(1); _Pragma("unroll") for (int m = 0; m < 4; ++m) _Pragma("unroll") for (int n = 0; n < 2; ++n) _Pragma("unroll") for (int k = 0; k < 2; ++k) \
        acc[ai][bj][m][n] = __builtin_amdgcn_mfma_f32_16x16x32_bf16(Bt[n][k], At[m][k], acc[ai][bj][m][n], 0, 0, 0); __builtin_amdgcn_s_setprio(0); } while (0)
#define PG8_WAIT_V(n) asm volatile("s_waitcnt vmcnt(" #n ")" ::: "memory")
#define PG8_WAIT_L(n) asm volatile("s_waitcnt lgkmcnt(" #n ")" ::: "memory")
#define PG8_BAR __builtin_amdgcn_s_barrier()
#define PG8_SCHED __builtin_amdgcn_sched_barrier(0)
    Unit cur, nxt; int ui = 0;
    if (!S.next(0, cur)) return;
    f32x4 acc[2][2][4][2];
#pragma unroll
    for (int a = 0; a < 2; ++a)
#pragma unroll
        for (int b = 0; b < 2; ++b)
#pragma unroll
            for (int m = 0; m < 4; ++m)
#pragma unroll
                for (int n = 0; n < 2; ++n) acc[a][b][m][n] = (f32x4){0.f, 0.f, 0.f, 0.f};
    bf16x8 At[4][2], B0[2][2], B1[2][2];
    const char* cA = (const char*)g.A + (size_t)cur.pm * tstepA; const char* cB = (const char*)g.Bt + (size_t)cur.pn * tstepB;
    PG8_STAGE(PG8_SB(0, 0), cB, voffB); PG8_STAGE(PG8_SB(0, 1), cB + hstepB, voffB); PG8_STAGE(PG8_SA(0, 0), cA, voffA); PG8_STAGE(PG8_SA(0, 1), cA + hstepA, voffA);
    if (wr == 1) PG8_BAR;
    PG8_WAIT_V(2); PG8_BAR;
    PG8_STAGE(PG8_SB(1, 0), cB + kstep, voffB); PG8_STAGE(PG8_SA(1, 0), cA + kstep, voffA); PG8_STAGE(PG8_SB(1, 1), cB + hstepB + kstep, voffB);
    PG8_WAIT_V(6); PG8_BAR;
    for (;;) {
        const bool has_next = S.next(ui + 1, nxt);
        const char* nA = has_next ? (const char*)g.A + (size_t)nxt.pm * tstepA : cA; const char* nB = has_next ? (const char*)g.Bt + (size_t)nxt.pn * tstepB : cB;
        for (int t = 0; t < nt; t += 2) {
            const bool last = (t == nt - 2);
            const char* a1 = cA + (size_t)(t + 1) * kstep;
            const char* a2 = last ? nA : cA + (size_t)(t + 2) * kstep; const char* b2 = last ? nB : cB + (size_t)(t + 2) * kstep;
            const char* a3 = a2 + kstep; const char* b3 = b2 + kstep;
            PG8_LDB(B0, 0, 0); PG8_LDB(B1, 0, 1); PG8_SCHED; PG8_LDA(At, 0, 0); PG8_STAGE(PG8_SA(1, 1), a1 + hstepA, voffA);
            PG8_WAIT_V(8); PG8_WAIT_L(0); PG8_BAR; PG8_MMA(0, 0, At, B0); PG8_MMA(0, 1, At, B1); PG8_BAR; PG8_SCHED;
            PG8_LDA(At, 0, 1); PG8_STAGE(PG8_SB(0, 0), b2, voffB); PG8_STAGE(PG8_SB(0, 1), b2 + hstepB, voffB); PG8_STAGE(PG8_SA(0, 0), a2, voffA);
            PG8_WAIT_V(8); PG8_WAIT_L(0); PG8_BAR; PG8_MMA(1, 0, At, B0); PG8_MMA(1, 1, At, B1); PG8_BAR; PG8_SCHED;
            PG8_LDB(B0, 1, 0); PG8_LDB(B1, 1, 1); PG8_SCHED; PG8_LDA(At, 1, 0); PG8_STAGE(PG8_SA(0, 1), a2 + hstepA, voffA);
            PG8_WAIT_V(8); PG8_WAIT_L(0); PG8_BAR; PG8_MMA(0, 0, At, B0); PG8_MMA(0, 1, At, B1); PG8_BAR; PG8_SCHED;
            PG8_LDA(At, 1, 1); PG8_STAGE(PG8_SB(1, 0), b3, voffB); PG8_STAGE(PG8_SB(1, 1), b3 + hstepB, voffB); PG8_STAGE(PG8_SA(1, 0), a3, voffA);
            PG8_WAIT_V(8); PG8_WAIT_L(0); PG8_BAR; PG8_MMA(1, 0, At, B0); PG8_MMA(1, 1, At, B1); PG8_BAR; PG8_SCHED;
        }
        if (wr == 0) PG8_BAR;
        E(acc, cur, wr, wc, fr, fq);
        if (!has_next) break;
#pragma unroll
        for (int a = 0; a < 2; ++a)
#pragma unroll
            for (int b = 0; b < 2; ++b)
#pragma unroll
                for (int m = 0; m < 4; ++m)
#pragma unroll
                    for (int n = 0; n < 2; ++n) acc[a][b][m][n] = (f32x4){0.f, 0.f, 0.f, 0.f};
        cur = nxt; cA = nA; cB = nB; ++ui;
        if (wr == 1) PG8_BAR;
    }
    PG8_WAIT_V(0);
    PG8_BAR;
#undef PG8_SA
#undef PG8_SB
#undef PG8_STAGE
#undef PG8_LDA
#undef PG8_LDB
#undef PG8_MMA
#undef PG8_WAIT_V
#undef PG8_WAIT_L
#undef PG8_BAR
#undef PG8_SCHED
}
typedef f32x4 Acc[2][2][4][2];
DI void st16(bf16_t* p, f32x4 a, f32x4 b) { u32x4 w; w.x = pk2(a[0], a[1]); w.y = pk2(a[2], a[3]); w.z = pk2(b[0], b[1]); w.w = pk2(b[2], b[3]); *(u32x4*)p = w; }

struct EpiSwiGLU {
    bf16_t* ACT; const float* ss;
    DI void operator()(const Acc& acc, const Unit& u, int wr, int wc, int fr, int fq) const {
        float ssv[8];
#pragma unroll
        for (int i = 0; i < 8; ++i) ssv[i] = ss[u.pm * BM + (i >> 2) * HALF + wr * 64 + (i & 3) * 16 + fr];
        __builtin_amdgcn_sched_barrier(0);
#pragma unroll
        for (int ai = 0; ai < 2; ++ai)
#pragma unroll
            for (int m = 0; m < 4; ++m) {
                const int row = u.pm * BM + ai * HALF + wr * 64 + m * 16 + fr;
                const float rs = rsqrtf(ssv[ai * 4 + m] * (1.f / DM) + EPS);
                f32x4 o[2];
#pragma unroll
                for (int n = 0; n < 2; ++n)
#pragma unroll
                    for (int j = 0; j < 4; ++j) { const float gv = acc[ai][0][m][n][j] * rs, uv = acc[ai][1][m][n][j] * rs; o[n][j] = gv * sigmoidf_(gv) * uv; }
                st16(ACT + (size_t)row * FF + u.pn * 128 + wc * 32 + fq * 8, o[0], o[1]);
            }
    }
};
template <bool IN16, bool OUT32, bool OUT16, bool SS> struct EpiResid {
    const float* xin32; const bf16_t* xin16; float* xout; bf16_t* xb; float* ss; float scale;
    DI void operator()(const Acc& acc, const Unit& u, int wr, int wc, int fr, int fq) const {
#pragma unroll
        for (int ai = 0; ai < 2; ++ai) {
            f32x4 xv[4][2][2]; u32x4 xw[4][2];
#pragma unroll
            for (int m = 0; m < 4; ++m)
#pragma unroll
                for (int bj = 0; bj < 2; ++bj) { const size_t off = (size_t)(u.pm * BM + ai * HALF + wr * 64 + m * 16 + fr) * DM + u.pn * BM + bj * HALF + wc * 32 + fq * 8;
                    if (IN16) xw[m][bj] = *(const u32x4*)(xin16 + off);
                    else { xv[m][bj][0] = *(const f32x4*)(xin32 + off); xv[m][bj][1] = *(const f32x4*)(xin32 + off + 4); } }
            __builtin_amdgcn_sched_barrier(0);
#pragma unroll
            for (int m = 0; m < 4; ++m) {
                const int row = u.pm * BM + ai * HALF + wr * 64 + m * 16 + fr;
                float sq = 0.f;
#pragma unroll
                for (int bj = 0; bj < 2; ++bj) {
                    const size_t off = (size_t)row * DM + u.pn * BM + bj * HALF + wc * 32 + fq * 8;
                    f32x4 x0, x1;
                    if (IN16) { const u32x4 w = xw[m][bj]; x0 = (f32x4){bflo(w.x), bfhi(w.x), bflo(w.y), bfhi(w.y)}; x1 = (f32x4){bflo(w.z), bfhi(w.z), bflo(w.w), bfhi(w.w)}; }
                    else { x0 = xv[m][bj][0]; x1 = xv[m][bj][1]; }
                    x0 = x0 + acc[ai][bj][m][0] * scale; x1 = x1 + acc[ai][bj][m][1] * scale;
                    if (OUT32) { *(f32x4*)(xout + off) = x0; *(f32x4*)(xout + off + 4) = x1; }
                    if (OUT16) st16(xb + off, x0, x1);
                    if (SS) sq += (x0[0] * x0[0] + x0[1] * x0[1]) + (x0[2] * x0[2] + x0[3] * x0[3]) + (x1[0] * x1[0] + x1[1] * x1[1]) + (x1[2] * x1[2] + x1[3] * x1[3]);
                }
                if (SS) { sq += __shfl_xor(sq, 16); sq += __shfl_xor(sq, 32); if (fq == 0) atomicAdd(ss + row, sq); }
            }
        }
    }
};
struct EpiProj {
    bf16_t *QA, *KV, *QKR, *VR, *GR; const float* ss; const float *cosN, *sinN, *cosR, *sinR;
    DI void operator()(const Acc& acc, const Unit& u, int wr, int wc, int fr, int fq) const {
        const int t = u.pn;
        float ssv[8];
#pragma unroll
        for (int i = 0; i < 8; ++i) ssv[i] = ss[u.pm * BM + (i >> 2) * HALF + wr * 64 + (i & 3) * 16 + fr];
        __builtin_amdgcn_sched_barrier(0);
#pragma unroll
        for (int ai = 0; ai < 2; ++ai)
#pragma unroll
          for (int mp = 0; mp < 2; ++mp) {
            f32x4 csv[2][2], snv[2][2];
            if (t <= 4) { if (fq == 0) {
#pragma unroll
                for (int r2 = 0; r2 < 2; ++r2)
#pragma unroll
                    for (int n = 0; n < 2; ++n) { const int pos2 = (u.pm * BM + ai * HALF + wr * 64 + (2 * mp + r2) * 16 + fr) & (SEQ - 1); csv[r2][n] = *(const f32x4*)(cosN + pos2 * 8 + 4 * n); snv[r2][n] = *(const f32x4*)(sinN + pos2 * 8 + 4 * n); } }
            } else if (t >= 7 && t < 11) {
#pragma unroll
                for (int r2 = 0; r2 < 2; ++r2)
#pragma unroll
                    for (int n = 0; n < 2; ++n) { const int pos2 = (u.pm * BM + ai * HALF + wr * 64 + (2 * mp + r2) * 16 + fr) & (SEQ - 1); csv[r2][n] = *(const f32x4*)(cosR + pos2 * 32 + 8 * fq + 4 * n); snv[r2][n] = *(const f32x4*)(sinR + pos2 * 32 + 8 * fq + 4 * n); }
            }
            __builtin_amdgcn_sched_barrier(0);
#pragma unroll
            for (int r2 = 0; r2 < 2; ++r2) {
                const int m = 2 * mp + r2;
                const int row = u.pm * BM + ai * HALF + wr * 64 + m * 16 + fr;
                const float rs = rsqrtf(ssv[ai * 4 + m] * (1.f / DM) + EPS);
                const int pos = row & (SEQ - 1);
                f32x4 v[2][2];
#pragma unroll
                for (int bj = 0; bj < 2; ++bj)
#pragma unroll
                    for (int n = 0; n < 2; ++n) v[bj][n] = acc[ai][bj][m][n] * rs;
                bf16_t* dst; int c0, c1;
                if (t <= 4) {
                    if (fq == 0) {
#pragma unroll
                        for (int n = 0; n < 2; ++n) { const f32x4 cs = csv[r2][n], sn = snv[r2][n];
                            const f32x4 lo = v[0][n], hi = v[1][n]; v[0][n] = lo * cs - hi * sn; v[1][n] = hi * cs + lo * sn; }
                    }
                    if (t < 4) {
#pragma unroll
                        for (int bj = 0; bj < 2; ++bj)
#pragma unroll
                            for (int n = 0; n < 2; ++n) v[bj][n] = v[bj][n] * C2;
                        dst = QA; c0 = 256 * t + 64 * wc + 8 * fq; c1 = c0 + 32;
                    } else { dst = KV; c0 = 64 * wc + 8 * fq; c1 = c0 + 32; }
                } else if (t >= 7 && t < 11) {
                    const bool isq = t < 9; const int head = 4 * ((t - 7) & 1) + wc; const int c = pos & 127;
                    const float lg = __log2f(1.f - exp2f(-5.f - (float)head));
                    const float f = isq ? 0.125f * exp2f((float)c * lg) : exp2f(-(float)c * lg);
#pragma unroll
                    for (int n = 0; n < 2; ++n) { const f32x4 cs = csv[r2][n], sn = snv[r2][n];
                        const f32x4 lo = v[0][n], hi = v[1][n]; v[0][n] = (lo * cs - hi * sn) * f; v[1][n] = (hi * cs + lo * sn) * f; }
                    dst = QKR; c0 = (isq ? 0 : 512) + 256 * ((t - 7) & 1) + 64 * wc + 8 * fq; c1 = c0 + 32;
                } else {
                    const int cc = 32 * wc + 8 * fq;
                    if (t == 5 || t == 6) { dst = KV; c0 = 256 * (t - 4) + cc; }
                    else if (t < 15) { dst = VR; c0 = 256 * (t - 11) + cc; }
                    else if (t < 19) { dst = GR; c0 = 256 * (t - 15) + cc;
#pragma unroll
                        for (int bj = 0; bj < 2; ++bj)
#pragma unroll
                            for (int n = 0; n < 2; ++n)
#pragma unroll
                                for (int j = 0; j < 4; ++j) { const float x = v[bj][n][j]; v[bj][n][j] = x * sigmoidf_(x); }
                    } else { dst = KV; c0 = 768 + cc;
#pragma unroll
                        for (int bj = 0; bj < 2; ++bj)
#pragma unroll
                            for (int n = 0; n < 2; ++n)
#pragma unroll
                                for (int j = 0; j < 4; ++j) v[bj][n][j] = sigmoidf_(v[bj][n][j]);
                    }
                    c1 = c0 + 128;
                }
                st16(dst + (size_t)row * DM + c0, v[0][0], v[0][1]);
                st16(dst + (size_t)row * DM + c1, v[1][0], v[1][1]);
            }
          }
    }
};
struct EpiGate {
    bf16_t *GA_, *GR_; const float* ss;
    DI void operator()(const Acc& acc, const Unit& u, int wr, int wc, int fr, int fq) const {
        bf16_t* dst = u.pn < 4 ? GA_ : GR_; const int ct = (u.pn & 3) * BM;
        float ssv[8];
#pragma unroll
        for (int i = 0; i < 8; ++i) ssv[i] = ss[u.pm * BM + (i >> 2) * HALF + wr * 64 + (i & 3) * 16 + fr];
        __builtin_amdgcn_sched_barrier(0);
#pragma unroll
        for (int ai = 0; ai < 2; ++ai)
#pragma unroll
            for (int m = 0; m < 4; ++m) {
                const int row = u.pm * BM + ai * HALF + wr * 64 + m * 16 + fr;
                const float rs = rsqrtf(ssv[ai * 4 + m] * (1.f / DM) + EPS);
#pragma unroll
                for (int bj = 0; bj < 2; ++bj) { f32x4 o[2];
#pragma unroll
                    for (int n = 0; n < 2; ++n)
#pragma unroll
                        for (int j = 0; j < 4; ++j) o[n][j] = sigmoidf_(acc[ai][bj][m][n][j] * rs);
                    st16(dst + (size_t)row * DM + ct + bj * HALF + wc * 32 + fq * 8, o[0], o[1]); }
            }
    }
};
template <bool ADD> struct EpiMix {
    const bf16_t* G_; bf16_t* MIX;
    DI void operator()(const Acc& acc, const Unit& u, int wr, int wc, int fr, int fq) const {
#pragma unroll
        for (int ai = 0; ai < 2; ++ai) {
            u32x4 gv[4][2], pv[4][2];
#pragma unroll
            for (int m = 0; m < 4; ++m)
#pragma unroll
                for (int bj = 0; bj < 2; ++bj) { const size_t off = (size_t)(u.pm * BM + ai * HALF + wr * 64 + m * 16 + fr) * DM + u.pn * BM + bj * HALF + wc * 32 + fq * 8;
                    gv[m][bj] = *(const u32x4*)(G_ + off); pv[m][bj] = (u32x4){0u, 0u, 0u, 0u}; if (ADD) pv[m][bj] = *(const u32x4*)(MIX + off); }
            __builtin_amdgcn_sched_barrier(0);
#pragma unroll
            for (int m = 0; m < 4; ++m) {
                const int row = u.pm * BM + ai * HALF + wr * 64 + m * 16 + fr;
#pragma unroll
                for (int bj = 0; bj < 2; ++bj) {
                    const size_t off = (size_t)row * DM + u.pn * BM + bj * HALF + wc * 32 + fq * 8;
                    const u32x4 gw = gv[m][bj];
                    const u32x4 pw = pv[m][bj];
                    f32x4 o0, o1;
                    o0[0] = bflo(gw.x) * acc[ai][bj][m][0][0]; o0[1] = bfhi(gw.x) * acc[ai][bj][m][0][1]; o0[2] = bflo(gw.y) * acc[ai][bj][m][0][2]; o0[3] = bfhi(gw.y) * acc[ai][bj][m][0][3];
                    o1[0] = bflo(gw.z) * acc[ai][bj][m][1][0]; o1[1] = bfhi(gw.z) * acc[ai][bj][m][1][1]; o1[2] = bflo(gw.w) * acc[ai][bj][m][1][2]; o1[3] = bfhi(gw.w) * acc[ai][bj][m][1][3];
                    if (ADD) { o0[0] += bflo(pw.x); o0[1] += bfhi(pw.x); o0[2] += bflo(pw.y); o0[3] += bfhi(pw.y); o1[0] += bflo(pw.z); o1[1] += bfhi(pw.z); o1[2] += bflo(pw.w); o1[3] += bfhi(pw.w); }
                    st16(MIX + off, o0, o1);
                }
            }
        }
    }
};
}

struct Args { const float* in[21]; float* out; unsigned char* ws; int ph_lo, ph_hi; };

DI void tr_item(const float* W, int ldw, int K, bf16_t* WT, int drow0, int scol4, const float* ksc, int k0, LAS float* scr, int lane) {
    const int kq = lane >> 4, n4 = 4 * (lane & 15);
    f32x4 v[16];
#pragma unroll
    for (int i = 0; i < 16; ++i) v[i] = scol4 >= 0 ? *(const f32x4*)(W + (size_t)(k0 + 4 * i + kq) * ldw + scol4) : (f32x4){0.f, 0.f, 0.f, 0.f};
#pragma unroll
    for (int i = 0; i < 16; ++i) { LAS float* d = scr + (4 * i + kq) * 65 + n4; d[0] = v[i].x; d[1] = v[i].y; d[2] = v[i].z; d[3] = v[i].w; }
    asm volatile("s_waitcnt lgkmcnt(0)" ::: "memory");
    const int c = lane & 7, nl = lane >> 3;
    f32x4 s0 = (f32x4){1.f, 1.f, 1.f, 1.f}, s1 = s0;
    if (ksc) { s0 = *(const f32x4*)(ksc + k0 + 8 * c); s1 = *(const f32x4*)(ksc + k0 + 8 * c + 4); }
#pragma unroll
    for (int j = 0; j < 8; ++j) { const int n = nl + 8 * j; const LAS float* p = scr + (8 * c) * 65 + n;
        u32x4 o; o.x = pk2(p[0 * 65] * s0.x, p[1 * 65] * s0.y); o.y = pk2(p[2 * 65] * s0.z, p[3 * 65] * s0.w); o.z = pk2(p[4 * 65] * s1.x, p[5 * 65] * s1.y); o.w = pk2(p[6 * 65] * s1.z, p[7 * 65] * s1.w);
        *(u32x4*)(WT + (size_t)(drow0 + n) * K + k0 + 8 * c) = o; }
    asm volatile("s_waitcnt lgkmcnt(0)" ::: "memory");
}
DI int win_src(int nrow) {
    const int t = nrow >> 8, rr = nrow & 255, bj = rr >> 7, wc = (rr >> 5) & 3, c = rr & 31;
    if (t < 4) return (4 * t + wc) * 64 + ldim(32 * bj + c);
    if (t == 4) return (wc < 2 ? 1280 + wc * 64 : 1536 + (wc - 2) * 64) + ldim(32 * bj + c);
    if (t == 5) return rr < 128 ? 1024 + rr : 1152 + rr - 128;
    if (t == 6) return rr < 128 ? 1408 + rr : 1664 + rr - 128;
    if (t < 9) return 1840 + (4 * (t - 7) + wc) * 64 + 32 * bj + c;
    if (t < 11) return 2352 + (4 * (t - 9) + wc) * 64 + 32 * bj + c;
    if (t < 15) return 2864 + (t - 11) * 256 + rr;
    if (t < 19) return 3888 + (t - 15) * 256 + rr;
    return rr < 48 ? 1792 + rr : -1;
}
template <int SET>
DI void prep_transposes(const Args& a, LAS unsigned char* lds, int gw, int NGW, int wave, int lane) {
    unsigned char* ws = a.ws;
    LAS float* scr = (LAS float*)(lds + wave * 18432);
    constexpr int I0 = (5632 / 64) * 16, I1 = (1024 / 64) * (2816 / 64), I2 = (5120 / 64) * 16, I3 = (2048 / 64) * 16, I4 = 16 * 16, I9 = 4 * 32, I11 = 4;
    constexpr int NIT = SET == 0 ? I0 + I1 + I2 + I3 + 2 * I9 + 2 * I11 : I0 + I1 + 3 * I4;
    constexpr int L = SET;
    const int l4 = 4 * (lane & 15);
    for (int it = gw; it < NIT; it += NGW) {
        int r = it;
        if (r < I0) { const int nb = r / 16, kb = r % 16, nrow = nb * 64 + l4; const int tile = nrow >> 8, rr = nrow & 255;
            tr_item(a.in[(rr >> 7) ? (L ? 18 : 3) : (L ? 17 : 2)], FF, DM, (bf16_t*)(ws + (L ? WS_WGU2 : WS_WGU1)), nb * 64, 128 * tile + (rr & 127), a.in[L ? 16 : 1], kb * 64, scr, lane); continue; } r -= I0;
        if (r < I1) { const int nb = r / 44, kb = r % 44;
            tr_item(a.in[L ? 19 : 4], DM, FF, (bf16_t*)(ws + (L ? WS_WD2 : WS_WD1)), nb * 64, nb * 64 + l4, nullptr, kb * 64, scr, lane); continue; } r -= I1;
        if (SET == 1) { const int w = r / I4; r -= w * I4; const int nb = r / 16, kb = r % 16;
            tr_item(a.in[13 + w], DM, DM, (bf16_t*)(ws + (w == 0 ? WS_WN : (w == 1 ? WS_WR : WS_WO))), nb * 64, nb * 64 + l4, nullptr, kb * 64, scr, lane); continue; }
        if (r < I2) { const int nb = r / 16, kb = r % 16; tr_item(a.in[6], DIN, DM, (bf16_t*)(ws + WS_WIN), nb * 64, win_src(nb * 64 + l4), a.in[5], kb * 64, scr, lane); continue; } r -= I2;
        if (r < I3) { const int nb = r / 16, kb = r % 16; tr_item(a.in[6], DIN, DM, (bf16_t*)(ws + WS_WGM), nb * 64, 4912 + nb * 64 + l4, a.in[5], kb * 64, scr, lane); continue; } r -= I3;
        if (r < 2 * I9) { const int w = r / I9; r -= w * I9; const int nb = r / 32, kb = r % 32;
            tr_item(a.in[w ? 10 : 8], 256, 2048, (bf16_t*)(ws + (w ? WS_W1V : WS_W1K)), nb * 64, nb * 64 + l4, nullptr, kb * 64, scr, lane); continue; } r -= 2 * I9;
        { const int w = r / I11; r -= w * I11; const int kb = r;
            tr_item(a.in[w ? 11 : 9], 64, 256, (bf16_t*)(ws + (w ? WS_W2V : WS_W2K)), 0, w ? l4 : ldim(l4), nullptr, kb * 64, scr, lane); }
    }
}
DI void phase_prep(const Args& a, LAS unsigned char* lds, int gw, int NGW, int wave, int lane) {
    unsigned char* ws = a.ws;
    prep_transposes<0>(a, lds, gw, NGW, wave, lane);
    const float* x = a.in[0]; bf16_t* xb = (bf16_t*)(ws + WS_XB); float* ss1 = (float*)(ws + WS_SS1);
    for (int m0 = gw; m0 < T; m0 += 2 * NGW) {
        const int m1 = m0 + NGW;
        const bool two = m1 < T;
        const f32x4* xr0 = (const f32x4*)(x + (size_t)m0 * DM) + lane; const f32x4* xr1 = (const f32x4*)(x + (size_t)(two ? m1 : m0) * DM) + lane;
        f32x4 v0[4], v1[4]; float s0 = 0.f, s1 = 0.f;
#pragma unroll
        for (int j = 0; j < 4; ++j) { v0[j] = xr0[64 * j]; v1[j] = xr1[64 * j]; }
#pragma unroll
        for (int j = 0; j < 4; ++j) { s0 += (v0[j].x * v0[j].x + v0[j].y * v0[j].y) + (v0[j].z * v0[j].z + v0[j].w * v0[j].w); s1 += (v1[j].x * v1[j].x + v1[j].y * v1[j].y) + (v1[j].z * v1[j].z + v1[j].w * v1[j].w); }
        s0 = wave_sum(s0); s1 = wave_sum(s1);
        u32x2* o0 = (u32x2*)(xb + (size_t)m0 * DM) + lane; u32x2* o1 = (u32x2*)(xb + (size_t)m1 * DM) + lane;
#pragma unroll
        for (int j = 0; j < 4; ++j) { o0[64 * j] = (u32x2){pk2(v0[j].x, v0[j].y), pk2(v0[j].z, v0[j].w)}; if (two) o1[64 * j] = (u32x2){pk2(v1[j].x, v1[j].y), pk2(v1[j].z, v1[j].w)}; }
        if (lane == 0) { ss1[m0] = s0; ((float*)(ws + WS_SS2))[m0] = 0.f; ((float*)(ws + WS_SS3))[m0] = 0.f;
            if (two) { ss1[m1] = s1; ((float*)(ws + WS_SS2))[m1] = 0.f; ((float*)(ws + WS_SS3))[m1] = 0.f; } }
    }
    const int gt = gw * 64 + lane, NGT = NGW * 64;
    for (int e = gt; e < SEQ * 8; e += NGT) { const int pos = e >> 3, i = e & 7; const float fr = powf(500000.0f, -(float)i * 2.0f / 16.0f); const float ang = (float)pos * fr;
        ((float*)(ws + WS_COSN))[e] = cosf(ang); ((float*)(ws + WS_SINN))[e] = sinf(ang); }
    for (int e = gt; e < SEQ * 32; e += NGT) { const int pos = e >> 5, i = e & 31; const float fr = powf(10000.0f, -(float)i * 2.0f / 64.0f); const float ang = (float)pos * fr;
        ((float*)(ws + WS_COSR))[e] = cosf(ang); ((float*)(ws + WS_SINR))[e] = sinf(ang); }
    for (int o = gw; o < 256; o += NGW) { const int w = o >> 7, jg = (o >> 5) & 3, kc = o & 31; const float* W1 = a.in[w ? 10 : 8]; const float* pe = a.in[7]; float s = 0.f;
#pragma unroll 16
        for (int k = 0; k < 64; ++k) s += pe[kc * 64 + k] * W1[(size_t)(kc * 64 + k) * 256 + jg * 64 + lane];
        ((float*)(ws + WS_BPART))[(w * 32 + kc) * 256 + jg * 64 + lane] = s; }
    for (int e = gt; e < 2 * 8 * 64; e += NGT) { const int w = e >> 9, bg = (e >> 6) & 7, d = e & 63; ((bf16_t*)(ws + (w ? WS_VC : WS_KC)))[(bg * 256 + 255) * 64 + d] = 0; }
}

DI float gelu_tanh(float x) { const float u = 0.7978845608028654f * (x + 0.044715f * x * x * x); const float e = __expf(2.f * u); const float th = 1.f - 2.f * __builtin_amdgcn_rcpf(e + 1.f); return 0.5f * x * (1.f + th); }
DI void compress_item(const Args& a, LAS unsigned char* lds, int item, int tid, int wave, int lane) {
    unsigned char* ws = a.ws; const int r32 = lane & 31, hi = lane >> 5;
    const int mt = item & 63, kv = item >> 6;
    const bf16_t* KV = (const bf16_t*)(ws + WS_KV);
    const bf16_t* W1T = (const bf16_t*)(ws + (kv ? WS_W1V : WS_W1K)); const bf16_t* W2T = (const bf16_t*)(ws + (kv ? WS_W2V : WS_W2K));
    int m = mt * 32 + r32; if (m > 2039) m = 2039;
    const int bg = m / 255, nc = m % 255, b = bg >> 1, g = bg & 1;
    __syncthreads();
#pragma unroll
    for (int i = 0; i < 16; ++i) {
        const int e = i * 512 + tid, seg = e >> 3, ch = e & 7, mrow = seg >> 5, l = seg & 31;
        int m3 = mt * 32 + mrow; if (m3 > 2039) m3 = 2039;
        const int bg3 = m3 / 255, nc3 = m3 % 255;
        const u32x4 v = *(const u32x4*)(KV + (size_t)((bg3 >> 1) * SEQ + nc3 * 16 + l) * DM + 256 + kv * 128 + (bg3 & 1) * 64 + 8 * ch);
        *(LAS u32x4*)(lds + mrow * 4112 + l * 128 + ch * 16) = v;
    }
    const bf16_t* wsrc = W1T + (size_t)(32 * wave + r32) * 2048 + 8 * hi;
    const LAS unsigned char* bsrc = lds + r32 * 4112 + 16 * hi;
    __syncthreads();
    f32x16 h = {};
#pragma unroll 1
    for (int s0 = 0; s0 < 128; s0 += 16) {
        bf16x8 af[16], bfr[16];
#pragma unroll
        for (int j = 0; j < 16; ++j) af[j] = *(const bf16x8*)(wsrc + 16 * (s0 + j));
#pragma unroll
        for (int j = 0; j < 16; ++j) bfr[j] = *(const LAS bf16x8*)(bsrc + 32 * (s0 + j));
        __builtin_amdgcn_sched_barrier(0);
#pragma unroll
        for (int j = 0; j < 16; ++j) h = MFMA32(af[j], bfr[j], h);
    }
    LAS float* red = (LAS float*)lds;
    LAS float* biasL = (LAS float*)(lds + 65536);
    __syncthreads();
    if (tid < 256) { const float* bp = (const float*)(ws + WS_BPART) + kv * 32 * 256 + tid; float b = 0.f;
#pragma unroll
        for (int c = 0; c < 32; ++c) b += bp[c * 256];
        biasL[tid] = b; }
    __syncthreads();
#pragma unroll
    for (int i = 0; i < 16; ++i) h[i] = gelu_tanh(h[i] + biasL[32 * wave + crow(i, hi)]);
#pragma unroll
    for (int dt = 0; dt < 2; ++dt) {
        f32x16 o = {};
#pragma unroll
        for (int ks = 0; ks < 2; ++ks) {
            const bf16_t* wp = W2T + (size_t)(32 * dt + r32) * 256 + 32 * wave + 16 * ks + 4 * hi;
            const s16x4 lo = *(const s16x4*)wp, hh = *(const s16x4*)(wp + 8);
            o = MFMA32(cat8(lo, hh), pack8(h, ks), o);
        }
#pragma unroll
        for (int i = 0; i < 16; ++i) red[(wave * 64 + 32 * dt + crow(i, hi)) * 32 + r32] = o[i];
    }
    __syncthreads();
    {
        const int mm = tid & 31, dq = tid >> 5; const int d0 = 4 * dq;
        float s[4] = {0.f, 0.f, 0.f, 0.f}, ps[4] = {0.f, 0.f, 0.f, 0.f};
        const bool rot = (kv == 0) && (dq < 2 || dq == 8 || dq == 9);
#pragma unroll
        for (int w = 0; w < 8; ++w)
#pragma unroll
            for (int j = 0; j < 4; ++j) { s[j] += red[(w * 64 + d0 + j) * 32 + mm]; ps[j] += red[(w * 64 + ((d0 + j) ^ 32)) * 32 + mm]; }
        const int m2 = mt * 32 + mm;
        if (m2 < 2040) {
            const int bg2 = m2 / 255, nc2 = m2 % 255;
            if (rot) { const int pos = 16 * nc2 + 31; const float* cs = (const float*)(ws + WS_COSN) + pos * 8; const float* sn = (const float*)(ws + WS_SINN) + pos * 8;
#pragma unroll
                for (int j = 0; j < 4; ++j) { const int i = (d0 + j) & 7; s[j] = (d0 < 8) ? s[j] * cs[i] - ps[j] * sn[i] : s[j] * cs[i] + ps[j] * sn[i]; } }
            bf16_t* dst = (bf16_t*)(ws + (kv ? WS_VC : WS_KC)) + (size_t)(bg2 * 256 + nc2) * 64 + d0;
            *(u32x2*)dst = (u32x2){pk2(s[0], s[1]), pk2(s[2], s[3])};
        }
    }
    __syncthreads();
}

DI void retstate_item(const Args& a, LAS unsigned char* lds, int item, int tid, int wave, int lane) {
    unsigned char* ws = a.ws; const int r32 = lane & 31, hi = lane >> 5;
    const int bh = item >> 2, dvs = item & 3, b = bh >> 3, h = bh & 7;
    const bf16_t* Kp = (const bf16_t*)(ws + WS_QKR) + (size_t)b * SEQ * DM + 512 + 64 * h;
    const bf16_t* Vp = (const bf16_t*)(ws + WS_VR) + (size_t)b * SEQ * DM + 128 * h + 32 * dvs;
    bf16_t* Rp = (bf16_t*)(ws + WS_RP) + (size_t)bh * 32 * 8192;
    const float lg = __log2f(1.f - exp2f(-5.f - (float)h));
    const float g127 = exp2f(127.f * lg), g128 = exp2f(128.f * lg);
    struct RS { u32x4 k0, k1, v; };
    auto gload = [&](RS& r, int n) __attribute__((always_inline)) {
        { const int e = tid, row = e >> 3, ch = e & 7; r.k0 = *(const u32x4*)(Kp + (size_t)(n * 128 + row) * DM + 8 * ch); }
        { const int e = tid + 512, row = e >> 3, ch = e & 7; r.k1 = *(const u32x4*)(Kp + (size_t)(n * 128 + row) * DM + 8 * ch); }
        { const int row = tid >> 2, ch = tid & 3; r.v = *(const u32x4*)(Vp + (size_t)(n * 128 + row) * DM + 8 * ch); }
    };
    auto lwrite = [&](const RS& r, int buf) __attribute__((always_inline)) {
        LAS unsigned char* kb = lds + buf * 24576; LAS unsigned char* vb = kb + 16384;
        { const int e = tid, row = e >> 3, ch = e & 7; *(LAS u32x4*)(kb + ((ch >> 2) * 8 + (row >> 4)) * 1024 + (row & 15) * 64 + (ch & 3) * 16) = r.k0; }
        { const int e = tid + 512, row = e >> 3, ch = e & 7; *(LAS u32x4*)(kb + ((ch >> 2) * 8 + (row >> 4)) * 1024 + (row & 15) * 64 + (ch & 3) * 16) = r.k1; }
        { const int row = tid >> 2, ch = tid & 3; *(LAS u32x4*)(vb + (row >> 4) * 1024 + (row & 15) * 64 + ch * 16) = r.v; }
    };
    f32x16 R = {};
    const int troff = ((lane >> 4) & 1) * 32 + (lane & 3) * 8 + (4 * hi + ((lane & 15) >> 2)) * 64;
    auto body = [&](RS& r, const int n) __attribute__((always_inline)) {
        const int buf = n & 1;
        lwrite(r, buf);
        if (n + 4 < 32) gload(r, n + 4);
        __syncthreads();
        if (wave < 2) {
            bf16_t* rp = Rp + (size_t)n * 8192 + (size_t)(32 * dvs + r32) * 64 + 32 * wave + 4 * hi;
#pragma unroll
            for (int q = 0; q < 4; ++q) *(u32x2*)(rp + 8 * q) = (u32x2){pk2(R[4 * q], R[4 * q + 1]), pk2(R[4 * q + 2], R[4 * q + 3])};
            const LAS char* kb = (const LAS char*)(lds + buf * 24576) + troff; const LAS char* vb = (const LAS char*)(lds + buf * 24576 + 16384) + troff;
            f32x16 kvn = {};
#pragma unroll
            for (int ks = 0; ks < 8; ++ks) {
                const bf16x8 af = cat8(vtr(kb + (wave * 8 + ks) * 1024), vtr(kb + (wave * 8 + ks) * 1024 + 512));
                const bf16x8 bfv = cat8(vtr(vb + ks * 1024), vtr(vb + ks * 1024 + 512));
                kvn = MFMA32(af, bfv, kvn);
            }
#pragma unroll
            for (int i = 0; i < 16; ++i) R[i] = g128 * R[i] + g127 * kvn[i];
        }
    };
    RS r0, r1, r2, r3;
    __syncthreads();
    gload(r0, 0); gload(r1, 1); gload(r2, 2); gload(r3, 3);
#pragma unroll 1
    for (int n = 0; n < 32; n += 4) { body(r0, n); body(r1, n + 1); body(r2, n + 2); body(r3, n + 3); }
    __syncthreads();
}

constexpr int AT_K = 0, AT_V = 16384, AT_IMP = 32768, AT_SLAB = 64 * 33, AT_SEL = 32768 + 8 * AT_SLAB * 4;
struct TileRegs { u32x4 k, v; };
DI void at_gload(TileRegs& r, const bf16_t* Kb, const bf16_t* Vb, int pitch, int kt, int wave, int lane) {
    r.k = *(const u32x4*)(Kb + (size_t)(kt * 64 + lane) * pitch + wave * 8);
    r.v = *(const u32x4*)(Vb + (size_t)(kt * 64 + 16 * (wave & 3) + (lane >> 2)) * pitch + (wave >> 2) * 32 + (lane & 3) * 8);
}
DI void at_lwrite(const TileRegs& r, LAS unsigned char* lds, int buf, int wave, int lane) {
    *(LAS u32x4*)(lds + AT_K + buf * 8192 + wave * 1024 + lane * 16) = r.k;
    *(LAS u32x4*)(lds + AT_V + buf * 8192 + wave * 1024 + lane * 16) = r.v;
}
DI void at_qk(f32x16& p0, f32x16& p1, const LAS unsigned char* kslot, const bf16x8* qr, const f32x16& cinit, int r32, int hi) {
    const LAS unsigned char* kb = kslot + hi * 1024 + r32 * 16;
#pragma unroll
    for (int d0 = 0; d0 < 4; ++d0) {
        const bf16x8 b0 = *(const LAS bf16x8*)(kb + d0 * 2048), b1 = *(const LAS bf16x8*)(kb + d0 * 2048 + 512);
        if (d0 == 0) { p0 = MFMA32(b0, qr[0], cinit); p1 = MFMA32(b1, qr[0], cinit); }
        else { p0 = MFMA32(b0, qr[d0], p0); p1 = MFMA32(b1, qr[d0], p1); }
    }
}
DI void at_pv(f32x16* o, const LAS unsigned char* vslot, const f32x16& p0, const f32x16& p1, int lane, int hi) {
    const LAS char* vp = (const LAS char*)vslot + ((lane >> 4) & 1) * 32 + (lane & 3) * 8 + (4 * hi + ((lane & 15) >> 2)) * 64;
    const bf16x8 pa[4] = {pack8(p0, 0), pack8(p0, 1), pack8(p1, 0), pack8(p1, 1)};
#pragma unroll
    for (int dt = 0; dt < 2; ++dt)
#pragma unroll
        for (int ks = 0; ks < 4; ++ks) {
            const bf16x8 vf = cat8(vtr(vp + dt * 4096 + ks * 1024), vtr(vp + dt * 4096 + ks * 1024 + 512));
            o[dt] = MFMA32(vf, pa[ks], o[dt]);
        }
}
DI void at_pv2(f32x16* o, const s16x4* vl, const s16x4* vh, const f32x16& p0, const f32x16& p1) {
    const bf16x8 pa[4] = {pack8(p0, 0), pack8(p0, 1), pack8(p1, 0), pack8(p1, 1)};
    __builtin_amdgcn_sched_barrier(0);
#pragma unroll
    for (int ks = 0; ks < 4; ++ks) { o[0] = MFMA32(cat8(vl[ks], vh[ks]), pa[ks], o[0]); o[1] = MFMA32(cat8(vl[4 + ks], vh[4 + ks]), pa[ks], o[1]); }
}
DI float max32(const f32x16& p0, const f32x16& p1) {
    float a = fmaxf(fmaxf(p0[0], p0[1]), p1[0]), b = fmaxf(fmaxf(p0[2], p0[3]), p1[1]); a = fmaxf(fmaxf(a, p1[2]), p1[3]);
#pragma unroll
    for (int i = 4; i < 16; i += 4) { a = fmaxf(fmaxf(a, p0[i]), p0[i + 1]); b = fmaxf(fmaxf(b, p0[i + 2]), p0[i + 3]); a = fmaxf(fmaxf(a, p1[i]), p1[i + 1]); b = fmaxf(fmaxf(b, p1[i + 2]), p1[i + 3]); }
    const float mx = fmaxf(a, b);
    return xmax(mx);
}
DI float sum32(const f32x16& p0, const f32x16& p1) {
    const f32x16 sv = p0 + p1;
    const float a = (sv[0] + sv[1]) + (sv[2] + sv[3]), b = (sv[4] + sv[5]) + (sv[6] + sv[7]), c = (sv[8] + sv[9]) + (sv[10] + sv[11]), d = (sv[12] + sv[13]) + (sv[14] + sv[15]);
    const float t = (a + b) + (c + d);
    return xsum(t);
}
#ifndef PEXP
#define PEXP 7
#endif
template <int MODE, int EXP = 0>
DI void at_loop(LAS unsigned char* lds, const bf16_t* Kb, const bf16_t* Vb, int pitch, int first, int last, const bf16x8* qr, f32x16* o, float& mrun, float& lrun,
                int t0, unsigned long long selm, int tid, int wave, int lane, TileRegs& trA) {
    const int r32 = lane & 31, hi = lane >> 5; const int t = t0 + r32;
    const float NINF = -__builtin_inff(); constexpr float THR = 8.f;
    __syncthreads();
    float cref = -mrun; if (MODE == 1) cref = lrun > 0.f ? -(mrun + __log2f(lrun)) : 0.f;
    float carry = 0.f;
    auto step = [&](const int kt, TileRegs& tr, const int buf) __attribute__((always_inline)) {
        if (EXP != 3) at_lwrite(tr, lds, buf, wave, lane);
        if (kt + 1 <= last) at_gload(tr, Kb, Vb, pitch, kt + 1, wave, lane);
        if (EXP != 3) __syncthreads();
        f32x16 p0, p1;
        {
            float c = cref; if (MODE == 2) { const bool sel = (selm >> kt) & 1ull; c = sel ? cref : NINF; }
            f32x16 ci;
#pragma unroll
            for (int i = 0; i < 16; ++i) ci[i] = c;
            const LAS unsigned char* kb = lds + AT_K + buf * 8192 + hi * 1024 + r32 * 16;
            bf16x8 kf[8];
#pragma unroll
            for (int d0 = 0; d0 < 4; ++d0) { kf[2 * d0] = *(const LAS bf16x8*)(kb + d0 * 2048); kf[2 * d0 + 1] = *(const LAS bf16x8*)(kb + d0 * 2048 + 512); }
            __builtin_amdgcn_sched_barrier(0);
            if (EXP == 4) { p0 = ci; p1 = ci; p0[0] += __builtin_bit_cast(float, (int)kf[0][0] + (int)kf[7][3]); } else {
            p0 = MFMA32(kf[0], qr[0], ci); p1 = MFMA32(kf[1], qr[0], ci);
#pragma unroll
            for (int d0 = 1; d0 < 4; ++d0) { p0 = MFMA32(kf[2 * d0], qr[d0], p0); p1 = MFMA32(kf[2 * d0 + 1], qr[d0], p1); } }
            __builtin_amdgcn_sched_barrier(0);
        }
        s16x4 vl[8], vh[8];
        if (MODE != 0 && EXP != 2) {
            const LAS char* vp = (const LAS char*)(lds + AT_V + buf * 8192) + ((lane >> 4) & 1) * 32 + (lane & 3) * 8 + (4 * hi + ((lane & 15) >> 2)) * 64;
#pragma unroll
            for (int i = 0; i < 8; ++i) { vl[i] = vtr(vp + (i >> 2) * 4096 + (i & 3) * 1024); vh[i] = vtr(vp + (i >> 2) * 4096 + (i & 3) * 1024 + 512); }
            __builtin_amdgcn_sched_barrier(0);
        }
        if (MODE <= 1) {
            if (16 * (64 * kt + 63) + 31 > t0) {
#pragma unroll
                for (int i = 0; i < 16; ++i) { const int n0 = 64 * kt + crow(i, hi); if (16 * n0 + 31 > t) p0[i] = NINF; if (16 * (n0 + 32) + 31 > t) p1[i] = NINF; }
            }
        } else if (MODE == 2) {
            if (kt == last) {
#pragma unroll
                for (int i = 0; i < 16; ++i) { const int k0 = 64 * kt + crow(i, hi); if (k0 > t) p0[i] = NINF; if (k0 + 32 > t) p1[i] = NINF; }
            }
        } else {
            if (kt == last || 64 * kt + 512 <= t0 + 31) {
#pragma unroll
                for (int i = 0; i < 16; ++i) { const int k0 = 64 * kt + crow(i, hi); if (k0 > t || t - k0 >= 512) p0[i] = NINF; if (k0 + 32 > t || t - k0 - 32 >= 512) p1[i] = NINF; }
            }
        }
        if (MODE == 1) {
#pragma unroll
            for (int i = 0; i < 16; ++i) { p0[i] = __builtin_amdgcn_exp2f(p0[i]); p1[i] = __builtin_amdgcn_exp2f(p1[i]); }
            LAS float* slab = (LAS float*)(lds + AT_IMP) + wave * AT_SLAB + r32;
            float av[2][4], rb[2][4];
#pragma unroll
            for (int hf = 0; hf < 2; ++hf)
#pragma unroll
                for (int gq = 0; gq < 4; ++gq) {
                    const f32x16& x = hf ? p1 : p0;
                    const float bb = 0.5f * x[4 * gq + 3]; av[hf][gq] = x[4 * gq] + x[4 * gq + 1] + x[4 * gq + 2] + bb; rb[hf][gq] = xhalf(bb);
                }
#pragma unroll
            for (int hf = 0; hf < 2; ++hf)
#pragma unroll
                for (int gq = 0; gq < 4; ++gq) {
                    const float prevrb = gq > 0 ? rb[hf][gq - 1] : (hf == 1 ? rb[0][3] : carry);
                    const int s = 16 * kt + 8 * hf + 2 * gq + hi;
                    slab[s * 33] = av[hf][gq] + (hi ? rb[hf][gq] : prevrb);
                }
            carry = rb[1][3];
            at_pv2(o, vl, vh, p0, p1);
        } else {
            const float tm = max32(p0, p1);
            const bool mv = (tm > THR) || (lrun == 0.f && tm > NINF);
            if (__any(mv)) {
                const float d = mv ? tm : 0.f;
                const float alpha = (lrun == 0.f) ? 1.f : __builtin_amdgcn_exp2f(-d);
                mrun += d; lrun *= alpha;
#pragma unroll
                for (int i = 0; i < 16; ++i) { p0[i] -= d; p1[i] -= d; }
                cref = -mrun;
                if (MODE != 0) {
#pragma unroll
                    for (int i = 0; i < 16; ++i) { o[0][i] *= alpha; o[1][i] *= alpha; }
                }
            }
            if (MODE == 0) {
#pragma unroll
                for (int i = 0; i < 16; ++i) { p0[i] = __builtin_amdgcn_exp2f(p0[i]); p1[i] = __builtin_amdgcn_exp2f(p1[i]); }
                lrun += sum32(p0, p1);
            } else {
                float ls[4];
#pragma unroll
                for (int ks = 0; ks < 4; ++ks) {
                    f32x16& x = (ks < 2) ? p0 : p1; const int r0 = 8 * (ks & 1);
#pragma unroll
                    for (int i = 0; i < 8; ++i) x[r0 + i] = __builtin_amdgcn_exp2f(x[r0 + i]);
                    ls[ks] = ((x[r0] + x[r0 + 1]) + (x[r0 + 2] + x[r0 + 3])) + ((x[r0 + 4] + x[r0 + 5]) + (x[r0 + 6] + x[r0 + 7]));
                    const bf16x8 pa = pack8(x, ks & 1);
                    o[0] = MFMA32(cat8(vl[ks], vh[ks]), pa, o[0]); o[1] = MFMA32(cat8(vl[4 + ks], vh[4 + ks]), pa, o[1]);
                }
                lrun += xsum((ls[0] + ls[1]) + (ls[2] + ls[3]));
            }
        }
    };
    for (int kt = first; kt <= last; kt += 2) {
        step(kt, trA, 0);
        if (kt + 1 <= last) step(kt + 1, trA, 1);
    }
}
template <bool ADD> DI void nsa_accum(bf16_t* aout, const f32x16* o, float f) {
    u32x2 wv[8];
    if (ADD) {
#pragma unroll
        for (int i = 0; i < 8; ++i) wv[i] = *(const u32x2*)(aout + 32 * (i >> 2) + 8 * (i & 3));
        __builtin_amdgcn_sched_barrier(0);
    }
#pragma unroll
    for (int dt = 0; dt < 2; ++dt)
#pragma unroll
        for (int q = 0; q < 4; ++q) {
            u32x2* p = (u32x2*)(aout + 32 * dt + 8 * q);
            float v0 = f * o[dt][4 * q], v1 = f * o[dt][4 * q + 1], v2 = f * o[dt][4 * q + 2], v3 = f * o[dt][4 * q + 3];
            if (ADD) { const u32x2 w = wv[dt * 4 + q]; v0 += bflo(w.x); v1 += bfhi(w.x); v2 += bflo(w.y); v3 += bfhi(w.y); }
            *p = (u32x2){pk2(v0, v1), pk2(v2, v3)};
        }
}
template <int EXP = 0> DI void nsa_item(const Args& a, LAS unsigned char* lds, int item, int tid, int wave, int lane, bool dry = false) {
    unsigned char* ws = a.ws; const int r32 = lane & 31, hi = lane >> 5;
    const int bg = item >> 7, qt = item & 127, b = bg >> 1, g = bg & 1; const int t0 = qt * 32, cur = t0 >> 6;
    bf16_t* QA = (bf16_t*)(ws + WS_QA); const bf16_t* KV = (const bf16_t*)(ws + WS_KV);
    const size_t tokrow = (size_t)(b * SEQ + t0 + r32) * DM; const int head = g * 8 + wave;
    bf16x8 qr[4];
#pragma unroll
    for (int d0 = 0; d0 < 4; ++d0) qr[d0] = *(const bf16x8*)(QA + tokrow + head * 64 + 16 * d0 + 8 * hi);
    float gate[3];
#pragma unroll
    for (int j = 0; j < 3; ++j) gate[j] = bf2f(KV[tokrow + 768 + head * 3 + j]);
    { LAS float* z = (LAS float*)(lds + AT_IMP) + wave * AT_SLAB;
#pragma unroll
      for (int i = 0; i < 33; ++i) z[lane + 64 * i] = 0.f; }
    f32x16 o[2];
    bf16_t* aout = QA + tokrow + head * 64 + 4 * hi;
    const bf16_t* KC = (const bf16_t*)(ws + WS_KC) + (size_t)bg * 256 * 64; const bf16_t* VC = (const bf16_t*)(ws + WS_VC) + (size_t)bg * 256 * 64;
    const int lastc = (t0 >> 4) >> 6;
    float mrun = 0.f, lrun = 0.f;
    TileRegs tr0;
    at_gload(tr0, KC, VC, 64, 0, wave, lane);
    if (EXP != 7) at_loop<0>(lds, KC, VC, 64, 0, lastc, qr, o, mrun, lrun, t0, 0ull, tid, wave, lane, tr0);
    o[0] = (f32x16){}; o[1] = (f32x16){};
    at_gload(tr0, KC, VC, 64, 0, wave, lane);
    if (EXP != 7 && EXP != 8) at_loop<1>(lds, KC, VC, 64, 0, lastc, qr, o, mrun, lrun, t0, 0ull, tid, wave, lane, tr0);
    const bf16_t* Ks = KV + (size_t)b * SEQ * DM + 64 * g; const bf16_t* Vs = KV + (size_t)b * SEQ * DM + 512 + 64 * g;
    at_gload(tr0, Ks, Vs, DM, 0, wave, lane);
    if (!(dry && a.ph_lo != 12345)) nsa_accum<false>(aout, o, gate[0]);
    __syncthreads();
    if (EXP >= 6) { if (lane == 0) { for (int qi = 0; qi < 4; ++qi) *(LAS unsigned long long*)(lds + AT_SEL + (4 * wave + qi) * 8) = ~0ull; } }
    else {
        const LAS float* imp = (const LAS float*)(lds + AT_IMP);
#pragma unroll 1
        for (int qi = 0; qi < 4; ++qi) {
            const int q = 4 * wave + qi; float v = 0.f;
#pragma unroll
            for (int w = 0; w < 8; ++w) v += imp[w * AT_SLAB + lane * 33 + q];
            const int s = lane;
            if (s == 0 || s == cur || s == cur - 1) v = 1.0e4f; else if (s > cur) v = -1.0e4f;
            typedef unsigned long long u64x2_t __attribute__((ext_vector_type(2)));
            const unsigned vb = __builtin_bit_cast(unsigned, v); const unsigned key = (vb >> 31) ? ~vb : (vb | 0x80000000u);
            const unsigned long long K = ((unsigned long long)key << 32) | (unsigned)(63 - lane);
            LAS unsigned long long* tk = (LAS unsigned long long*)(lds + AT_SEL + 256) + wave * 64;
            tk[lane] = K;
            u64x2_t rr[32];
#pragma unroll
            for (int j = 0; j < 32; ++j) rr[j] = *(const LAS u64x2_t*)(tk + 2 * j);
            int rank = 0;
#pragma unroll
            for (int j = 0; j < 32; ++j) { rank += (rr[j].x > K) ? 1 : 0; rank += (rr[j].y > K) ? 1 : 0; }
            const unsigned long long mk = __ballot(rank < 16 && s <= cur);
            if (lane == 0) *(LAS unsigned long long*)(lds + AT_SEL + q * 8) = mk;
        }
    }
    __syncthreads();
    const unsigned long long selm = *(const LAS unsigned long long*)(lds + AT_SEL + r32 * 8);
    const bf16_t* Kw = KV + (size_t)b * SEQ * DM + 128 + 64 * g; const bf16_t* Vw = KV + (size_t)b * SEQ * DM + 640 + 64 * g;
    const int firstw = t0 >= 511 ? (t0 - 511) >> 6 : 0;
    {
        mrun = 0.f; lrun = 0.f; o[0] = (f32x16){}; o[1] = (f32x16){};
        if (EXP < 5) at_loop<2, EXP>(lds, Ks, Vs, DM, 0, cur, qr, o, mrun, lrun, t0, selm, tid, wave, lane, tr0);
        const float f = gate[1] * (lrun > 0.f ? 1.f / lrun : 0.f);
        at_gload(tr0, Kw, Vw, DM, firstw, wave, lane);
        if (!(dry && a.ph_lo != 12345)) nsa_accum<true>(aout, o, f);
    }
    {
        mrun = 0.f; lrun = 0.f; o[0] = (f32x16){}; o[1] = (f32x16){};
        if (EXP < 5) at_loop<3, EXP>(lds, Kw, Vw, DM, firstw, cur, qr, o, mrun, lrun, t0, 0ull, tid, wave, lane, tr0);
        const float f = gate[2] * (lrun > 0.f ? 1.f / lrun : 0.f);
        if (!(dry && a.ph_lo != 12345)) nsa_accum<true>(aout, o, f);
    }
}

DI void retout_item(const Args& a, LAS unsigned char* lds, int item, int tid, int wave, int lane, bool dry = false) {
    unsigned char* ws = a.ws; const int r32 = lane & 31, hi = lane >> 5;
    const int half = wave >> 2, ww = wave & 3, tl = tid & 255;
    const int chunk = item * 2 + half;
    const int bh = chunk >> 5, n = chunk & 31, b = bh >> 3, h = bh & 7;
    const size_t row0 = (size_t)b * SEQ + n * 128;
    const bf16_t* QKR = (const bf16_t*)(ws + WS_QKR); bf16_t* VR = (bf16_t*)(ws + WS_VR); const bf16_t* GR = (const bf16_t*)(ws + WS_GR);
    const bf16_t* Rp = (const bf16_t*)(ws + WS_RP) + (size_t)chunk * 8192;
    LAS unsigned char* vimg = lds + half * 32768;
    __syncthreads();
    { u32x4 vv[8];
#pragma unroll
      for (int it = 0; it < 8; ++it) { const int e = it * 256 + tl, key = e >> 4, ch = e & 15; vv[it] = *(const u32x4*)(VR + (row0 + key) * DM + 128 * h + 8 * ch); }
      __builtin_amdgcn_sched_barrier(0);
#pragma unroll
      for (int it = 0; it < 8; ++it) { const int e = it * 256 + tl, key = e >> 4, ch = e & 15;
        *(LAS u32x4*)(vimg + ((ch >> 2) * 8 + (key >> 4)) * 1024 + (key & 15) * 64 + (ch & 3) * 16) = vv[it]; } }
    const float lg = __log2f(1.f - exp2f(-5.f - (float)h)); const float gam = exp2f(lg);
    bf16x8 qr[4];
    const bf16_t* qp = QKR + (row0 + 32 * ww + r32) * DM + 64 * h + 8 * hi;
#pragma unroll
    for (int d0 = 0; d0 < 4; ++d0) qr[d0] = *(const bf16x8*)(qp + 16 * d0);
    f32x16 o[4];
#pragma unroll
    for (int dh = 0; dh < 2; ++dh) { bf16x8 rf[8];
#pragma unroll
      for (int i = 0; i < 8; ++i) rf[i] = *(const bf16x8*)(Rp + (size_t)(32 * (2 * dh + (i >> 2)) + r32) * 64 + 8 * hi + 16 * (i & 3));
      __builtin_amdgcn_sched_barrier(0);
#pragma unroll
      for (int d2 = 0; d2 < 2; ++d2) { const int dt = 2 * dh + d2; o[dt] = (f32x16){};
#pragma unroll
        for (int d0 = 0; d0 < 4; ++d0) o[dt] = MFMA32(rf[d2 * 4 + d0], qr[d0], o[dt]);
#pragma unroll
        for (int i = 0; i < 16; ++i) o[dt][i] *= gam; } }
    __syncthreads();
    const LAS char* vp = (const LAS char*)vimg + ((lane >> 4) & 1) * 32 + (lane & 3) * 8 + (4 * hi + ((lane & 15) >> 2)) * 64;
    for (int jt = 0; jt <= ww; ++jt) {
        f32x16 p = {};
        const bf16_t* kp = QKR + (row0 + 32 * jt + r32) * DM + 512 + 64 * h + 8 * hi;
        bf16x8 kfr[4];
#pragma unroll
        for (int d0 = 0; d0 < 4; ++d0) kfr[d0] = *(const bf16x8*)(kp + 16 * d0);
        __builtin_amdgcn_sched_barrier(0);
#pragma unroll
        for (int d0 = 0; d0 < 4; ++d0) p = MFMA32(kfr[d0], qr[d0], p);
        if (jt == ww) {
#pragma unroll
            for (int i = 0; i < 16; ++i) if (crow(i, hi) > r32) p[i] = 0.f;
        }
        const bf16x8 pa0 = pack8(p, 0), pa1 = pack8(p, 1);
#pragma unroll
        for (int dt = 0; dt < 4; ++dt) {
            const LAS char* v0 = vp + (dt * 8 + 2 * jt) * 1024;
            o[dt] = MFMA32(cat8(vtr(v0), vtr(v0 + 512)), pa0, o[dt]);
            o[dt] = MFMA32(cat8(vtr(v0 + 1024), vtr(v0 + 1536)), pa1, o[dt]);
        }
    }
    float s = 0.f;
#pragma unroll
    for (int dt = 0; dt < 4; ++dt)
#pragma unroll
        for (int i = 0; i < 16; ++i) s += o[dt][i];
    s = xsum(s); const float mu = s * (1.f / 128.f); float q2 = 0.f;
#pragma unroll
    for (int dt = 0; dt < 4; ++dt)
#pragma unroll
        for (int i = 0; i < 16; ++i) { const float d = o[dt][i] - mu; q2 += d * d; }
    q2 = xsum(q2); const float rstd = rsqrtf(q2 * (1.f / 128.f) + GN_EPS);
    const float* gn = a.in[12] + 128 * h;
    const size_t orow = (row0 + 32 * ww + r32) * DM + 128 * h;
    __syncthreads();
    if (dry && a.ph_lo != 12345) return;
#pragma unroll
    for (int dh = 0; dh < 2; ++dh) {
        f32x4 ggv[8]; u32x2 gwv[8];
#pragma unroll
        for (int i = 0; i < 8; ++i) { const int dv = 32 * (2 * dh + (i >> 2)) + 8 * (i & 3) + 4 * hi; ggv[i] = *(const f32x4*)(gn + dv); gwv[i] = *(const u32x2*)(GR + orow + dv); }
        __builtin_amdgcn_sched_barrier(0);
#pragma unroll
        for (int d2 = 0; d2 < 2; ++d2)
#pragma unroll
            for (int q = 0; q < 4; ++q) {
                const int dt = 2 * dh + d2; const int dv = 32 * dt + 8 * q + 4 * hi;
                const f32x4 gg = ggv[d2 * 4 + q]; const u32x2 gw = gwv[d2 * 4 + q];
                const float r0 = (o[dt][4 * q] - mu) * rstd * gg[0] * bflo(gw.x), r1 = (o[dt][4 * q + 1] - mu) * rstd * gg[1] * bfhi(gw.x);
                const float r2 = (o[dt][4 * q + 2] - mu) * rstd * gg[2] * bflo(gw.y), r3 = (o[dt][4 * q + 3] - mu) * rstd * gg[3] * bfhi(gw.y);
                *(u32x2*)(VR + orow + dv) = (u32x2){pk2(r0, r1), pk2(r2, r3)};
            }
    }
}

#define XB_TMO      128
#define XB_XCNT(j)  (256  + 64 * (j))
#define XB_XSUB(j)  (1280 + 64 * (j))
#define XB_XGEN(j)  (2304 + 64 * (j))
#define XB_TOP      3328
#define XB_TOPGEN   3392
#define XCD_BAR_WORDS 3456
#define XB_SPIN_CAP (1u << 22)
DI unsigned xb_ld(unsigned* p)              { return __hip_atomic_load(p, __ATOMIC_RELAXED, __HIP_MEMORY_SCOPE_AGENT); }
DI unsigned xb_add(unsigned* p, unsigned v) { return __hip_atomic_fetch_add(p, v, __ATOMIC_RELAXED, __HIP_MEMORY_SCOPE_AGENT); }
DI unsigned xb_xcc_id() { return (unsigned)__builtin_amdgcn_s_getreg((3 << 11) | 20) & 0xFu; }
#define XB_SPIN(cond, bar) do { unsigned _sp = 0; while (cond) { __builtin_amdgcn_s_sleep(1); \
    if ((++_sp & 255u) == 0u) { if (xb_ld(&(bar)[XB_TMO])) break; if (_sp > XB_SPIN_CAP) { atomicAdd(&(bar)[XB_TMO], 1u); break; } } } } while (0)
struct XcdBarrier { unsigned* bar; unsigned x; volatile LAS unsigned* st; };
DI XcdBarrier xcd_barrier_post(unsigned* bar, volatile LAS unsigned* st) {
    XcdBarrier b; b.bar = bar; b.x = xb_xcc_id(); b.st = st;
    if (threadIdx.x == 0) (void)xb_add(&bar[XB_XCNT(b.x)], 1u);
    return b;
}
DI void xcd_barrier_complete(unsigned* bar, unsigned x, unsigned& nloc, unsigned& nx) {
    const unsigned G = gridDim.x * gridDim.y * gridDim.z;
    unsigned sum, cnt, mine, sp = 0u;
    for (;;) {
        sum = 0u; cnt = 0u; mine = 0u;
#pragma unroll
        for (unsigned j = 0; j < 16; ++j) { const unsigned c = xb_ld(&bar[XB_XCNT(j)]); sum += c; cnt += (c > 0u) ? 1u : 0u; mine = (j == x) ? c : mine; }
        if (sum == G) break;
        __builtin_amdgcn_s_sleep(1);
        if ((++sp & 255u) == 0u) { if (xb_ld(&bar[XB_TMO])) break; if (sp > XB_SPIN_CAP) { atomicAdd(&bar[XB_TMO], 1u); break; } }
    }
    nloc = mine > 0u ? mine : 1u; nx = cnt > 0u ? cnt : 1u;
}
DI void xcd_barrier(const XcdBarrier& b) {
    asm volatile("s_waitcnt vmcnt(0)" ::: "memory");
    __syncthreads();
    if (threadIdx.x == 0) {
        unsigned* bar = b.bar;
        __builtin_amdgcn_s_waitcnt(0);
        unsigned nloc = b.st[0], nx = b.st[1];
        if (nloc == 0u) { xcd_barrier_complete(bar, b.x, nloc, nx); b.st[0] = nloc; b.st[1] = nx; }
        const unsigned old = xb_add(&bar[XB_XSUB(b.x)], 1u);
        const unsigned gen = old / nloc;
        if (old + 1u == (gen + 1u) * nloc) {
            __builtin_amdgcn_fence(__ATOMIC_RELEASE, "agent");
            asm volatile("s_waitcnt vmcnt(0)" ::: "memory");
            const unsigned og = xb_add(&bar[XB_TOP], 1u);
            const unsigned tg = og / nx;
            if (og + 1u == (tg + 1u) * nx) xb_add(&bar[XB_TOPGEN], 1u);
            else XB_SPIN(xb_ld(&bar[XB_TOPGEN]) == tg, bar);
            __builtin_amdgcn_fence(__ATOMIC_ACQUIRE, "agent");
            xb_add(&bar[XB_XGEN(b.x)], 1u);
            asm volatile("s_waitcnt vmcnt(0)" ::: "memory");
        } else {
            XB_SPIN(xb_ld(&bar[XB_XGEN(b.x)]) == gen, bar);
            __builtin_amdgcn_fence(__ATOMIC_ACQUIRE, "agent");
            asm volatile("s_waitcnt vmcnt(0)" ::: "memory");
        }
    }
    __syncthreads();
}

__global__ void __launch_bounds__(512, 2) fwd_mega(Args args) {
    extern __shared__ __attribute__((aligned(16))) unsigned char lds_raw[];
    LAS unsigned char* lds = (LAS unsigned char*)lds_raw;
    cg::grid_group grid = cg::this_grid();
    const int tid = threadIdx.x, lane = tid & 63, wave = __builtin_amdgcn_readfirstlane(tid >> 6);
    const int G = gridDim.x, bx = blockIdx.x;
    const int gw = bx * 8 + wave, NGW = G * 8;
    unsigned char* ws = args.ws;
    const int lo = args.ph_lo, hi_ = args.ph_hi;
#define IN(k) (lo <= (k) && (k) < hi_)
    volatile LAS unsigned* bst = (volatile LAS unsigned*)(lds + LDS_BYTES - 64);
    if (tid < 16) bst[tid] = 0u;
    __syncthreads();
    XcdBarrier xbar = xcd_barrier_post((unsigned*)(ws + WS_BAR), bst);
    if (args.ph_lo == 12345) grid.sync();
#define SEAM(k) do { if (IN(k) && IN((k) + 1)) xcd_barrier(xbar); } while (0)
    float* ss1 = (float*)(ws + WS_SS1); float* ss2 = (float*)(ws + WS_SS2); float* ss3 = (float*)(ws + WS_SS3);
    bf16_t* XB = (bf16_t*)(ws + WS_XB); bf16_t* ACT = (bf16_t*)(ws + WS_ACT);

#ifndef PROBE
#define PROBE 0
#endif
    if (IN(0)) phase_prep(args, lds, gw, NGW, wave, lane);
    if (PROBE == 5) { xcd_barrier(xbar); phase_prep(args, lds, gw, NGW, wave, lane); }
    if (PROBE == 4) { for (int i = 0; i < 10; ++i) xcd_barrier(xbar); }
    SEAM(0);

    if (IN(1)) {
#pragma unroll 1
        for (int rep = 0; rep < (PROBE == 1 ? 2 : 1); ++rep) {
        pg8::Gemm g{XB, (const bf16_t*)(ws + WS_WGU1), DM, DM}; pg8::StaticOrder S; S.init(T, 2 * FF, G, bx);
        pg8::EpiSwiGLU E{ACT, ss1}; pg8::gemm_phase(lds, g, S, E);
        }
        { const int nfull = (22 * 64) % G;
          if (nfull > 0 && nfull < G) { if (bx >= nfull) prep_transposes<1>(args, lds, (bx - nfull) * 8 + wave, (G - nfull) * 8, wave, lane); }
          else prep_transposes<1>(args, lds, gw, NGW, wave, lane); }
    }
    SEAM(1);
    if (IN(2)) {
        pg8::Gemm g{ACT, (const bf16_t*)(ws + WS_WD1), FF, FF}; pg8::StaticOrder S; S.init(T, DM, G, bx);
        pg8::EpiResid<false, false, true, true> E{args.in[0], nullptr, nullptr, XB, ss2, 0.5f}; pg8::gemm_phase(lds, g, S, E);
    }
    SEAM(2);
    if (IN(3)) {
        pg8::Gemm g{XB, (const bf16_t*)(ws + WS_WIN), DM, DM}; pg8::StaticOrder S; S.init(T, 5120, G, bx);
        pg8::EpiProj E{(bf16_t*)(ws + WS_QA), (bf16_t*)(ws + WS_KV), (bf16_t*)(ws + WS_QKR), (bf16_t*)(ws + WS_VR), (bf16_t*)(ws + WS_GR), ss2,
                       (const float*)(ws + WS_COSN), (const float*)(ws + WS_SINN), (const float*)(ws + WS_COSR), (const float*)(ws + WS_SINR)};
        pg8::gemm_phase(lds, g, S, E);
    }
    SEAM(3);
    if (IN(4)) {
        if (PROBE == 2) { for (int it = bx; it < 256; it += G) { if (it < 128) compress_item(args, lds, it, tid, wave, lane); else retstate_item(args, lds, it - 128, tid, wave, lane); } }
        for (int it = bx; it < 256; it += G) { if (it < 128) compress_item(args, lds, it, tid, wave, lane); else retstate_item(args, lds, it - 128, tid, wave, lane); }
    }
    SEAM(4);
    if (IN(5)) {
        for (int vc = bx; vc < 256; vc += G) {
            const int bg = vc >> 5, j = vc & 31;
            const int qts[4] = {127 - j, 64 + j, 63 - j, j};
            if (PROBE == 3) {
#pragma unroll 1
                for (int i = 0; i < 4; ++i) nsa_item<PEXP>(args, lds, bg * 128 + qts[i], tid, wave, lane, true);
            }
#pragma unroll 1
            for (int i = 0; i < 4; ++i) nsa_item(args, lds, bg * 128 + qts[i], tid, wave, lane);
            if (PROBE == 6) {
#pragma unroll 1
                for (int i = 0; i < 2; ++i) retout_item(args, lds, vc * 2 + i, tid, wave, lane, true);
            }
#pragma unroll 1
            for (int i = 0; i < 2; ++i) retout_item(args, lds, vc * 2 + i, tid, wave, lane);
        }
    }
    SEAM(5);
    if (IN(6)) {
        { pg8::Gemm g{XB, (const bf16_t*)(ws + WS_WGM), DM, DM}; pg8::GateOrder S; S.S.init(T, DM, G, bx);
          pg8::EpiGate E{(bf16_t*)(ws + WS_GATEA), (bf16_t*)(ws + WS_GATER), ss2}; pg8::gemm_phase(lds, g, S, E); }
        { pg8::Gemm g{(const bf16_t*)(ws + WS_QA), (const bf16_t*)(ws + WS_WN), DM, DM}; pg8::StaticOrder S; S.init(T, DM, G, bx);
          pg8::EpiMix<false> E{(const bf16_t*)(ws + WS_GATEA), (bf16_t*)(ws + WS_MIX)}; pg8::gemm_phase(lds, g, S, E); }
        { pg8::Gemm g{(const bf16_t*)(ws + WS_VR), (const bf16_t*)(ws + WS_WR), DM, DM}; pg8::StaticOrder S; S.init(T, DM, G, bx);
          pg8::EpiMix<true> E{(const bf16_t*)(ws + WS_GATER), (bf16_t*)(ws + WS_MIX)}; pg8::gemm_phase(lds, g, S, E); }
    }
    SEAM(6);
    if (IN(7)) {
        pg8::Gemm g{(const bf16_t*)(ws + WS_MIX), (const bf16_t*)(ws + WS_WO), DM, DM}; pg8::StaticOrder S; S.init(T, DM, G, bx);
        pg8::EpiResid<true, false, true, true> E{nullptr, XB, nullptr, XB, ss3, 1.0f}; pg8::gemm_phase(lds, g, S, E);
    }
    SEAM(7);
    if (IN(8)) {
        pg8::Gemm g{XB, (const bf16_t*)(ws + WS_WGU2), DM, DM}; pg8::StaticOrder S; S.init(T, 2 * FF, G, bx);
        pg8::EpiSwiGLU E{ACT, ss3}; pg8::gemm_phase(lds, g, S, E);
    }
    SEAM(8);
    if (IN(9)) {
        pg8::Gemm g{ACT, (const bf16_t*)(ws + WS_WD2), FF, FF}; pg8::StaticOrder S; S.init(T, DM, G, bx);
        pg8::EpiResid<true, true, false, false> E{nullptr, XB, args.out, nullptr, nullptr, 0.5f}; pg8::gemm_phase(lds, g, S, E);
    }
    SEAM(9);
    if (IN(10)) {
        const float* gf = args.in[20];
        for (int m0 = gw; m0 < T; m0 += 2 * NGW) {
            const int m1 = (m0 + NGW < T) ? m0 + NGW : m0;
            f32x4* xr0 = (f32x4*)(args.out + (size_t)m0 * DM) + lane; f32x4* xr1 = (f32x4*)(args.out + (size_t)m1 * DM) + lane;
            f32x4 v0[4], v1[4]; float s0 = 0.f, s1 = 0.f;
#pragma unroll
            for (int j = 0; j < 4; ++j) { v0[j] = xr0[64 * j]; v1[j] = xr1[64 * j]; }
#pragma unroll
            for (int j = 0; j < 4; ++j) { s0 += (v0[j].x * v0[j].x + v0[j].y * v0[j].y) + (v0[j].z * v0[j].z + v0[j].w * v0[j].w); s1 += (v1[j].x * v1[j].x + v1[j].y * v1[j].y) + (v1[j].z * v1[j].z + v1[j].w * v1[j].w); }
            const float rs0 = rsqrtf(wave_sum(s0) * (1.f / DM) + EPS), rs1 = rsqrtf(wave_sum(s1) * (1.f / DM) + EPS);
#pragma unroll
            for (int j = 0; j < 4; ++j) { const f32x4 gg = *((const f32x4*)gf + lane + 64 * j); xr0[64 * j] = v0[j] * rs0 * gg; if (m1 != m0) xr1[64 * j] = v1[j] * rs1 * gg; }
        }
    }
#undef IN
#undef SEAM
}

#ifndef N_LAUNCH_SPLIT
#define N_LAUNCH_SPLIT 0
#endif
extern "C" void kernel_launch(void* const* d_in, const int* in_sizes, int n_in, void* d_out, int out_size, void* d_ws, size_t ws_size, hipStream_t stream) {
    static int grid = 0;
    if (grid == 0) {
        int dev = 0, cus = 0, per_cu = 0;
        if (n_in != 21 || ws_size < WS_END) { fprintf(stderr, "kernel_launch: unexpected inputs (n_in %d, ws %zu)\n", n_in, ws_size); grid = -1; return; }
        hipGetDevice(&dev); hipDeviceGetAttribute(&cus, hipDeviceAttributeMultiprocessorCount, dev);
        if (hipFuncSetAttribute((const void*)fwd_mega, hipFuncAttributeMaxDynamicSharedMemorySize, LDS_BYTES) != hipSuccess) { fprintf(stderr, "hipFuncSetAttribute failed\n"); grid = -1; return; }
        if (hipOccupancyMaxActiveBlocksPerMultiprocessor(&per_cu, (const void*)fwd_mega, 512, LDS_BYTES) != hipSuccess || per_cu < 1) { fprintf(stderr, "occupancy query: %d\n", per_cu); per_cu = 1; }
        (void)hipGetLastError();
        grid = cus * 1;
    }
    if (grid < 0) return;
    Args a{};
    for (int i = 0; i < 21; ++i) a.in[i] = (const float*)d_in[i];
    a.out = (float*)d_out; a.ws = (unsigned char*)d_ws;
#if N_LAUNCH_SPLIT
    for (int p = 0; p < 11; ++p) { a.ph_lo = p; a.ph_hi = p + 1; hipLaunchKernelGGL(fwd_mega, dim3(grid), dim3(512), LDS_BYTES, stream, a); }
#else
    a.ph_lo = 0; a.ph_hi = 11;
    if (hipMemsetAsync((char*)d_ws + WS_BAR, 0, XCD_BAR_WORDS * 4, stream) != hipSuccess) { fprintf(stderr, "memset of barrier words failed\n"); return; }
    void* kargs[] = {&a};
    hipError_t e = hipLaunchCooperativeKernel((const void*)fwd_mega, dim3(grid), dim3(512), kargs, LDS_BYTES, stream);
    if (e != hipSuccess) fprintf(stderr, "cooperative launch failed: %s (grid %d)\n", hipGetErrorString(e), grid);
#endif
}
```

```cpp
#include <hip/hip_runtime.h>
#include <hip/hip_cooperative_groups.h>
#include <cstdio>
#include <cstdint>
namespace cg = cooperative_groups;

#define LAS __attribute__((address_space(3)))
#define DI __device__ __forceinline__
typedef unsigned short bf16_t;
typedef short bf16x8 __attribute__((ext_vector_type(8)));
typedef short s16x4 __attribute__((ext_vector_type(4)));
typedef float f32x4 __attribute__((ext_vector_type(4)));
typedef float f32x16 __attribute__((ext_vector_type(16)));
typedef unsigned u32x4 __attribute__((ext_vector_type(4)));
typedef unsigned u32x2 __attribute__((ext_vector_type(2)));

constexpr int T = 16384, SEQ = 4096, DM = 1024, FF = 2816, DIN = 6960;
constexpr float EPS = 1e-6f, GN_EPS = 1e-5f;
constexpr float C2 = 0.125f * 1.4426950408889634f;

constexpr size_t MiB = 1u << 20, KiB = 1u << 10;
constexpr size_t WS_SS1 = 0, WS_SS2 = 64 * KiB, WS_SS3 = 128 * KiB, WS_CBIAS = 192 * KiB;
constexpr size_t WS_BAR = 208 * KiB;
constexpr size_t WS_COSN = 256 * KiB, WS_SINN = 384 * KiB, WS_COSR = 512 * KiB, WS_SINR = 1024 * KiB;
constexpr size_t WS_KC = 1536 * KiB, WS_VC = 1792 * KiB;
constexpr size_t WS_BPART = 2 * MiB + 128 * KiB;
constexpr size_t WS_W2K = 2 * MiB, WS_W2V = 2 * MiB + 32 * KiB, WS_W1K = 3 * MiB, WS_W1V = 4 * MiB;
constexpr size_t WS_WGU1 = 5 * MiB, WS_WD1 = 16 * MiB, WS_RP = 5 * MiB;
constexpr size_t WS_WIN = 22 * MiB, WS_WGM = 32 * MiB, WS_WN = 36 * MiB, WS_WR = 38 * MiB, WS_WO = 40 * MiB;
constexpr size_t WS_WGU2 = 42 * MiB, WS_WD2 = 53 * MiB;
constexpr size_t WS_XB = 59 * MiB;
constexpr size_t WS_QA = 91 * MiB, WS_KV = 123 * MiB, WS_QKR = 155 * MiB, WS_VR = 187 * MiB, WS_GR = 219 * MiB, WS_END = 251 * MiB;
constexpr size_t WS_ACT = WS_QA, WS_GATEA = WS_QKR, WS_GATER = WS_GR, WS_MIX = WS_KV;

constexpr int LDS_BYTES = 147456;

DI unsigned f2bf(float f) { unsigned u = __builtin_bit_cast(unsigned, f); return (u + 0x7fffu + ((u >> 16) & 1u)) >> 16; }
typedef float f32x2_t __attribute__((ext_vector_type(2))); typedef __bf16 bf16x2_t __attribute__((ext_vector_type(2)));
DI unsigned pk2(float lo, float hi) { f32x2_t v = {lo, hi}; bf16x2_t b = __builtin_convertvector(v, bf16x2_t); return __builtin_bit_cast(unsigned, b); }
DI float bf2f(unsigned short h) { return __builtin_bit_cast(float, (unsigned)h << 16); }
DI float bflo(unsigned w) { return __builtin_bit_cast(float, w << 16); }
DI float bfhi(unsigned w) { return __builtin_bit_cast(float, w & 0xffff0000u); }
DI int crow(int r, int hi) { return (r & 3) + 8 * (r >> 2) + 4 * hi; }
DI float wave_sum(float v) {
#pragma unroll
    for (int o = 1; o < 64; o <<= 1) v += __shfl_xor(v, o);
    return v;
}
DI float xhalf(float v) {
    unsigned w = __builtin_bit_cast(unsigned, v); asm volatile("" : "+v"(w));
    const auto rr = __builtin_amdgcn_permlane32_swap(__builtin_bit_cast(unsigned, v), w, false, false);
    return __builtin_bit_cast(float, (threadIdx.x & 32) ? rr[0] : rr[1]);
}
DI bf16x8 pack8(const f32x16& x, int s) {
    u32x4 p; p.x = pk2(x[8 * s], x[8 * s + 1]); p.y = pk2(x[8 * s + 2], x[8 * s + 3]); p.z = pk2(x[8 * s + 4], x[8 * s + 5]); p.w = pk2(x[8 * s + 6], x[8 * s + 7]);
    return __builtin_bit_cast(bf16x8, p);
}
#define MFMA32(a, b, c) __builtin_amdgcn_mfma_f32_32x32x16_bf16((a), (b), (c), 0, 0, 0)
typedef short v4i16_t __attribute__((ext_vector_type(4)));
DI s16x4 vtr(const LAS char* p) { return __builtin_bit_cast(s16x4, __builtin_amdgcn_ds_read_tr16_b64_v4i16((LAS v4i16_t*)p)); }
DI bf16x8 cat8(s16x4 lo, s16x4 hi) { return (bf16x8){lo[0], lo[1], lo[2], lo[3], hi[0], hi[1], hi[2], hi[3]}; }
DI float sigmoidf_(float x) { return __builtin_amdgcn_rcpf(1.f + __expf(-x)); }
DI float xsum(float v) { return v + xhalf(v); }
DI float xmax(float v) { return fmaxf(v, xhalf(v)); }
DI int ldim(int p) { return p < 8 ? p : (p < 32 ? p + 8 : (p < 40 ? p - 24 : p)); }

namespace pg8 {
constexpr int BM = 256, BK = 64, HALF = 128, HTB = HALF * BK * 2, STAGE_BYTES = 8 * HTB, NXCD = 8, WGM = 8;
__host__ __device__ __forceinline__ int lds_byte(int r, int c) { const int st = (r >> 4) * 2 + (c >> 5), rr = r & 15, cc = c & 31, ob = rr * 64 + cc * 2; return st * 1024 + (ob ^ (((ob >> 9) & 1) << 5)); }
__host__ __device__ __forceinline__ void stage_rc(int b, int& R, int& C) { const int st = b / 1024, sb = b % 1024, swz = sb ^ (((sb >> 9) & 1) << 5); R = (st >> 1) * 16 + swz / 64; C = (st & 1) * 32 + (swz % 64) / 2; }
__host__ __device__ __forceinline__ int perm32(int rho) { const int n = rho >> 4, i = rho & 15; return 8 * (i >> 2) + 4 * n + (i & 3); }
struct Unit { int pm, pn; };
struct Gemm { const bf16_t* A; const bf16_t* Bt; int lda, K; };
struct StaticOrder {
    int nM, nN, nwg, G, c;
    DI void init(int M, int N, int G_, int c_) { nM = M / BM; nN = N / BM; nwg = nM * nN; G = G_; c = c_; }
    DI bool map(long L, Unit& u) const {
        if (L >= nwg) return false;
        int wgid = (int)L; { const int q = nwg / NXCD, r = nwg % NXCD, xcd = wgid % NXCD, off = wgid / NXCD; wgid = (xcd < r ? xcd * (q + 1) : r * (q + 1) + (xcd - r) * q) + off; }
        const int nig = WGM * nN, gid = wgid / nig, fm = gid * WGM, gsz = (nM - fm) < WGM ? (nM - fm) : WGM;
        u.pm = fm + ((wgid % nig) % gsz); u.pn = (wgid % nig) / gsz; return true;
    }
    DI bool next(int i, Unit& u) const { return map((long)i * G + c, u); }
};
struct GateOrder {
    StaticOrder S;
    DI bool next(int i, Unit& u) const { if (!S.map((long)(i >> 1) * S.G + S.c, u)) return false; u.pn += 4 * (i & 1); return true; }
};

template <class Epi, class Sched>
__device__ __forceinline__ void gemm_phase(LAS unsigned char* lds, const Gemm g, const Sched& S, const Epi& E) {
    const int tid = threadIdx.x, wid = __builtin_amdgcn_readfirstlane(tid >> 6), lane = tid & 63, wr = wid >> 2, wc = wid & 3, fr = lane & 15, fq = lane >> 4;
    const int K = g.K, nt = K / BK, lda = g.lda;
    unsigned voffA[2], voffB[2];
#pragma unroll
    for (int i = 0; i < 2; ++i) { int R, C; stage_rc(tid * 16 + i * 8192, R, C); const int Rb = (R & ~31) + perm32(R & 31);
        voffA[i] = (unsigned)(R * lda + C) * 2u; voffB[i] = (unsigned)(Rb * K + C) * 2u; }
    const size_t kstep = (size_t)(BK * 2);
    const size_t hstepA = (size_t)HALF * lda * 2, hstepB = (size_t)HALF * K * 2;
    const size_t tstepA = 2 * hstepA, tstepB = 2 * hstepB;
    const unsigned ldsw = (unsigned)wid * 1024u;
    const int aoff = lds_byte(wr * 64 + fr, fq * 8), boff = lds_byte(wc * 32 + fr, fq * 8);
#define PG8_SA(b, h) (((b) * 2 + (h)) * HTB)
#define PG8_SB(b, h) ((4 + (b) * 2 + (h)) * HTB)
#define PG8_STAGE(bufoff, gbase, voff) do { _Pragma("unroll") for (int _i = 0; _i < 2; ++_i) \
        __builtin_amdgcn_global_load_lds((const unsigned*)((const char*)(gbase) + (voff)[_i]), (LAS unsigned*)(lds + (bufoff) + ldsw + _i * 8192), 16, 0, 0); } while (0)
#define PG8_LDA(dst, b, h) do { _Pragma("unroll") for (int m = 0; m < 4; ++m) _Pragma("unroll") for (int k = 0; k < 2; ++k) dst[m][k] = *(const LAS bf16x8*)(lds + PG8_SA(b, h) + aoff + m * 2048 + k * 1024); } while (0)
#define PG8_LDB(dst, b, h) do { _Pragma("unroll") for (int n = 0; n < 2; ++n) _Pragma("unroll") for (int k = 0; k < 2; ++k) dst[n][k] = *(const LAS bf16x8*)(lds + PG8_SB(b, h) + boff + n * 2048 + k * 1024); } while (0)
#define PG8_MMA(ai, bj, At, Bt) do { __builtin_amdgcn_s_setprio(1); _Pragma("unroll") for (int m = 0; m < 4; ++m) _Pragma("unroll") for (int n = 0; n < 2; ++n) _Pragma("unroll") for (int k = 0; k < 2; ++k) \
        acc[ai][bj][m][n] = __builtin_amdgcn_mfma_f32_16x16x32_bf16(Bt[n][k], At[m][k], acc[ai][bj][m][n], 0, 0, 0); __builtin_amdgcn_s_setprio(0); } while (0)
#define PG8_WAIT_V(n) asm volatile("s_waitcnt vmcnt(" #n ")" ::: "memory")
#define PG8_WAIT_L(n) asm volatile("s_waitcnt lgkmcnt(" #n ")" ::: "memory")
#define PG8_BAR __builtin_amdgcn_s_barrier()
#define PG8_SCHED __builtin_amdgcn_sched_barrier(0)
    Unit cur, nxt; int ui = 0;
    if (!S.next(0, cur)) return;
    f32x4 acc[2][2][4][2];
#pragma unroll
    for (int a = 0; a < 2; ++a)
#pragma unroll
        for (int b = 0; b < 2; ++b)
#pragma unroll
            for (int m = 0; m < 4; ++m)
#pragma unroll
                for (int n = 0; n < 2; ++n) acc[a][b][m][n] = (f32x4){0.f, 0.f, 0.f, 0.f};
    bf16x8 At[4][2], B0[2][2], B1[2][2];
    const char* cA = (const char*)g.A + (size_t)cur.pm * tstepA; const char* cB = (const char*)g.Bt + (size_t)cur.pn * tstepB;
    PG8_STAGE(PG8_SB(0, 0), cB, voffB); PG8_STAGE(PG8_SB(0, 1), cB + hstepB, voffB); PG8_STAGE(PG8_SA(0, 0), cA, voffA); PG8_STAGE(PG8_SA(0, 1), cA + hstepA, voffA);
    if (wr == 1) PG8_BAR;
    PG8_WAIT_V(2); PG8_BAR;
    PG8_STAGE(PG8_SB(1, 0), cB + kstep, voffB); PG8_STAGE(PG8_SA(1, 0), cA + kstep, voffA); PG8_STAGE(PG8_SB(1, 1), cB + hstepB + kstep, voffB);
    PG8_WAIT_V(6); PG8_BAR;
    for (;;) {
        const bool has_next = S.next(ui + 1, nxt);
        const char* nA = has_next ? (const char*)g.A + (size_t)nxt.pm * tstepA : cA; const char* nB = has_next ? (const char*)g.Bt + (size_t)nxt.pn * tstepB : cB;
        for (int t = 0; t < nt; t += 2) {
            const bool last = (t == nt - 2);
            const char* a1 = cA + (size_t)(t + 1) * kstep;
            const char* a2 = last ? nA : cA + (size_t)(t + 2) * kstep; const char* b2 = last ? nB : cB + (size_t)(t + 2) * kstep;
            const char* a3 = a2 + kstep; const char* b3 = b2 + kstep;
            PG8_LDB(B0, 0, 0); PG8_LDB(B1, 0, 1); PG8_SCHED; PG8_LDA(At, 0, 0); PG8_STAGE(PG8_SA(1, 1), a1 + hstepA, voffA);
            PG8_WAIT_V(8); PG8_WAIT_L(0); PG8_BAR; PG8_MMA(0, 0, At, B0); PG8_MMA(0, 1, At, B1); PG8_BAR; PG8_SCHED;
            PG8_LDA(At, 0, 1); PG8_STAGE(PG8_SB(0, 0), b2, voffB); PG8_STAGE(PG8_SB(0, 1), b2 + hstepB, voffB); PG8_STAGE(PG8_SA(0, 0), a2, voffA);
            PG8_WAIT_V(8); PG8_WAIT_L(0); PG8_BAR; PG8_MMA(1, 0, At, B0); PG8_MMA(1, 1, At, B1); PG8_BAR; PG8_SCHED;
            PG8_LDB(B0, 1, 0); PG8_LDB(B1, 1, 1); PG8_SCHED; PG8_LDA(At, 1, 0); PG8_STAGE(PG8_SA(0, 1), a2 + hstepA, voffA);
            PG8_WAIT_V(8); PG8_WAIT_L(0); PG8_BAR; PG8_MMA(0, 0, At, B0); PG8_MMA(0, 1, At, B1); PG8_BAR; PG8_SCHED;
            PG8_LDA(At, 1, 1); PG8_STAGE(PG8_SB(1, 0), b3, voffB); PG8_STAGE(PG8_SB(1, 1), b3 + hstepB, voffB); PG8_STAGE(PG8_SA(1, 0), a3, voffA);
            PG8_WAIT_V(8); PG8_WAIT_L(0); PG8_BAR; PG8_MMA(1, 0, At, B0); PG8_MMA(1, 1, At, B1); PG8_BAR; PG8_SCHED;
        }
        if (wr == 0) PG8_BAR;
        E(acc, cur, wr, wc, fr, fq);
        if (!has_next) break;
#pragma unroll
        for (int a = 0; a < 2; ++a)
#pragma unroll
            for (int b = 0; b < 2; ++b)
#pragma unroll
                for (int m = 0; m < 4; ++m)
#pragma unroll
                    for (int n = 0; n < 2; ++n) acc[a][b][m][n] = (f32x4){0.f, 0.f, 0.f, 0.f};
        cur = nxt; cA = nA; cB = nB; ++ui;
        if (wr == 1) PG8_BAR;
    }
    PG8_WAIT_V(0);
    PG8_BAR;
#undef PG8_SA
#undef PG8_SB
#undef PG8_STAGE
#undef PG8_LDA
#undef PG8_LDB
#undef PG8_MMA
#undef PG8_WAIT_V
#undef PG8_WAIT_L
#undef PG8_BAR
#undef PG8_SCHED
}
typedef f32x4 Acc[2][2][4][2];
DI void st16(bf16_t* p, f32x4 a, f32x4 b) { u32x4 w; w.x = pk2(a[0], a[1]); w.y = pk2(a[2], a[3]); w.z = pk2(b[0], b[1]); w.w = pk2(b[2], b[3]); *(u32x4*)p = w; }

struct EpiSwiGLU {
    bf16_t* ACT; const float* ss;
    DI void operator()(const Acc& acc, const Unit& u, int wr, int wc, int fr, int fq) const {
        float ssv[8];
#pragma unroll
        for (int i = 0; i < 8; ++i) ssv[i] = ss[u.pm * BM + (i >> 2) * HALF + wr * 64 + (i & 3) * 16 + fr];
        __builtin_amdgcn_sched_barrier(0);
#pragma unroll
        for (int ai = 0; ai < 2; ++ai)
#pragma unroll
            for (int m = 0; m < 4; ++m) {
                const int row = u.pm * BM + ai * HALF + wr * 64 + m * 16 + fr;
                const float rs = rsqrtf(ssv[ai * 4 + m] * (1.f / DM) + EPS);
                f32x4 o[2];
#pragma unroll
                for (int n = 0; n < 2; ++n)
#pragma unroll
                    for (int j = 0; j < 4; ++j) { const float gv = acc[ai][0][m][n][j] * rs, uv = acc[ai][1][m][n][j] * rs; o[n][j] = gv * sigmoidf_(gv) * uv; }
                st16(ACT + (size_t)row * FF + u.pn * 128 + wc * 32 + fq * 8, o[0], o[1]);
            }
    }
};
template <bool IN16, bool OUT32, bool OUT16, bool SS> struct EpiResid {
    const float* xin32; const bf16_t* xin16; float* xout; bf16_t* xb; float* ss; float scale;
    DI void operator()(const Acc& acc, const Unit& u, int wr, int wc, int fr, int fq) const {
#pragma unroll
        for (int ai = 0; ai < 2; ++ai) {
            f32x4 xv[4][2][2]; u32x4 xw[4][2];
#pragma unroll
            for (int m = 0; m < 4; ++m)
#pragma unroll
                for (int bj = 0; bj < 2; ++bj) { const size_t off = (size_t)(u.pm * BM + ai * HALF + wr * 64 + m * 16 + fr) * DM + u.pn * BM + bj * HALF + wc * 32 + fq * 8;
                    if (IN16) xw[m][bj] = *(const u32x4*)(xin16 + off);
                    else { xv[m][bj][0] = *(const f32x4*)(xin32 + off); xv[m][bj][1] = *(const f32x4*)(xin32 + off + 4); } }
            __builtin_amdgcn_sched_barrier(0);
#pragma unroll
            for (int m = 0; m < 4; ++m) {
                const int row = u.pm * BM + ai * HALF + wr * 64 + m * 16 + fr;
                float sq = 0.f;
#pragma unroll
                for (int bj = 0; bj < 2; ++bj) {
                    const size_t off = (size_t)row * DM + u.pn * BM + bj * HALF + wc * 32 + fq * 8;
                    f32x4 x0, x1;
                    if (IN16) { const u32x4 w = xw[m][bj]; x0 = (f32x4){bflo(w.x), bfhi(w.x), bflo(w.y), bfhi(w.y)}; x1 = (f32x4){bflo(w.z), bfhi(w.z), bflo(w.w), bfhi(w.w)}; }
                    else { x0 = xv[m][bj][0]; x1 = xv[m][bj][1]; }
                    x0 = x0 + acc[ai][bj][m][0] * scale; x1 = x1 + acc[ai][bj][m][1] * scale;
                    if (OUT32) { *(f32x4*)(xout + off) = x0; *(f32x4*)(xout + off + 4) = x1; }
                    if (OUT16) st16(xb + off, x0, x1);
                    if (SS) sq += (x0[0] * x0[0] + x0[1] * x0[1]) + (x0[2] * x0[2] + x0[3] * x0[3]) + (x1[0] * x1[0] + x1[1] * x1[1]) + (x1[2] * x1[2] + x1[3] * x1[3]);
                }
                if (SS) { sq += __shfl_xor(sq, 16); sq += __shfl_xor(sq, 32); if (fq == 0) atomicAdd(ss + row, sq); }
            }
        }
    }
};
struct EpiProj {
    bf16_t *QA, *KV, *QKR, *VR, *GR; const float* ss; const float *cosN, *sinN, *cosR, *sinR;
    DI void operator()(const Acc& acc, const Unit& u, int wr, int wc, int fr, int fq) const {
        const int t = u.pn;
        float ssv[8];
#pragma unroll
        for (int i = 0; i < 8; ++i) ssv[i] = ss[u.pm * BM + (i >> 2) * HALF + wr * 64 + (i & 3) * 16 + fr];
        __builtin_amdgcn_sched_barrier(0);
#pragma unroll
        for (int ai = 0; ai < 2; ++ai)
#pragma unroll
          for (int mp = 0; mp < 2; ++mp) {
            f32x4 csv[2][2], snv[2][2];
            if (t <= 4) { if (fq == 0) {
#pragma unroll
                for (int r2 = 0; r2 < 2; ++r2)
#pragma unroll
                    for (int n = 0; n < 2; ++n) { const int pos2 = (u.pm * BM + ai * HALF + wr * 64 + (2 * mp + r2) * 16 + fr) & (SEQ - 1); csv[r2][n] = *(const f32x4*)(cosN + pos2 * 8 + 4 * n); snv[r2][n] = *(const f32x4*)(sinN + pos2 * 8 + 4 * n); } }
            } else if (t >= 7 && t < 11) {
#pragma unroll
                for (int r2 = 0; r2 < 2; ++r2)
#pragma unroll
                    for (int n = 0; n < 2; ++n) { const int pos2 = (u.pm * BM + ai * HALF + wr * 64 + (2 * mp + r2) * 16 + fr) & (SEQ - 1); csv[r2][n] = *(const f32x4*)(cosR + pos2 * 32 + 8 * fq + 4 * n); snv[r2][n] = *(const f32x4*)(sinR + pos2 * 32 + 8 * fq + 4 * n); }
            }
            __builtin_amdgcn_sched_barrier(0);
#pragma unroll
            for (int r2 = 0; r2 < 2; ++r2) {
                const int m = 2 * mp + r2;
                const int row = u.pm * BM + ai * HALF + wr * 64 + m * 16 + fr;
                const float rs = rsqrtf(ssv[ai * 4 + m] * (1.f / DM) + EPS);
                const int pos = row & (SEQ - 1);
                f32x4 v[2][2];
#pragma unroll
                for (int bj = 0; bj < 2; ++bj)
#pragma unroll
                    for (int n = 0; n < 2; ++n) v[bj][n] = acc[ai][bj][m][n] * rs;
                bf16_t* dst; int c0, c1;
                if (t <= 4) {
                    if (fq == 0) {
#pragma unroll
                        for (int n = 0; n < 2; ++n) { const f32x4 cs = csv[r2][n], sn = snv[r2][n];
                            const f32x4 lo = v[0][n], hi = v[1][n]; v[0][n] = lo * cs - hi * sn; v[1][n] = hi * cs + lo * sn; }
                    }
                    if (t < 4) {
#pragma unroll
                        for (int bj = 0; bj < 2; ++bj)
#pragma unroll
                            for (int n = 0; n < 2; ++n) v[bj][n] = v[bj][n] * C2;
                        dst = QA; c0 = 256 * t + 64 * wc + 8 * fq; c1 = c0 + 32;
                    } else { dst = KV; c0 = 64 * wc + 8 * fq; c1 = c0 + 32; }
                } else if (t >= 7 && t < 11) {
                    const bool isq = t < 9; const int head = 4 * ((t - 7) & 1) + wc; const int c = pos & 127;
                    const float lg = __log2f(1.f - exp2f(-5.f - (float)head));
                    const float f = isq ? 0.125f * exp2f((float)c * lg) : exp2f(-(float)c * lg);
#pragma unroll
                    for (int n = 0; n < 2; ++n) { const f32x4 cs = csv[r2][n], sn = snv[r2][n];
                        const f32x4 lo = v[0][n], hi = v[1][n]; v[0][n] = (lo * cs - hi * sn) * f; v[1][n] = (hi * cs + lo * sn) * f; }
                    dst = QKR; c0 = (isq ? 0 : 512) + 256 * ((t - 7) & 1) + 64 * wc + 8 * fq; c1 = c0 + 32;
                } else {
                    const int cc = 32 * wc + 8 * fq;
                    if (t == 5 || t == 6) { dst = KV; c0 = 256 * (t - 4) + cc; }
                    else if (t < 15) { dst = VR; c0 = 256 * (t - 11) + cc; }
                    else if (t < 19) { dst = GR; c0 = 256 * (t - 15) + cc;
#pragma unroll
                        for (int bj = 0; bj < 2; ++bj)
#pragma unroll
                            for (int n = 0; n < 2; ++n)
#pragma unroll
                                for (int j = 0; j < 4; ++j) { const float x = v[bj][n][j]; v[bj][n][j] = x * sigmoidf_(x); }
                    } else { dst = KV; c0 = 768 + cc;
#pragma unroll
                        for (int bj = 0; bj < 2; ++bj)
#pragma unroll
                            for (int n = 0; n < 2; ++n)
#pragma unroll
                                for (int j = 0; j < 4; ++j) v[bj][n][j] = sigmoidf_(v[bj][n][j]);
                    }
                    c1 = c0 + 128;
                }
                st16(dst + (size_t)row * DM + c0, v[0][0], v[0][1]);
                st16(dst + (size_t)row * DM + c1, v[1][0], v[1][1]);
            }
          }
    }
};
struct EpiGate {
    bf16_t *GA_, *GR_; const float* ss;
    DI void operator()(const Acc& acc, const Unit& u, int wr, int wc, int fr, int fq) const {
        bf16_t* dst = u.pn < 4 ? GA_ : GR_; const int ct = (u.pn & 3) * BM;
        float ssv[8];
#pragma unroll
        for (int i = 0; i < 8; ++i) ssv[i] = ss[u.pm * BM + (i >> 2) * HALF + wr * 64 + (i & 3) * 16 + fr];
        __builtin_amdgcn_sched_barrier(0);
#pragma unroll
        for (int ai = 0; ai < 2; ++ai)
#pragma unroll
            for (int m = 0; m < 4; ++m) {
                const int row = u.pm * BM + ai * HALF + wr * 64 + m * 16 + fr;
                const float rs = rsqrtf(ssv[ai * 4 + m] * (1.f / DM) + EPS);
#pragma unroll
                for (int bj = 0; bj < 2; ++bj) { f32x4 o[2];
#pragma unroll
                    for (int n = 0; n < 2; ++n)
#pragma unroll
                        for (int j = 0; j < 4; ++j) o[n][j] = sigmoidf_(acc[ai][bj][m][n][j] * rs);
                    st16(dst + (size_t)row * DM + ct + bj * HALF + wc * 32 + fq * 8, o[0], o[1]); }
            }
    }
};
template <bool ADD> struct EpiMix {
    const bf16_t* G_; bf16_t* MIX;
    DI void operator()(const Acc& acc, const Unit& u, int wr, int wc, int fr, int fq) const {
#pragma unroll
        for (int ai = 0; ai < 2; ++ai) {
            u32x4 gv[4][2], pv[4][2];
#pragma unroll
            for (int m = 0; m < 4; ++m)
#pragma unroll
                for (int bj = 0; bj < 2; ++bj) { const size_t off = (size_t)(u.pm * BM + ai * HALF + wr * 64 + m * 16 + fr) * DM + u.pn * BM + bj * HALF + wc * 32 + fq * 8;
                    gv[m][bj] = *(const u32x4*)(G_ + off); pv[m][bj] = (u32x4){0u, 0u, 0u, 0u}; if (ADD) pv[m][bj] = *(const u32x4*)(MIX + off); }
            __builtin_amdgcn_sched_barrier(0);
#pragma unroll
            for (int m = 0; m < 4; ++m) {
                const int row = u.pm * BM + ai * HALF + wr * 64 + m * 16 + fr;
#pragma unroll
                for (int bj = 0; bj < 2; ++bj) {
                    const size_t off = (size_t)row * DM + u.pn * BM + bj * HALF + wc * 32 + fq * 8;
                    const u32x4 gw = gv[m][bj];
                    const u32x4 pw = pv[m][bj];
                    f32x4 o0, o1;
                    o0[0] = bflo(gw.x) * acc[ai][bj][m][0][0]; o0[1] = bfhi(gw.x) * acc[ai][bj][m][0][1]; o0[2] = bflo(gw.y) * acc[ai][bj][m][0][2]; o0[3] = bfhi(gw.y) * acc[ai][bj][m][0][3];
                    o1[0] = bflo(gw.z) * acc[ai][bj][m][1][0]; o1[1] = bfhi(gw.z) * acc[ai][bj][m][1][1]; o1[2] = bflo(gw.w) * acc[ai][bj][m][1][2]; o1[3] = bfhi(gw.w) * acc[ai][bj][m][1][3];
                    if (ADD) { o0[0] += bflo(pw.x); o0[1] += bfhi(pw.x); o0[2] += bflo(pw.y); o0[3] += bfhi(pw.y); o1[0] += bflo(pw.z); o1[1] += bfhi(pw.z); o1[2] += bflo(pw.w); o1[3] += bfhi(pw.w); }
                    st16(MIX + off, o0, o1);
                }
            }
        }
    }
};
}

struct Args { const float* in[21]; float* out; unsigned char* ws; int ph_lo, ph_hi; };

DI void tr_item(const float* W, int ldw, int K, bf16_t* WT, int drow0, int scol4, const float* ksc, int k0, LAS float* scr, int lane) {
    const int kq = lane >> 4, n4 = 4 * (lane & 15);
    f32x4 v[16];
#pragma unroll
    for (int i = 0; i < 16; ++i) v[i] = scol4 >= 0 ? *(const f32x4*)(W + (size_t)(k0 + 4 * i + kq) * ldw + scol4) : (f32x4){0.f, 0.f, 0.f, 0.f};
#pragma unroll
    for (int i = 0; i < 16; ++i) { LAS float* d = scr + (4 * i + kq) * 65 + n4; d[0] = v[i].x; d[1] = v[i].y; d[2] = v[i].z; d[3] = v[i].w; }
    asm volatile("s_waitcnt lgkmcnt(0)" ::: "memory");
    const int c = lane & 7, nl = lane >> 3;
    f32x4 s0 = (f32x4){1.f, 1.f, 1.f, 1.f}, s1 = s0;
    if (ksc) { s0 = *(const f32x4*)(ksc + k0 + 8 * c); s1 = *(const f32x4*)(ksc + k0 + 8 * c + 4); }
#pragma unroll
    for (int j = 0; j < 8; ++j) { const int n = nl + 8 * j; const LAS float* p = scr + (8 * c) * 65 + n;
        u32x4 o; o.x = pk2(p[0 * 65] * s0.x, p[1 * 65] * s0.y); o.y = pk2(p[2 * 65] * s0.z, p[3 * 65] * s0.w); o.z = pk2(p[4 * 65] * s1.x, p[5 * 65] * s1.y); o.w = pk2(p[6 * 65] * s1.z, p[7 * 65] * s1.w);
        *(u32x4*)(WT + (size_t)(drow0 + n) * K + k0 + 8 * c) = o; }
    asm volatile("s_waitcnt lgkmcnt(0)" ::: "memory");
}
DI int win_src(int nrow) {
    const int t = nrow >> 8, rr = nrow & 255, bj = rr >> 7, wc = (rr >> 5) & 3, c = rr & 31;
    if (t < 4) return (4 * t + wc) * 64 + ldim(32 * bj + c);
    if (t == 4) return (wc < 2 ? 1280 + wc * 64 : 1536 + (wc - 2) * 64) + ldim(32 * bj + c);
    if (t == 5) return rr < 128 ? 1024 + rr : 1152 + rr - 128;
    if (t == 6) return rr < 128 ? 1408 + rr : 1664 + rr - 128;
    if (t < 9) return 1840 + (4 * (t - 7) + wc) * 64 + 32 * bj + c;
    if (t < 11) return 2352 + (4 * (t - 9) + wc) * 64 + 32 * bj + c;
    if (t < 15) return 2864 + (t - 11) * 256 + rr;
    if (t < 19) return 3888 + (t - 15) * 256 + rr;
    return rr < 48 ? 1792 + rr : -1;
}
template <int SET>
DI void prep_transposes(const Args& a, LAS unsigned char* lds, int gw, int NGW, int wave, int lane) {
    unsigned char* ws = a.ws;
    LAS float* scr = (LAS float*)(lds + wave * 18432);
    constexpr int I0 = (5632 / 64) * 16, I1 = (1024 / 64) * (2816 / 64), I2 = (5120 / 64) * 16, I3 = (2048 / 64) * 16, I4 = 16 * 16, I9 = 4 * 32, I11 = 4;
    constexpr int NIT = SET == 0 ? I0 + I1 + I2 + I3 + 2 * I9 + 2 * I11 : I0 + I1 + 3 * I4;
    constexpr int L = SET;
    const int l4 = 4 * (lane & 15);
    for (int it = gw; it < NIT; it += NGW) {
        int r = it;
        if (r < I0) { const int nb = r / 16, kb = r % 16, nrow = nb * 64 + l4; const int tile = nrow >> 8, rr = nrow & 255;
            tr_item(a.in[(rr >> 7) ? (L ? 18 : 3) : (L ? 17 : 2)], FF, DM, (bf16_t*)(ws + (L ? WS_WGU2 : WS_WGU1)), nb * 64, 128 * tile + (rr & 127), a.in[L ? 16 : 1], kb * 64, scr, lane); continue; } r -= I0;
        if (r < I1) { const int nb = r / 44, kb = r % 44;
            tr_item(a.in[L ? 19 : 4], DM, FF, (bf16_t*)(ws + (L ? WS_WD2 : WS_WD1)), nb * 64, nb * 64 + l4, nullptr, kb * 64, scr, lane); continue; } r -= I1;
        if (SET == 1) { const int w = r / I4; r -= w * I4; const int nb = r / 16, kb = r % 16;
            tr_item(a.in[13 + w], DM, DM, (bf16_t*)(ws + (w == 0 ? WS_WN : (w == 1 ? WS_WR : WS_WO))), nb * 64, nb * 64 + l4, nullptr, kb * 64, scr, lane); continue; }
        if (r < I2) { const int nb = r / 16, kb = r % 16; tr_item(a.in[6], DIN, DM, (bf16_t*)(ws + WS_WIN), nb * 64, win_src(nb * 64 + l4), a.in[5], kb * 64, scr, lane); continue; } r -= I2;
        if (r < I3) { const int nb = r / 16, kb = r % 16; tr_item(a.in[6], DIN, DM, (bf16_t*)(ws + WS_WGM), nb * 64, 4912 + nb * 64 + l4, a.in[5], kb * 64, scr, lane); continue; } r -= I3;
        if (r < 2 * I9) { const int w = r / I9; r -= w * I9; const int nb = r / 32, kb = r % 32;
            tr_item(a.in[w ? 10 : 8], 256, 2048, (bf16_t*)(ws + (w ? WS_W1V : WS_W1K)), nb * 64, nb * 64 + l4, nullptr, kb * 64, scr, lane); continue; } r -= 2 * I9;
        { const int w = r / I11; r -= w * I11; const int kb = r;
            tr_item(a.in[w ? 11 : 9], 64, 256, (bf16_t*)(ws + (w ? WS_W2V : WS_W2K)), 0, w ? l4 : ldim(l4), nullptr, kb * 64, scr, lane); }
    }
}
DI void phase_prep(const Args& a, LAS unsigned char* lds, int gw, int NGW, int wave, int lane) {
    unsigned char* ws = a.ws;
    prep_transposes<0>(a, lds, gw, NGW, wave, lane);
    const float* x = a.in[0]; bf16_t* xb = (bf16_t*)(ws + WS_XB); float* ss1 = (float*)(ws + WS_SS1);
    for (int m0 = gw; m0 < T; m0 += 2 * NGW) {
        const int m1 = m0 + NGW;
        const bool two = m1 < T;
        const f32x4* xr0 = (const f32x4*)(x + (size_t)m0 * DM) + lane; const f32x4* xr1 = (const f32x4*)(x + (size_t)(two ? m1 : m0) * DM) + lane;
        f32x4 v0[4], v1[4]; float s0 = 0.f, s1 = 0.f;
#pragma unroll
        for (int j = 0; j < 4; ++j) { v0[j] = xr0[64 * j]; v1[j] = xr1[64 * j]; }
#pragma unroll
        for (int j = 0; j < 4; ++j) { s0 += (v0[j].x * v0[j].x + v0[j].y * v0[j].y) + (v0[j].z * v0[j].z + v0[j].w * v0[j].w); s1 += (v1[j].x * v1[j].x + v1[j].y * v1[j].y) + (v1[j].z * v1[j].z + v1[j].w * v1[j].w); }
        s0 = wave_sum(s0); s1 = wave_sum(s1);
        u32x2* o0 = (u32x2*)(xb + (size_t)m0 * DM) + lane; u32x2* o1 = (u32x2*)(xb + (size_t)m1 * DM) + lane;
#pragma unroll
        for (int j = 0; j < 4; ++j) { o0[64 * j] = (u32x2){pk2(v0[j].x, v0[j].y), pk2(v0[j].z, v0[j].w)}; if (two) o1[64 * j] = (u32x2){pk2(v1[j].x, v1[j].y), pk2(v1[j].z, v1[j].w)}; }
        if (lane == 0) { ss1[m0] = s0; ((float*)(ws + WS_SS2))[m0] = 0.f; ((float*)(ws + WS_SS3))[m0] = 0.f;
            if (two) { ss1[m1] = s1; ((float*)(ws + WS_SS2))[m1] = 0.f; ((float*)(ws + WS_SS3))[m1] = 0.f; } }
    }
    const int gt = gw * 64 + lane, NGT = NGW * 64;
    for (int e = gt; e < SEQ * 8; e += NGT) { const int pos = e >> 3, i = e & 7; const float fr = powf(500000.0f, -(float)i * 2.0f / 16.0f); const float ang = (float)pos * fr;
        ((float*)(ws + WS_COSN))[e] = cosf(ang); ((float*)(ws + WS_SINN))[e] = sinf(ang); }
    for (int e = gt; e < SEQ * 32; e += NGT) { const int pos = e >> 5, i = e & 31; const float fr = powf(10000.0f, -(float)i * 2.0f / 64.0f); const float ang = (float)pos * fr;
        ((float*)(ws + WS_COSR))[e] = cosf(ang); ((float*)(ws + WS_SINR))[e] = sinf(ang); }
    for (int o = gw; o < 256; o += NGW) { const int w = o >> 7, jg = (o >> 5) & 3, kc = o & 31; const float* W1 = a.in[w ? 10 : 8]; const float* pe = a.in[7]; float s = 0.f;
#pragma unroll 16
        for (int k = 0; k < 64; ++k) s += pe[kc * 64 + k] * W1[(size_t)(kc * 64 + k) * 256 + jg * 64 + lane];
        ((float*)(ws + WS_BPART))[(w * 32 + kc) * 256 + jg * 64 + lane] = s; }
    for (int e = gt; e < 2 * 8 * 64; e += NGT) { const int w = e >> 9, bg = (e >> 6) & 7, d = e & 63; ((bf16_t*)(ws + (w ? WS_VC : WS_KC)))[(bg * 256 + 255) * 64 + d] = 0; }
}

DI float gelu_tanh(float x) { const float u = 0.7978845608028654f * (x + 0.044715f * x * x * x); const float e = __expf(2.f * u); const float th = 1.f - 2.f * __builtin_amdgcn_rcpf(e + 1.f); return 0.5f * x * (1.f + th); }
DI void compress_item(const Args& a, LAS unsigned char* lds, int item, int tid, int wave, int lane) {
    unsigned char* ws = a.ws; const int r32 = lane & 31, hi = lane >> 5;
    const int mt = item & 63, kv = item >> 6;
    const bf16_t* KV = (const bf16_t*)(ws + WS_KV);
    const bf16_t* W1T = (const bf16_t*)(ws + (kv ? WS_W1V : WS_W1K)); const bf16_t* W2T = (const bf16_t*)(ws + (kv ? WS_W2V : WS_W2K));
    int m = mt * 32 + r32; if (m > 2039) m = 2039;
    const int bg = m / 255, nc = m % 255, b = bg >> 1, g = bg & 1;
    __syncthreads();
#pragma unroll
    for (int i = 0; i < 16; ++i) {
        const int e = i * 512 + tid, seg = e >> 3, ch = e & 7, mrow = seg >> 5, l = seg & 31;
        int m3 = mt * 32 + mrow; if (m3 > 2039) m3 = 2039;
        const int bg3 = m3 / 255, nc3 = m3 % 255;
        const u32x4 v = *(const u32x4*)(KV + (size_t)((bg3 >> 1) * SEQ + nc3 * 16 + l) * DM + 256 + kv * 128 + (bg3 & 1) * 64 + 8 * ch);
        *(LAS u32x4*)(lds + mrow * 4112 + l * 128 + ch * 16) = v;
    }
    const bf16_t* wsrc = W1T + (size_t)(32 * wave + r32) * 2048 + 8 * hi;
    const LAS unsigned char* bsrc = lds + r32 * 4112 + 16 * hi;
    __syncthreads();
    f32x16 h = {};
#pragma unroll 1
    for (int s0 = 0; s0 < 128; s0 += 16) {
        bf16x8 af[16], bfr[16];
#pragma unroll
        for (int j = 0; j < 16; ++j) af[j] = *(const bf16x8*)(wsrc + 16 * (s0 + j));
#pragma unroll
        for (int j = 0; j < 16; ++j) bfr[j] = *(const LAS bf16x8*)(bsrc + 32 * (s0 + j));
        __builtin_amdgcn_sched_barrier(0);
#pragma unroll
        for (int j = 0; j < 16; ++j) h = MFMA32(af[j], bfr[j], h);
    }
    LAS float* red = (LAS float*)lds;
    LAS float* biasL = (LAS float*)(lds + 65536);
    __syncthreads();
    if (tid < 256) { const float* bp = (const float*)(ws + WS_BPART) + kv * 32 * 256 + tid; float b = 0.f;
#pragma unroll
        for (int c = 0; c < 32; ++c) b += bp[c * 256];
        biasL[tid] = b; }
    __syncthreads();
#pragma unroll
    for (int i = 0; i < 16; ++i) h[i] = gelu_tanh(h[i] + biasL[32 * wave + crow(i, hi)]);
#pragma unroll
    for (int dt = 0; dt < 2; ++dt) {
        f32x16 o = {};
#pragma unroll
        for (int ks = 0; ks < 2; ++ks) {
            const bf16_t* wp = W2T + (size_t)(32 * dt + r32) * 256 + 32 * wave + 16 * ks + 4 * hi;
            const s16x4 lo = *(const s16x4*)wp, hh = *(const s16x4*)(wp + 8);
            o = MFMA32(cat8(lo, hh), pack8(h, ks), o);
        }
#pragma unroll
        for (int i = 0; i < 16; ++i) red[(wave * 64 + 32 * dt + crow(i, hi)) * 32 + r32] = o[i];
    }
    __syncthreads();
    {
        const int mm = tid & 31, dq = tid >> 5; const int d0 = 4 * dq;
        float s[4] = {0.f, 0.f, 0.f, 0.f}, ps[4] = {0.f, 0.f, 0.f, 0.f};
        const bool rot = (kv == 0) && (dq < 2 || dq == 8 || dq == 9);
#pragma unroll
        for (int w = 0; w < 8; ++w)
#pragma unroll
            for (int j = 0; j < 4; ++j) { s[j] += red[(w * 64 + d0 + j) * 32 + mm]; ps[j] += red[(w * 64 + ((d0 + j) ^ 32)) * 32 + mm]; }
        const int m2 = mt * 32 + mm;
        if (m2 < 2040) {
            const int bg2 = m2 / 255, nc2 = m2 % 255;
            if (rot) { const int pos = 16 * nc2 + 31; const float* cs = (const float*)(ws + WS_COSN) + pos * 8; const float* sn = (const float*)(ws + WS_SINN) + pos * 8;
#pragma unroll
                for (int j = 0; j < 4; ++j) { const int i = (d0 + j) & 7; s[j] = (d0 < 8) ? s[j] * cs[i] - ps[j] * sn[i] : s[j] * cs[i] + ps[j] * sn[i]; } }
            bf16_t* dst = (bf16_t*)(ws + (kv ? WS_VC : WS_KC)) + (size_t)(bg2 * 256 + nc2) * 64 + d0;
            *(u32x2*)dst = (u32x2){pk2(s[0], s[1]), pk2(s[2], s[3])};
        }
    }
    __syncthreads();
}

DI void retstate_item(const Args& a, LAS unsigned char* lds, int item, int tid, int wave, int lane) {
    unsigned char* ws = a.ws; const int r32 = lane & 31, hi = lane >> 5;
    const int bh = item >> 2, dvs = item & 3, b = bh >> 3, h = bh & 7;
    const bf16_t* Kp = (const bf16_t*)(ws + WS_QKR) + (size_t)b * SEQ * DM + 512 + 64 * h;
    const bf16_t* Vp = (const bf16_t*)(ws + WS_VR) + (size_t)b * SEQ * DM + 128 * h + 32 * dvs;
    bf16_t* Rp = (bf16_t*)(ws + WS_RP) + (size_t)bh * 32 * 8192;
    const float lg = __log2f(1.f - exp2f(-5.f - (float)h));
    const float g127 = exp2f(127.f * lg), g128 = exp2f(128.f * lg);
    struct RS { u32x4 k0, k1, v; };
    auto gload = [&](RS& r, int n) __attribute__((always_inline)) {
        { const int e = tid, row = e >> 3, ch = e & 7; r.k0 = *(const u32x4*)(Kp + (size_t)(n * 128 + row) * DM + 8 * ch); }
        { const int e = tid + 512, row = e >> 3, ch = e & 7; r.k1 = *(const u32x4*)(Kp + (size_t)(n * 128 + row) * DM + 8 * ch); }
        { const int row = tid >> 2, ch = tid & 3; r.v = *(const u32x4*)(Vp + (size_t)(n * 128 + row) * DM + 8 * ch); }
    };
    auto lwrite = [&](const RS& r, int buf) __attribute__((always_inline)) {
        LAS unsigned char* kb = lds + buf * 24576; LAS unsigned char* vb = kb + 16384;
        { const int e = tid, row = e >> 3, ch = e & 7; *(LAS u32x4*)(kb + ((ch >> 2) * 8 + (row >> 4)) * 1024 + (row & 15) * 64 + (ch & 3) * 16) = r.k0; }
        { const int e = tid + 512, row = e >> 3, ch = e & 7; *(LAS u32x4*)(kb + ((ch >> 2) * 8 + (row >> 4)) * 1024 + (row & 15) * 64 + (ch & 3) * 16) = r.k1; }
        { const int row = tid >> 2, ch = tid & 3; *(LAS u32x4*)(vb + (row >> 4) * 1024 + (row & 15) * 64 + ch * 16) = r.v; }
    };
    f32x16 R = {};
    const int troff = ((lane >> 4) & 1) * 32 + (lane & 3) * 8 + (4 * hi + ((lane & 15) >> 2)) * 64;
    auto body = [&](RS& r, const int n) __attribute__((always_inline)) {
        const int buf = n & 1;
        lwrite(r, buf);
        if (n + 4 < 32) gload(r, n + 4);
        __syncthreads();
        if (wave < 2) {
            bf16_t* rp = Rp + (size_t)n * 8192 + (size_t)(32 * dvs + r32) * 64 + 32 * wave + 4 * hi;
#pragma unroll
            for (int q = 0; q < 4; ++q) *(u32x2*)(rp + 8 * q) = (u32x2){pk2(R[4 * q], R[4 * q + 1]), pk2(R[4 * q + 2], R[4 * q + 3])};
            const LAS char* kb = (const LAS char*)(lds + buf * 24576) + troff; const LAS char* vb = (const LAS char*)(lds + buf * 24576 + 16384) + troff;
            f32x16 kvn = {};
#pragma unroll
            for (int ks = 0; ks < 8; ++ks) {
                const bf16x8 af = cat8(vtr(kb + (wave * 8 + ks) * 1024), vtr(kb + (wave * 8 + ks) * 1024 + 512));
                const bf16x8 bfv = cat8(vtr(vb + ks * 1024), vtr(vb + ks * 1024 + 512));
                kvn = MFMA32(af, bfv, kvn);
            }
#pragma unroll
            for (int i = 0; i < 16; ++i) R[i] = g128 * R[i] + g127 * kvn[i];
        }
    };
    RS r0, r1, r2, r3;
    __syncthreads();
    gload(r0, 0); gload(r1, 1); gload(r2, 2); gload(r3, 3);
#pragma unroll 1
    for (int n = 0; n < 32; n += 4) { body(r0, n); body(r1, n + 1); body(r2, n + 2); body(r3, n + 3); }
    __syncthreads();
}

constexpr int AT_K = 0, AT_V = 16384, AT_IMP = 32768, AT_SLAB = 64 * 33, AT_SEL = 32768 + 8 * AT_SLAB * 4;
struct TileRegs { u32x4 k, v; };
DI void at_gload(TileRegs& r, const bf16_t* Kb, const bf16_t* Vb, int pitch, int kt, int wave, int lane) {
    r.k = *(const u32x4*)(Kb + (size_t)(kt * 64 + lane) * pitch + wave * 8);
    r.v = *(const u32x4*)(Vb + (size_t)(kt * 64 + 16 * (wave & 3) + (lane >> 2)) * pitch + (wave >> 2) * 32 + (lane & 3) * 8);
}
DI void at_lwrite(const TileRegs& r, LAS unsigned char* lds, int buf, int wave, int lane) {
    *(LAS u32x4*)(lds + AT_K + buf * 8192 + wave * 1024 + lane * 16) = r.k;
    *(LAS u32x4*)(lds + AT_V + buf * 8192 + wave * 1024 + lane * 16) = r.v;
}
DI void at_qk(f32x16& p0, f32x16& p1, const LAS unsigned char* kslot, const bf16x8* qr, const f32x16& cinit, int r32, int hi) {
    const LAS unsigned char* kb = kslot + hi * 1024 + r32 * 16;
#pragma unroll
    for (int d0 = 0; d0 < 4; ++d0) {
        const bf16x8 b0 = *(const LAS bf16x8*)(kb + d0 * 2048), b1 = *(const LAS bf16x8*)(kb + d0 * 2048 + 512);
        if (d0 == 0) { p0 = MFMA32(b0, qr[0], cinit); p1 = MFMA32(b1, qr[0], cinit); }
        else { p0 = MFMA32(b0, qr[d0], p0); p1 = MFMA32(b1, qr[d0], p1); }
    }
}
DI void at_pv(f32x16* o, const LAS unsigned char* vslot, const f32x16& p0, const f32x16& p1, int lane, int hi) {
    const LAS char* vp = (const LAS char*)vslot + ((lane >> 4) & 1) * 32 + (lane & 3) * 8 + (4 * hi + ((lane & 15) >> 2)) * 64;
    const bf16x8 pa[4] = {pack8(p0, 0), pack8(p0, 1), pack8(p1, 0), pack8(p1, 1)};
#pragma unroll
    for (int dt = 0; dt < 2; ++dt)
#pragma unroll
        for (int ks = 0; ks < 4; ++ks) {
            const bf16x8 vf = cat8(vtr(vp + dt * 4096 + ks * 1024), vtr(vp + dt * 4096 + ks * 1024 + 512));
            o[dt] = MFMA32(vf, pa[ks], o[dt]);
        }
}
DI void at_pv2(f32x16* o, const s16x4* vl, const s16x4* vh, const f32x16& p0, const f32x16& p1) {
    const bf16x8 pa[4] = {pack8(p0, 0), pack8(p0, 1), pack8(p1, 0), pack8(p1, 1)};
    __builtin_amdgcn_sched_barrier(0);
#pragma unroll
    for (int ks = 0; ks < 4; ++ks) { o[0] = MFMA32(cat8(vl[ks], vh[ks]), pa[ks], o[0]); o[1] = MFMA32(cat8(vl[4 + ks], vh[4 + ks]), pa[ks], o[1]); }
}
DI float max32(const f32x16& p0, const f32x16& p1) {
    float a = fmaxf(fmaxf(p0[0], p0[1]), p1[0]), b = fmaxf(fmaxf(p0[2], p0[3]), p1[1]); a = fmaxf(fmaxf(a, p1[2]), p1[3]);
#pragma unroll
    for (int i = 4; i < 16; i += 4) { a = fmaxf(fmaxf(a, p0[i]), p0[i + 1]); b = fmaxf(fmaxf(b, p0[i + 2]), p0[i + 3]); a = fmaxf(fmaxf(a, p1[i]), p1[i + 1]); b = fmaxf(fmaxf(b, p1[i + 2]), p1[i + 3]); }
    const float mx = fmaxf(a, b);
    return xmax(mx);
}
DI float sum32(const f32x16& p0, const f32x16& p1) {
    const f32x16 sv = p0 + p1;
    const float a = (sv[0] + sv[1]) + (sv[2] + sv[3]), b = (sv[4] + sv[5]) + (sv[6] + sv[7]), c = (sv[8] + sv[9]) + (sv[10] + sv[11]), d = (sv[12] + sv[13]) + (sv[14] + sv[15]);
    const float t = (a + b) + (c + d);
    return xsum(t);
}
#ifndef PEXP
#define PEXP 7
#endif
template <int MODE, int EXP = 0>
DI void at_loop(LAS unsigned char* lds, const bf16_t* Kb, const bf16_t* Vb, int pitch, int first, int last, const bf16x8* qr, f32x16* o, float& mrun, float& lrun,
                int t0, unsigned long long selm, int tid, int wave, int lane, TileRegs& trA) {
    const int r32 = lane & 31, hi = lane >> 5; const int t = t0 + r32;
    const float NINF = -__builtin_inff(); constexpr float THR = 8.f;
    __syncthreads();
    float cref = -mrun; if (MODE == 1) cref = lrun > 0.f ? -(mrun + __log2f(lrun)) : 0.f;
    float carry = 0.f;
    auto step = [&](const int kt, TileRegs& tr, const int buf) __attribute__((always_inline)) {
        if (EXP != 3) at_lwrite(tr, lds, buf, wave, lane);
        if (kt + 1 <= last) at_gload(tr, Kb, Vb, pitch, kt + 1, wave, lane);
        if (EXP != 3) __syncthreads();
        f32x16 p0, p1;
        {
            float c = cref; if (MODE == 2) { const bool sel = (selm >> kt) & 1ull; c = sel ? cref : NINF; }
            f32x16 ci;
#pragma unroll
            for (int i = 0; i < 16; ++i) ci[i] = c;
            const LAS unsigned char* kb = lds + AT_K + buf * 8192 + hi * 1024 + r32 * 16;
            bf16x8 kf[8];
#pragma unroll
            for (int d0 = 0; d0 < 4; ++d0) { kf[2 * d0] = *(const LAS bf16x8*)(kb + d0 * 2048); kf[2 * d0 + 1] = *(const LAS bf16x8*)(kb + d0 * 2048 + 512); }
            __builtin_amdgcn_sched_barrier(0);
            if (EXP == 4) { p0 = ci; p1 = ci; p0[0] += __builtin_bit_cast(float, (int)kf[0][0] + (int)kf[7][3]); } else {
            p0 = MFMA32(kf[0], qr[0], ci); p1 = MFMA32(kf[1], qr[0], ci);
#pragma unroll
            for (int d0 = 1; d0 < 4; ++d0) { p0 = MFMA32(kf[2 * d0], qr[d0], p0); p1 = MFMA32(kf[2 * d0 + 1], qr[d0], p1); } }
            __builtin_amdgcn_sched_barrier(0);
        }
        s16x4 vl[8], vh[8];
        if (MODE != 0 && EXP != 2) {
            const LAS char* vp = (const LAS char*)(lds + AT_V + buf * 8192) + ((lane >> 4) & 1) * 32 + (lane & 3) * 8 + (4 * hi + ((lane & 15) >> 2)) * 64;
#pragma unroll
            for (int i = 0; i < 8; ++i) { vl[i] = vtr(vp + (i >> 2) * 4096 + (i & 3) * 1024); vh[i] = vtr(vp + (i >> 2) * 4096 + (i & 3) * 1024 + 512); }
            __builtin_amdgcn_sched_barrier(0);
        }
        if (MODE <= 1) {
            if (16 * (64 * kt + 63) + 31 > t0) {
#pragma unroll
                for (int i = 0; i < 16; ++i) { const int n0 = 64 * kt + crow(i, hi); if (16 * n0 + 31 > t) p0[i] = NINF; if (16 * (n0 + 32) + 31 > t) p1[i] = NINF; }
            }
        } else if (MODE == 2) {
            if (kt == last) {
#pragma unroll
                for (int i = 0; i < 16; ++i) { const int k0 = 64 * kt + crow(i, hi); if (k0 > t) p0[i] = NINF; if (k0 + 32 > t) p1[i] = NINF; }
            }
        } else {
            if (kt == last || 64 * kt + 512 <= t0 + 31) {
#pragma unroll
                for (int i = 0; i < 16; ++i) { const int k0 = 64 * kt + crow(i, hi); if (k0 > t || t - k0 >= 512) p0[i] = NINF; if (k0 + 32 > t || t - k0 - 32 >= 512) p1[i] = NINF; }
            }
        }
        if (MODE == 1) {
#pragma unroll
            for (int i = 0; i < 16; ++i) { p0[i] = __builtin_amdgcn_exp2f(p0[i]); p1[i] = __builtin_amdgcn_exp2f(p1[i]); }
            LAS float* slab = (LAS float*)(lds + AT_IMP) + wave * AT_SLAB + r32;
            float av[2][4], rb[2][4];
#pragma unroll
            for (int hf = 0; hf < 2; ++hf)
#pragma unroll
                for (int gq = 0; gq < 4; ++gq) {
                    const f32x16& x = hf ? p1 : p0;
                    const float bb = 0.5f * x[4 * gq + 3]; av[hf][gq] = x[4 * gq] + x[4 * gq + 1] + x[4 * gq + 2] + bb; rb[hf][gq] = xhalf(bb);
                }
#pragma unroll
            for (int hf = 0; hf < 2; ++hf)
#pragma unroll
                for (int gq = 0; gq < 4; ++gq) {
                    const float prevrb = gq > 0 ? rb[hf][gq - 1] : (hf == 1 ? rb[0][3] : carry);
                    const int s = 16 * kt + 8 * hf + 2 * gq + hi;
                    slab[s * 33] = av[hf][gq] + (hi ? rb[hf][gq] : prevrb);
                }
            carry = rb[1][3];
            at_pv2(o, vl, vh, p0, p1);
        } else {
            const float tm = max32(p0, p1);
            const bool mv = (tm > THR) || (lrun == 0.f && tm > NINF);
            if (__any(mv)) {
                const float d = mv ? tm : 0.f;
                const float alpha = (lrun == 0.f) ? 1.f : __builtin_amdgcn_exp2f(-d);
                mrun += d; lrun *= alpha;
#pragma unroll
                for (int i = 0; i < 16; ++i) { p0[i] -= d; p1[i] -= d; }
                cref = -mrun;
                if (MODE != 0) {
#pragma unroll
                    for (int i = 0; i < 16; ++i) { o[0][i] *= alpha; o[1][i] *= alpha; }
                }
            }
            if (MODE == 0) {
#pragma unroll
                for (int i = 0; i < 16; ++i) { p0[i] = __builtin_amdgcn_exp2f(p0[i]); p1[i] = __builtin_amdgcn_exp2f(p1[i]); }
                lrun += sum32(p0, p1);
            } else {
                float ls[4];
#pragma unroll
                for (int ks = 0; ks < 4; ++ks) {
                    f32x16& x = (ks < 2) ? p0 : p1; const int r0 = 8 * (ks & 1);
#pragma unroll
                    for (int i = 0; i < 8; ++i) x[r0 + i] = __builtin_amdgcn_exp2f(x[r0 + i]);
                    ls[ks] = ((x[r0] + x[r0 + 1]) + (x[r0 + 2] + x[r0 + 3])) + ((x[r0 + 4] + x[r0 + 5]) + (x[r0 + 6] + x[r0 + 7]));
                    const bf16x8 pa = pack8(x, ks & 1);
                    o[0] = MFMA32(cat8(vl[ks], vh[ks]), pa, o[0]); o[1] = MFMA32(cat8(vl[4 + ks], vh[4 + ks]), pa, o[1]);
                }
                lrun += xsum((ls[0] + ls[1]) + (ls[2] + ls[3]));
            }
        }
    };
    for (int kt = first; kt <= last; kt += 2) {
        step(kt, trA, 0);
        if (kt + 1 <= last) step(kt + 1, trA, 1);
    }
}
template <bool ADD> DI void nsa_accum(bf16_t* aout, const f32x16* o, float f) {
    u32x2 wv[8];
    if (ADD) {
#pragma unroll
        for (int i = 0; i < 8; ++i) wv[i] = *(const u32x2*)(aout + 32 * (i >> 2) + 8 * (i & 3));
        __builtin_amdgcn_sched_barrier(0);
    }
#pragma unroll
    for (int dt = 0; dt < 2; ++dt)
#pragma unroll
        for (int q = 0; q < 4; ++q) {
            u32x2* p = (u32x2*)(aout + 32 * dt + 8 * q);
            float v0 = f * o[dt][4 * q], v1 = f * o[dt][4 * q + 1], v2 = f * o[dt][4 * q + 2], v3 = f * o[dt][4 * q + 3];
            if (ADD) { const u32x2 w = wv[dt * 4 + q]; v0 += bflo(w.x); v1 += bfhi(w.x); v2 += bflo(w.y); v3 += bfhi(w.y); }
            *p = (u32x2){pk2(v0, v1), pk2(v2, v3)};
        }
}
template <int EXP = 0> DI void nsa_item(const Args& a, LAS unsigned char* lds, int item, int tid, int wave, int lane, bool dry = false) {
    unsigned char* ws = a.ws; const int r32 = lane & 31, hi = lane >> 5;
    const int bg = item >> 7, qt = item & 127, b = bg >> 1, g = bg & 1; const int t0 = qt * 32, cur = t0 >> 6;
    bf16_t* QA = (bf16_t*)(ws + WS_QA); const bf16_t* KV = (const bf16_t*)(ws + WS_KV);
    const size_t tokrow = (size_t)(b * SEQ + t0 + r32) * DM; const int head = g * 8 + wave;
    bf16x8 qr[4];
#pragma unroll
    for (int d0 = 0; d0 < 4; ++d0) qr[d0] = *(const bf16x8*)(QA + tokrow + head * 64 + 16 * d0 + 8 * hi);
    float gate[3];
#pragma unroll
    for (int j = 0; j < 3; ++j) gate[j] = bf2f(KV[tokrow + 768 + head * 3 + j]);
    { LAS float* z = (LAS float*)(lds + AT_IMP) + wave * AT_SLAB;
#pragma unroll
      for (int i = 0; i < 33; ++i) z[lane + 64 * i] = 0.f; }
    f32x16 o[2];
    bf16_t* aout = QA + tokrow + head * 64 + 4 * hi;
    const bf16_t* KC = (const bf16_t*)(ws + WS_KC) + (size_t)bg * 256 * 64; const bf16_t* VC = (const bf16_t*)(ws + WS_VC) + (size_t)bg * 256 * 64;
    const int lastc = (t0 >> 4) >> 6;
    float mrun = 0.f, lrun = 0.f;
    TileRegs tr0;
    at_gload(tr0, KC, VC, 64, 0, wave, lane);
    if (EXP != 7) at_loop<0>(lds, KC, VC, 64, 0, lastc, qr, o, mrun, lrun, t0, 0ull, tid, wave, lane, tr0);
    o[0] = (f32x16){}; o[1] = (f32x16){};
    at_gload(tr0, KC, VC, 64, 0, wave, lane);
    if (EXP != 7 && EXP != 8) at_loop<1>(lds, KC, VC, 64, 0, lastc, qr, o, mrun, lrun, t0, 0ull, tid, wave, lane, tr0);
    const bf16_t* Ks = KV + (size_t)b * SEQ * DM + 64 * g; const bf16_t* Vs = KV + (size_t)b * SEQ * DM + 512 + 64 * g;
    at_gload(tr0, Ks, Vs, DM, 0, wave, lane);
    if (!(dry && a.ph_lo != 12345)) nsa_accum<false>(aout, o, gate[0]);
    __syncthreads();
    if (EXP >= 6) { if (lane == 0) { for (int qi = 0; qi < 4; ++qi) *(LAS unsigned long long*)(lds + AT_SEL + (4 * wave + qi) * 8) = ~0ull; } }
    else {
        const LAS float* imp = (const LAS float*)(lds + AT_IMP);
#pragma unroll 1
        for (int qi = 0; qi < 4; ++qi) {
            const int q = 4 * wave + qi; float v = 0.f;
#pragma unroll
            for (int w = 0; w < 8; ++w) v += imp[w * AT_SLAB + lane * 33 + q];
            const int s = lane;
            if (s == 0 || s == cur || s == cur - 1) v = 1.0e4f; else if (s > cur) v = -1.0e4f;
            typedef unsigned long long u64x2_t __attribute__((ext_vector_type(2)));
            const unsigned vb = __builtin_bit_cast(unsigned, v); const unsigned key = (vb >> 31) ? ~vb : (vb | 0x80000000u);
            const unsigned long long K = ((unsigned long long)key << 32) | (unsigned)(63 - lane);
            LAS unsigned long long* tk = (LAS unsigned long long*)(lds + AT_SEL + 256) + wave * 64;
            tk[lane] = K;
            u64x2_t rr[32];
#pragma unroll
            for (int j = 0; j < 32; ++j) rr[j] = *(const LAS u64x2_t*)(tk + 2 * j);
            int rank = 0;
#pragma unroll
            for (int j = 0; j < 32; ++j) { rank += (rr[j].x > K) ? 1 : 0; rank += (rr[j].y > K) ? 1 : 0; }
            const unsigned long long mk = __ballot(rank < 16 && s <= cur);
            if (lane == 0) *(LAS unsigned long long*)(lds + AT_SEL + q * 8) = mk;
        }
    }
    __syncthreads();
    const unsigned long long selm = *(const LAS unsigned long long*)(lds + AT_SEL + r32 * 8);
    const bf16_t* Kw = KV + (size_t)b * SEQ * DM + 128 + 64 * g; const bf16_t* Vw = KV + (size_t)b * SEQ * DM + 640 + 64 * g;
    const int firstw = t0 >= 511 ? (t0 - 511) >> 6 : 0;
    {
        mrun = 0.f; lrun = 0.f; o[0] = (f32x16){}; o[1] = (f32x16){};
        if (EXP < 5) at_loop<2, EXP>(lds, Ks, Vs, DM, 0, cur, qr, o, mrun, lrun, t0, selm, tid, wave, lane, tr0);
        const float f = gate[1] * (lrun > 0.f ? 1.f / lrun : 0.f);
        at_gload(tr0, Kw, Vw, DM, firstw, wave, lane);
        if (!(dry && a.ph_lo != 12345)) nsa_accum<true>(aout, o, f);
    }
    {
        mrun = 0.f; lrun = 0.f; o[0] = (f32x16){}; o[1] = (f32x16){};
        if (EXP < 5) at_loop<3, EXP>(lds, Kw, Vw, DM, firstw, cur, qr, o, mrun, lrun, t0, 0ull, tid, wave, lane, tr0);
        const float f = gate[2] * (lrun > 0.f ? 1.f / lrun : 0.f);
        if (!(dry && a.ph_lo != 12345)) nsa_accum<true>(aout, o, f);
    }
}

DI void retout_item(const Args& a, LAS unsigned char* lds, int item, int tid, int wave, int lane, bool dry = false) {
    unsigned char* ws = a.ws; const int r32 = lane & 31, hi = lane >> 5;
    const int half = wave >> 2, ww = wave & 3, tl = tid & 255;
    const int chunk = item * 2 + half;
    const int bh = chunk >> 5, n = chunk & 31, b = bh >> 3, h = bh & 7;
    const size_t row0 = (size_t)b * SEQ + n * 128;
    const bf16_t* QKR = (const bf16_t*)(ws + WS_QKR); bf16_t* VR = (bf16_t*)(ws + WS_VR); const bf16_t* GR = (const bf16_t*)(ws + WS_GR);
    const bf16_t* Rp = (const bf16_t*)(ws + WS_RP) + (size_t)chunk * 8192;
    LAS unsigned char* vimg = lds + half * 32768;
    __syncthreads();
    { u32x4 vv[8];
#pragma unroll
      for (int it = 0; it < 8; ++it) { const int e = it * 256 + tl, key = e >> 4, ch = e & 15; vv[it] = *(const u32x4*)(VR + (row0 + key) * DM + 128 * h + 8 * ch); }
      __builtin_amdgcn_sched_barrier(0);
#pragma unroll
      for (int it = 0; it < 8; ++it) { const int e = it * 256 + tl, key = e >> 4, ch = e & 15;
        *(LAS u32x4*)(vimg + ((ch >> 2) * 8 + (key >> 4)) * 1024 + (key & 15) * 64 + (ch & 3) * 16) = vv[it]; } }
    const float lg = __log2f(1.f - exp2f(-5.f - (float)h)); const float gam = exp2f(lg);
    bf16x8 qr[4];
    const bf16_t* qp = QKR + (row0 + 32 * ww + r32) * DM + 64 * h + 8 * hi;
#pragma unroll
    for (int d0 = 0; d0 < 4; ++d0) qr[d0] = *(const bf16x8*)(qp + 16 * d0);
    f32x16 o[4];
#pragma unroll
    for (int dh = 0; dh < 2; ++dh) { bf16x8 rf[8];
#pragma unroll
      for (int i = 0; i < 8; ++i) rf[i] = *(const bf16x8*)(Rp + (size_t)(32 * (2 * dh + (i >> 2)) + r32) * 64 + 8 * hi + 16 * (i & 3));
      __builtin_amdgcn_sched_barrier(0);
#pragma unroll
      for (int d2 = 0; d2 < 2; ++d2) { const int dt = 2 * dh + d2; o[dt] = (f32x16){};
#pragma unroll
        for (int d0 = 0; d0 < 4; ++d0) o[dt] = MFMA32(rf[d2 * 4 + d0], qr[d0], o[dt]);
#pragma unroll
        for (int i = 0; i < 16; ++i) o[dt][i] *= gam; } }
    __syncthreads();
    const LAS char* vp = (const LAS char*)vimg + ((lane >> 4) & 1) * 32 + (lane & 3) * 8 + (4 * hi + ((lane & 15) >> 2)) * 64;
    for (int jt = 0; jt <= ww; ++jt) {
        f32x16 p = {};
        const bf16_t* kp = QKR + (row0 + 32 * jt + r32) * DM + 512 + 64 * h + 8 * hi;
        bf16x8 kfr[4];
#pragma unroll
        for (int d0 = 0; d0 < 4; ++d0) kfr[d0] = *(const bf16x8*)(kp + 16 * d0);
        __builtin_amdgcn_sched_barrier(0);
#pragma unroll
        for (int d0 = 0; d0 < 4; ++d0) p = MFMA32(kfr[d0], qr[d0], p);
        if (jt == ww) {
#pragma unroll
            for (int i = 0; i < 16; ++i) if (crow(i, hi) > r32) p[i] = 0.f;
        }
        const bf16x8 pa0 = pack8(p, 0), pa1 = pack8(p, 1);
#pragma unroll
        for (int dt = 0; dt < 4; ++dt) {
            const LAS char* v0 = vp + (dt * 8 + 2 * jt) * 1024;
            o[dt] = MFMA32(cat8(vtr(v0), vtr(v0 + 512)), pa0, o[dt]);
            o[dt] = MFMA32(cat8(vtr(v0 + 1024), vtr(v0 + 1536)), pa1, o[dt]);
        }
    }
    float s = 0.f;
#pragma unroll
    for (int dt = 0; dt < 4; ++dt)
#pragma unroll
        for (int i = 0; i < 16; ++i) s += o[dt][i];
    s = xsum(s); const float mu = s * (1.f / 128.f); float q2 = 0.f;
#pragma unroll
    for (int dt = 0; dt < 4; ++dt)
#pragma unroll
        for (int i = 0; i < 16; ++i) { const float d = o[dt][i] - mu; q2 += d * d; }
    q2 = xsum(q2); const float rstd = rsqrtf(q2 * (1.f / 128.f) + GN_EPS);
    const float* gn = a.in[12] + 128 * h;
    const size_t orow = (row0 + 32 * ww + r32) * DM + 128 * h;
    __syncthreads();
    if (dry && a.ph_lo != 12345) return;
#pragma unroll
    for (int dh = 0; dh < 2; ++dh) {
        f32x4 ggv[8]; u32x2 gwv[8];
#pragma unroll
        for (int i = 0; i < 8; ++i) { const int dv = 32 * (2 * dh + (i >> 2)) + 8 * (i & 3) + 4 * hi; ggv[i] = *(const f32x4*)(gn + dv); gwv[i] = *(const u32x2*)(GR + orow + dv); }
        __builtin_amdgcn_sched_barrier(0);
#pragma unroll
        for (int d2 = 0; d2 < 2; ++d2)
#pragma unroll
            for (int q = 0; q < 4; ++q) {
                const int dt = 2 * dh + d2; const int dv = 32 * dt + 8 * q + 4 * hi;
                const f32x4 gg = ggv[d2 * 4 + q]; const u32x2 gw = gwv[d2 * 4 + q];
                const float r0 = (o[dt][4 * q] - mu) * rstd * gg[0] * bflo(gw.x), r1 = (o[dt][4 * q + 1] - mu) * rstd * gg[1] * bfhi(gw.x);
                const float r2 = (o[dt][4 * q + 2] - mu) * rstd * gg[2] * bflo(gw.y), r3 = (o[dt][4 * q + 3] - mu) * rstd * gg[3] * bfhi(gw.y);
                *(u32x2*)(VR + orow + dv) = (u32x2){pk2(r0, r1), pk2(r2, r3)};
            }
    }
}

#define XB_TMO      128
#define XB_XCNT(j)  (256  + 64 * (j))
#define XB_XSUB(j)  (1280 + 64 * (j))
#define XB_XGEN(j)  (2304 + 64 * (j))
#define XB_TOP      3328
#define XB_TOPGEN   3392
#define XCD_BAR_WORDS 3456
#define XB_SPIN_CAP (1u << 22)
DI unsigned xb_ld(unsigned* p)              { return __hip_atomic_load(p, __ATOMIC_RELAXED, __HIP_MEMORY_SCOPE_AGENT); }
DI unsigned xb_add(unsigned* p, unsigned v) { return __hip_atomic_fetch_add(p, v, __ATOMIC_RELAXED, __HIP_MEMORY_SCOPE_AGENT); }
DI unsigned xb_xcc_id() { return (unsigned)__builtin_amdgcn_s_getreg((3 << 11) | 20) & 0xFu; }
#define XB_SPIN(cond, bar) do { unsigned _sp = 0; while (cond) { __builtin_amdgcn_s_sleep(1); \
    if ((++_sp & 255u) == 0u) { if (xb_ld(&(bar)[XB_TMO])) break; if (_sp > XB_SPIN_CAP) { atomicAdd(&(bar)[XB_TMO], 1u); break; } } } } while (0)
struct XcdBarrier { unsigned* bar; unsigned x; volatile LAS unsigned* st; };
DI XcdBarrier xcd_barrier_post(unsigned* bar, volatile LAS unsigned* st) {
    XcdBarrier b; b.bar = bar; b.x = xb_xcc_id(); b.st = st;
    if (threadIdx.x == 0) (void)xb_add(&bar[XB_XCNT(b.x)], 1u);
    return b;
}
DI void xcd_barrier_complete(unsigned* bar, unsigned x, unsigned& nloc, unsigned& nx) {
    const unsigned G = gridDim.x * gridDim.y * gridDim.z;
    unsigned sum, cnt, mine, sp = 0u;
    for (;;) {
        sum = 0u; cnt = 0u; mine = 0u;
#pragma unroll
        for (unsigned j = 0; j < 16; ++j) { const unsigned c = xb_ld(&bar[XB_XCNT(j)]); sum += c; cnt += (c > 0u) ? 1u : 0u; mine = (j == x) ? c : mine; }
        if (sum == G) break;
        __builtin_amdgcn_s_sleep(1);
        if ((++sp & 255u) == 0u) { if (xb_ld(&bar[XB_TMO])) break; if (sp > XB_SPIN_CAP) { atomicAdd(&bar[XB_TMO], 1u); break; } }
    }
    nloc = mine > 0u ? mine : 1u; nx = cnt > 0u ? cnt : 1u;
}
DI void xcd_barrier(const XcdBarrier& b) {
    asm volatile("s_waitcnt vmcnt(0)" ::: "memory");
    __syncthreads();
    if (threadIdx.x == 0) {
        unsigned* bar = b.bar;
        __builtin_amdgcn_s_waitcnt(0);
        unsigned nloc = b.st[0], nx = b.st[1];
        if (nloc == 0u) { xcd_barrier_complete(bar, b.x, nloc, nx); b.st[0] = nloc; b.st[1] = nx; }
        const unsigned old = xb_add(&bar[XB_XSUB(b.x)], 1u);
        const unsigned gen = old / nloc;
        if (old + 1u == (gen + 1u) * nloc) {
            __builtin_amdgcn_fence(__ATOMIC_RELEASE, "agent");
            asm volatile("s_waitcnt vmcnt(0)" ::: "memory");
            const unsigned og = xb_add(&bar[XB_TOP], 1u);
            const unsigned tg = og / nx;
            if (og + 1u == (tg + 1u) * nx) xb_add(&bar[XB_TOPGEN], 1u);
            else XB_SPIN(xb_ld(&bar[XB_TOPGEN]) == tg, bar);
            __builtin_amdgcn_fence(__ATOMIC_ACQUIRE, "agent");
            xb_add(&bar[XB_XGEN(b.x)], 1u);
            asm volatile("s_waitcnt vmcnt(0)" ::: "memory");
        } else {
            XB_SPIN(xb_ld(&bar[XB_XGEN(b.x)]) == gen, bar);
            __builtin_amdgcn_fence(__ATOMIC_ACQUIRE, "agent");
            asm volatile("s_waitcnt vmcnt(0)" ::: "memory");
        }
    }
    __syncthreads();
}

__global__ void __launch_bounds__(512, 2) fwd_mega(Args args) {
    extern __shared__ __attribute__((aligned(16))) unsigned char lds_raw[];
    LAS unsigned char* lds = (LAS unsigned char*)lds_raw;
    cg::grid_group grid = cg::this_grid();
    const int tid = threadIdx.x, lane = tid & 63, wave = __builtin_amdgcn_readfirstlane(tid >> 6);
    const int G = gridDim.x, bx = blockIdx.x;
    const int gw = bx * 8 + wave, NGW = G * 8;
    unsigned char* ws = args.ws;
    const int lo = args.ph_lo, hi_ = args.ph_hi;
#define IN(k) (lo <= (k) && (k) < hi_)
    volatile LAS unsigned* bst = (volatile LAS unsigned*)(lds + LDS_BYTES - 64);
    if (tid < 16) bst[tid] = 0u;
    __syncthreads();
    XcdBarrier xbar = xcd_barrier_post((unsigned*)(ws + WS_BAR), bst);
    if (args.ph_lo == 12345) grid.sync();
#define SEAM(k) do { if (IN(k) && IN((k) + 1)) xcd_barrier(xbar); } while (0)
    float* ss1 = (float*)(ws + WS_SS1); float* ss2 = (float*)(ws + WS_SS2); float* ss3 = (float*)(ws + WS_SS3);
    bf16_t* XB = (bf16_t*)(ws + WS_XB); bf16_t* ACT = (bf16_t*)(ws + WS_ACT);

#ifndef PROBE
#define PROBE 0
#endif
    if (IN(0)) phase_prep(args, lds, gw, NGW, wave, lane);
    if (PROBE == 5) { xcd_barrier(xbar); phase_prep(args, lds, gw, NGW, wave, lane); }
    if (PROBE == 4) { for (int i = 0; i < 10; ++i) xcd_barrier(xbar); }
    SEAM(0);

    if (IN(1)) {
#pragma unroll 1
        for (int rep = 0; rep < (PROBE == 1 ? 2 : 1); ++rep) {
        pg8::Gemm g{XB, (const bf16_t*)(ws + WS_WGU1), DM, DM}; pg8::StaticOrder S; S.init(T, 2 * FF, G, bx);
        pg8::EpiSwiGLU E{ACT, ss1}; pg8::gemm_phase(lds, g, S, E);
        }
        { const int nfull = (22 * 64) % G;
          if (nfull > 0 && nfull < G) { if (bx >= nfull) prep_transposes<1>(args, lds, (bx - nfull) * 8 + wave, (G - nfull) * 8, wave, lane); }
          else prep_transposes<1>(args, lds, gw, NGW, wave, lane); }
    }
    SEAM(1);
    if (IN(2)) {
        pg8::Gemm g{ACT, (const bf16_t*)(ws + WS_WD1), FF, FF}; pg8::StaticOrder S; S.init(T, DM, G, bx);
        pg8::EpiResid<true, false, true, true> E{nullptr, XB, nullptr, XB, ss2, 0.5f}; pg8::gemm_phase(lds, g, S, E);
    }
    SEAM(2);
    if (IN(3)) {
        pg8::Gemm g{XB, (const bf16_t*)(ws + WS_WIN), DM, DM}; pg8::StaticOrder S; S.init(T, 5120, G, bx);
        pg8::EpiProj E{(bf16_t*)(ws + WS_QA), (bf16_t*)(ws + WS_KV), (bf16_t*)(ws + WS_QKR), (bf16_t*)(ws + WS_VR), (bf16_t*)(ws + WS_GR), ss2,
                       (const float*)(ws + WS_COSN), (const float*)(ws + WS_SINN), (const float*)(ws + WS_COSR), (const float*)(ws + WS_SINR)};
        pg8::gemm_phase(lds, g, S, E);
    }
    SEAM(3);
    if (IN(4)) {
        if (PROBE == 2) { for (int it = bx; it < 256; it += G) { if (it < 128) compress_item(args, lds, it, tid, wave, lane); else retstate_item(args, lds, it - 128, tid, wave, lane); } }
        for (int it = bx; it < 256; it += G) { if (it < 128) compress_item(args, lds, it, tid, wave, lane); else retstate_item(args, lds, it - 128, tid, wave, lane); }
    }
    SEAM(4);
    if (IN(5)) {
        for (int vc = bx; vc < 256; vc += G) {
            const int bg = vc >> 5, j = vc & 31;
            const int qts[4] = {127 - j, 64 + j, 63 - j, j};
            if (PROBE == 3) {
#pragma unroll 1
                for (int i = 0; i < 4; ++i) nsa_item<PEXP>(args, lds, bg * 128 + qts[i], tid, wave, lane, true);
            }
#pragma unroll 1
            for (int i = 0; i < 4; ++i) nsa_item(args, lds, bg * 128 + qts[i], tid, wave, lane);
            if (PROBE == 6) {
#pragma unroll 1
                for (int i = 0; i < 2; ++i) retout_item(args, lds, vc * 2 + i, tid, wave, lane, true);
            }
#pragma unroll 1
            for (int i = 0; i < 2; ++i) retout_item(args, lds, vc * 2 + i, tid, wave, lane);
        }
    }
    SEAM(5);
    if (IN(6)) {
        { pg8::Gemm g{XB, (const bf16_t*)(ws + WS_WGM), DM, DM}; pg8::GateOrder S; S.S.init(T, DM, G, bx);
          pg8::EpiGate E{(bf16_t*)(ws + WS_GATEA), (bf16_t*)(ws + WS_GATER), ss2}; pg8::gemm_phase(lds, g, S, E); }
        { pg8::Gemm g{(const bf16_t*)(ws + WS_QA), (const bf16_t*)(ws + WS_WN), DM, DM}; pg8::StaticOrder S; S.init(T, DM, G, bx);
          pg8::EpiMix<false> E{(const bf16_t*)(ws + WS_GATEA), (bf16_t*)(ws + WS_MIX)}; pg8::gemm_phase(lds, g, S, E); }
        { pg8::Gemm g{(const bf16_t*)(ws + WS_VR), (const bf16_t*)(ws + WS_WR), DM, DM}; pg8::StaticOrder S; S.init(T, DM, G, bx);
          pg8::EpiMix<true> E{(const bf16_t*)(ws + WS_GATER), (bf16_t*)(ws + WS_MIX)}; pg8::gemm_phase(lds, g, S, E); }
    }
    SEAM(6);
    if (IN(7)) {
        pg8::Gemm g{(const bf16_t*)(ws + WS_MIX), (const bf16_t*)(ws + WS_WO), DM, DM}; pg8::StaticOrder S; S.init(T, DM, G, bx);
        pg8::EpiResid<true, false, true, true> E{nullptr, XB, nullptr, XB, ss3, 1.0f}; pg8::gemm_phase(lds, g, S, E);
    }
    SEAM(7);
    if (IN(8)) {
        pg8::Gemm g{XB, (const bf16_t*)(ws + WS_WGU2), DM, DM}; pg8::StaticOrder S; S.init(T, 2 * FF, G, bx);
        pg8::EpiSwiGLU E{ACT, ss3}; pg8::gemm_phase(lds, g, S, E);
    }
    SEAM(8);
    if (IN(9)) {
        pg8::Gemm g{ACT, (const bf16_t*)(ws + WS_WD2), FF, FF}; pg8::StaticOrder S; S.init(T, DM, G, bx);
        pg8::EpiResid<true, false, true, false> E{nullptr, XB, nullptr, XB, nullptr, 0.5f}; pg8::gemm_phase(lds, g, S, E);
    }
    SEAM(9);
    if (IN(10)) {
        const float* gf = args.in[20];
        f32x4 gg[2][2];
#pragma unroll
        for (int j = 0; j < 2; ++j) { gg[j][0] = *(const f32x4*)(gf + 512 * j + 8 * lane); gg[j][1] = *(const f32x4*)(gf + 512 * j + 8 * lane + 4); }
        for (int m0 = gw; m0 < T; m0 += 2 * NGW) {
            const int m1 = (m0 + NGW < T) ? m0 + NGW : m0;
            u32x4 w0[2], w1[2];
#pragma unroll
            for (int j = 0; j < 2; ++j) { w0[j] = *(const u32x4*)(XB + (size_t)m0 * DM + 512 * j + 8 * lane); w1[j] = *(const u32x4*)(XB + (size_t)m1 * DM + 512 * j + 8 * lane); }
            f32x4 a0[2][2], a1[2][2]; float s0 = 0.f, s1 = 0.f;
#pragma unroll
            for (int j = 0; j < 2; ++j) {
                a0[j][0] = (f32x4){bflo(w0[j].x), bfhi(w0[j].x), bflo(w0[j].y), bfhi(w0[j].y)}; a0[j][1] = (f32x4){bflo(w0[j].z), bfhi(w0[j].z), bflo(w0[j].w), bfhi(w0[j].w)};
                a1[j][0] = (f32x4){bflo(w1[j].x), bfhi(w1[j].x), bflo(w1[j].y), bfhi(w1[j].y)}; a1[j][1] = (f32x4){bflo(w1[j].z), bfhi(w1[j].z), bflo(w1[j].w), bfhi(w1[j].w)};
#pragma unroll
                for (int h = 0; h < 2; ++h) { s0 += (a0[j][h].x * a0[j][h].x + a0[j][h].y * a0[j][h].y) + (a0[j][h].z * a0[j][h].z + a0[j][h].w * a0[j][h].w);
                                              s1 += (a1[j][h].x * a1[j][h].x + a1[j][h].y * a1[j][h].y) + (a1[j][h].z * a1[j][h].z + a1[j][h].w * a1[j][h].w); }
            }
            const float rs0 = rsqrtf(wave_sum(s0) * (1.f / DM) + EPS), rs1 = rsqrtf(wave_sum(s1) * (1.f / DM) + EPS);
#pragma unroll
            for (int j = 0; j < 2; ++j)
#pragma unroll
                for (int h = 0; h < 2; ++h) {
                    *(f32x4*)(args.out + (size_t)m0 * DM + 512 * j + 8 * lane + 4 * h) = a0[j][h] * rs0 * gg[j][h];
                    if (m1 != m0) *(f32x4*)(args.out + (size_t)m1 * DM + 512 * j + 8 * lane + 4 * h) = a1[j][h] * rs1 * gg[j][h];
                }
        }
    }
#undef IN
#undef SEAM
}

#ifndef N_LAUNCH_SPLIT
#define N_LAUNCH_SPLIT 0
#endif
extern "C" void kernel_launch(void* const* d_in, const int* in_sizes, int n_in, void* d_out, int out_size, void* d_ws, size_t ws_size, hipStream_t stream) {
    static int grid = 0;
    if (grid == 0) {
        int dev = 0, cus = 0, per_cu = 0;
        if (n_in != 21 || ws_size < WS_END) { fprintf(stderr, "kernel_launch: unexpected inputs (n_in %d, ws %zu)\n", n_in, ws_size); grid = -1; return; }
        hipGetDevice(&dev); hipDeviceGetAttribute(&cus, hipDeviceAttributeMultiprocessorCount, dev);
        if (hipFuncSetAttribute((const void*)fwd_mega, hipFuncAttributeMaxDynamicSharedMemorySize, LDS_BYTES) != hipSuccess) { fprintf(stderr, "hipFuncSetAttribute failed\n"); grid = -1; return; }
        if (hipOccupancyMaxActiveBlocksPerMultiprocessor(&per_cu, (const void*)fwd_mega, 512, LDS_BYTES) != hipSuccess || per_cu < 1) { fprintf(stderr, "occupancy query: %d\n", per_cu); per_cu = 1; }
        (void)hipGetLastError();
        grid = cus * 1;
    }
    if (grid < 0) return;
    Args a{};
    for (int i = 0; i < 21; ++i) a.in[i] = (const float*)d_in[i];
    a.out = (float*)d_out; a.ws = (unsigned char*)d_ws;
#if N_LAUNCH_SPLIT
    for (int p = 0; p < 11; ++p) { a.ph_lo = p; a.ph_hi = p + 1; hipLaunchKernelGGL(fwd_mega, dim3(grid), dim3(512), LDS_BYTES, stream, a); }
#else
    a.ph_lo = 0; a.ph_hi = 11;
    if (hipMemsetAsync((char*)d_ws + WS_BAR, 0, XCD_BAR_WORDS * 4, stream) != hipSuccess) { fprintf(stderr, "memset of barrier words failed\n"); return; }
    void* kargs[] = {&a};
    hipError_t e = hipLaunchCooperativeKernel((const void*)fwd_mega, dim3(grid), dim3(512), kargs, LDS_BYTES, stream);
    if (e != hipSuccess) fprintf(stderr, "cooperative launch failed: %s (grid %d)\n", hipGetErrorString(e), grid);
#endif
}
```

```cpp
#include <hip/hip_runtime.h>
#include <hip/hip_cooperative_groups.h>
#include <cstdio>
#include <cstdint>
namespace cg = cooperative_groups;

#define LAS __attribute__((address_space(3)))
#define DI __device__ __forceinline__
typedef unsigned short bf16_t;
typedef short bf16x8 __attribute__((ext_vector_type(8)));
typedef short s16x4 __attribute__((ext_vector_type(4)));
typedef float f32x4 __attribute__((ext_vector_type(4)));
typedef float f32x16 __attribute__((ext_vector_type(16)));
typedef unsigned u32x4 __attribute__((ext_vector_type(4)));
typedef unsigned u32x2 __attribute__((ext_vector_type(2)));

constexpr int T = 16384, SEQ = 4096, DM = 1024, FF = 2816, DIN = 6960;
constexpr float EPS = 1e-6f, GN_EPS = 1e-5f;
constexpr float C2 = 0.125f * 1.4426950408889634f;

constexpr size_t MiB = 1u << 20, KiB = 1u << 10;
constexpr size_t WS_SS1 = 0, WS_SS2 = 64 * KiB, WS_SS3 = 128 * KiB, WS_CBIAS = 192 * KiB;
constexpr size_t WS_BAR = 208 * KiB;
constexpr size_t WS_COSN = 256 * KiB, WS_SINN = 384 * KiB, WS_COSR = 512 * KiB, WS_SINR = 1024 * KiB;
constexpr size_t WS_KC = 1536 * KiB, WS_VC = 1792 * KiB;
constexpr size_t WS_BPART = 2 * MiB + 128 * KiB;
constexpr size_t WS_W2K = 2 * MiB, WS_W2V = 2 * MiB + 32 * KiB, WS_W1K = 3 * MiB, WS_W1V = 4 * MiB;
constexpr size_t WS_WGU1 = 5 * MiB, WS_WD1 = 16 * MiB, WS_RP = 5 * MiB;
constexpr size_t WS_WIN = 22 * MiB, WS_WGM = 32 * MiB, WS_WN = 36 * MiB, WS_WR = 38 * MiB, WS_WO = 40 * MiB;
constexpr size_t WS_WGU2 = 42 * MiB, WS_WD2 = 53 * MiB;
constexpr size_t WS_XB = 59 * MiB;
constexpr size_t WS_QA = 91 * MiB, WS_KV = 123 * MiB, WS_QKR = 155 * MiB, WS_VR = 187 * MiB, WS_GR = 219 * MiB, WS_END = 251 * MiB;
constexpr size_t WS_ACT = WS_QA, WS_GATEA = WS_QKR, WS_GATER = WS_GR, WS_MIX = WS_KV;

constexpr int LDS_BYTES = 147456;

DI unsigned f2bf(float f) { unsigned u = __builtin_bit_cast(unsigned, f); return (u + 0x7fffu + ((u >> 16) & 1u)) >> 16; }
typedef float f32x2_t __attribute__((ext_vector_type(2))); typedef __bf16 bf16x2_t __attribute__((ext_vector_type(2)));
DI unsigned pk2(float lo, float hi) { f32x2_t v = {lo, hi}; bf16x2_t b = __builtin_convertvector(v, bf16x2_t); return __builtin_bit_cast(unsigned, b); }
DI float bf2f(unsigned short h) { return __builtin_bit_cast(float, (unsigned)h << 16); }
DI float bflo(unsigned w) { return __builtin_bit_cast(float, w << 16); }
DI float bfhi(unsigned w) { return __builtin_bit_cast(float, w & 0xffff0000u); }
DI int lane_id() { return (int)__builtin_amdgcn_mbcnt_hi(~0u, __builtin_amdgcn_mbcnt_lo(~0u, 0u)); }
DI int crow(int r, int hi) { return (r & 3) + 8 * (r >> 2) + 4 * hi; }
DI float wave_sum(float v) {
#pragma unroll
    for (int o = 1; o < 64; o <<= 1) v += __shfl_xor(v, o);
    return v;
}
DI float xhalf(float v) {
    unsigned w = __builtin_bit_cast(unsigned, v); asm volatile("" : "+v"(w));
    const auto rr = __builtin_amdgcn_permlane32_swap(__builtin_bit_cast(unsigned, v), w, false, false);
    return __builtin_bit_cast(float, (threadIdx.x & 32) ? rr[0] : rr[1]);
}
DI bf16x8 pack8(const f32x16& x, int s) {
    u32x4 p; p.x = pk2(x[8 * s], x[8 * s + 1]); p.y = pk2(x[8 * s + 2], x[8 * s + 3]); p.z = pk2(x[8 * s + 4], x[8 * s + 5]); p.w = pk2(x[8 * s + 6], x[8 * s + 7]);
    return __builtin_bit_cast(bf16x8, p);
}
#define MFMA32(a, b, c) __builtin_amdgcn_mfma_f32_32x32x16_bf16((a), (b), (c), 0, 0, 0)
typedef short v4i16_t __attribute__((ext_vector_type(4)));
DI s16x4 vtr(const LAS char* p) { return __builtin_bit_cast(s16x4, __builtin_amdgcn_ds_read_tr16_b64_v4i16((LAS v4i16_t*)p)); }
DI bf16x8 cat8(s16x4 lo, s16x4 hi) { return (bf16x8){lo[0], lo[1], lo[2], lo[3], hi[0], hi[1], hi[2], hi[3]}; }
DI float sigmoidf_(float x) { return __builtin_amdgcn_rcpf(1.f + __expf(-x)); }
DI float xsum(float v) { return v + xhalf(v); }
DI float xmax(float v) { return fmaxf(v, xhalf(v)); }
DI int ldim(int p) { return p < 8 ? p : (p < 32 ? p + 8 : (p < 40 ? p - 24 : p)); }

namespace pg8 {
constexpr int BM = 256, BK = 64, HALF = 128, HTB = HALF * BK * 2, STAGE_BYTES = 8 * HTB, NXCD = 8, WGM = 8;
__host__ __device__ __forceinline__ int lds_byte(int r, int c) { const int st = (r >> 4) * 2 + (c >> 5), rr = r & 15, cc = c & 31, ob = rr * 64 + cc * 2; return st * 1024 + (ob ^ (((ob >> 9) & 1) << 5)); }
__host__ __device__ __forceinline__ void stage_rc(int b, int& R, int& C) { const int st = b / 1024, sb = b % 1024, swz = sb ^ (((sb >> 9) & 1) << 5); R = (st >> 1) * 16 + swz / 64; C = (st & 1) * 32 + (swz % 64) / 2; }
__host__ __device__ __forceinline__ int perm32(int rho) { const int n = rho >> 4, i = rho & 15; return 8 * (i >> 2) + 4 * n + (i & 3); }
struct Unit { int pm, pn, sel; };
struct Gemm { const bf16_t* A; const bf16_t* Bt; int lda, K; const bf16_t* A2; const bf16_t* Bt2; };
struct StaticOrder {
    int nM, nN, nwg, G, c;
    DI void init(int M, int N, int G_, int c_) { nM = M / BM; nN = N / BM; nwg = nM * nN; G = G_; c = c_; }
    DI bool map(long L, Unit& u) const {
        if (L >= nwg) return false;
        int wgid = (int)L; { const int q = nwg / NXCD, r = nwg % NXCD, xcd = wgid % NXCD, off = wgid / NXCD; wgid = (xcd < r ? xcd * (q + 1) : r * (q + 1) + (xcd - r) * q) + off; }
        const int nig = WGM * nN, gid = wgid / nig, fm = gid * WGM, gsz = (nM - fm) < WGM ? (nM - fm) : WGM;
        u.pm = fm + ((wgid % nig) % gsz); u.pn = (wgid % nig) / gsz; u.sel = 0; return true;
    }
    DI bool next(int i, Unit& u) const { return map((long)i * G + c, u); }
};
struct GateOrder {
    StaticOrder S;
    DI bool next(int i, Unit& u) const { if (!S.map((long)(i >> 1) * S.G + S.c, u)) return false; u.pn += 4 * (i & 1); return true; }
};

struct PairOrder {
    StaticOrder S;
    DI bool next(int i, Unit& u) const { if (!S.map((long)(i >> 1) * S.G + S.c, u)) return false; u.sel = i & 1; return true; }
};
template <class E> DI auto keep_acc(const E& e, const Unit& u, int) -> decltype(e.keep(u)) { return e.keep(u); }
template <class E> DI bool keep_acc(const E&, const Unit&, long) { return false; }
template <class Epi, class Sched>
__device__ __forceinline__ void gemm_phase(LAS unsigned char* lds, const Gemm g, const Sched& S, const Epi& E) {
    const int tid = threadIdx.x, wid = __builtin_amdgcn_readfirstlane(tid >> 6), lane = tid & 63, wr = wid >> 2, wc = wid & 3, fr = lane & 15, fq = lane >> 4;
    const int K = g.K, nt = K / BK, lda = g.lda;
    unsigned voffA[2], voffB[2];
#pragma unroll
    for (int i = 0; i < 2; ++i) { int R, C; stage_rc(tid * 16 + i * 8192, R, C); const int Rb = (R & ~31) + perm32(R & 31);
        voffA[i] = (unsigned)(R * lda + C) * 2u; voffB[i] = (unsigned)(Rb * K + C) * 2u; }
    const size_t kstep = (size_t)(BK * 2);
    const size_t hstepA = (size_t)HALF * lda * 2, hstepB = (size_t)HALF * K * 2;
    const size_t tstepA = 2 * hstepA, tstepB = 2 * hstepB;
    const unsigned ldsw = (unsigned)wid * 1024u;
    const int aoff = lds_byte(wr * 64 + fr, fq * 8), boff = lds_byte(wc * 32 + fr, fq * 8);
#define PG8_SA(b, h) (((b) * 2 + (h)) * HTB)
#define PG8_SB(b, h) ((4 + (b) * 2 + (h)) * HTB)
#define PG8_STAGE(bufoff, gbase, voff) do { _Pragma("unroll") for (int _i = 0; _i < 2; ++_i) \
        __builtin_amdgcn_global_load_lds((const unsigned*)((const char*)(gbase) + (voff)[_i]), (LAS unsigned*)(lds + (bufoff) + ldsw + _i * 8192), 16, 0, 0); } while (0)
#define PG8_LDA(dst, b, h) do { _Pragma("unroll") for (int m = 0; m < 4; ++m) _Pragma("unroll") for (int k = 0; k < 2; ++k) dst[m][k] = *(const LAS bf16x8*)(lds + PG8_SA(b, h) + aoff + m * 2048 + k * 1024); } while (0)
#define PG8_LDB(dst, b, h) do { _Pragma("unroll") for (int n = 0; n < 2; ++n) _Pragma("unroll") for (int k = 0; k < 2; ++k) dst[n][k] = *(const LAS bf16x8*)(lds + PG8_SB(b, h) + boff + n * 2048 + k * 1024); } while (0)
#define PG8_MMA(ai, bj, At, Bt) do { __builtin_amdgcn_s_setprio(1); _Pragma("unroll") for (int m = 0; m < 4; ++m) _Pragma("unroll") for (int n = 0; n < 2; ++n) _Pragma("unroll") for (int k = 0; k < 2; ++k) \
        acc[ai][bj][m][n] = __builtin_amdgcn_mfma_f32_16x16x32_bf16(Bt[n][k], At[m][k], acc[ai][bj][m][n], 0, 0, 0); __builtin_amdgcn_s_setprio(0); } while (0)
#define PG8_WAIT_V(n) asm volatile("s_waitcnt vmcnt(" #n ")" ::: "memory")
#define PG8_WAIT_L(n) asm volatile("s_waitcnt lgkmcnt(" #n ")" ::: "memory")
#define PG8_BAR __builtin_amdgcn_s_barrier()
#define PG8_SCHED __builtin_amdgcn_sched_barrier(0)
    Unit cur, nxt; int ui = 0;
    if (!S.next(0, cur)) return;
    f32x4 acc[2][2][4][2];
#pragma unroll
    for (int a = 0; a < 2; ++a)
#pragma unroll
        for (int b = 0; b < 2; ++b)
#pragma unroll
            for (int m = 0; m < 4; ++m)
#pragma unroll
                for (int n = 0; n < 2; ++n) acc[a][b][m][n] = (f32x4){0.f, 0.f, 0.f, 0.f};
    bf16x8 At[4][2], B0[2][2], B1[2][2];
    const char* cA = (const char*)(cur.sel ? g.A2 : g.A) + (size_t)cur.pm * tstepA; const char* cB = (const char*)(cur.sel ? g.Bt2 : g.Bt) + (size_t)cur.pn * tstepB;
    PG8_STAGE(PG8_SB(0, 0), cB, voffB); PG8_STAGE(PG8_SB(0, 1), cB + hstepB, voffB); PG8_STAGE(PG8_SA(0, 0), cA, voffA); PG8_STAGE(PG8_SA(0, 1), cA + hstepA, voffA);
    if (wr == 1) PG8_BAR;
    PG8_WAIT_V(2); PG8_BAR;
    PG8_STAGE(PG8_SB(1, 0), cB + kstep, voffB); PG8_STAGE(PG8_SA(1, 0), cA + kstep, voffA); PG8_STAGE(PG8_SB(1, 1), cB + hstepB + kstep, voffB);
    PG8_WAIT_V(6); PG8_BAR;
    for (;;) {
        const bool has_next = S.next(ui + 1, nxt);
        const char* nA = has_next ? (const char*)(nxt.sel ? g.A2 : g.A) + (size_t)nxt.pm * tstepA : cA; const char* nB = has_next ? (const char*)(nxt.sel ? g.Bt2 : g.Bt) + (size_t)nxt.pn * tstepB : cB;
        for (int t = 0; t < nt; t += 2) {
            const bool last = (t == nt - 2);
            const char* a1 = cA + (size_t)(t + 1) * kstep;
            const char* a2 = last ? nA : cA + (size_t)(t + 2) * kstep; const char* b2 = last ? nB : cB + (size_t)(t + 2) * kstep;
            const char* a3 = a2 + kstep; const char* b3 = b2 + kstep;
            PG8_LDB(B0, 0, 0); PG8_LDB(B1, 0, 1); PG8_SCHED; PG8_LDA(At, 0, 0); PG8_STAGE(PG8_SA(1, 1), a1 + hstepA, voffA);
            PG8_WAIT_V(8); PG8_WAIT_L(0); PG8_BAR; PG8_MMA(0, 0, At, B0); PG8_MMA(0, 1, At, B1); PG8_BAR; PG8_SCHED;
            PG8_LDA(At, 0, 1); PG8_STAGE(PG8_SB(0, 0), b2, voffB); PG8_STAGE(PG8_SB(0, 1), b2 + hstepB, voffB); PG8_STAGE(PG8_SA(0, 0), a2, voffA);
            PG8_WAIT_V(8); PG8_WAIT_L(0); PG8_BAR; PG8_MMA(1, 0, At, B0); PG8_MMA(1, 1, At, B1); PG8_BAR; PG8_SCHED;
            PG8_LDB(B0, 1, 0); PG8_LDB(B1, 1, 1); PG8_SCHED; PG8_LDA(At, 1, 0); PG8_STAGE(PG8_SA(0, 1), a2 + hstepA, voffA);
            PG8_WAIT_V(8); PG8_WAIT_L(0); PG8_BAR; PG8_MMA(0, 0, At, B0); PG8_MMA(0, 1, At, B1); PG8_BAR; PG8_SCHED;
            PG8_LDA(At, 1, 1); PG8_STAGE(PG8_SB(1, 0), b3, voffB); PG8_STAGE(PG8_SB(1, 1), b3 + hstepB, voffB); PG8_STAGE(PG8_SA(1, 0), a3, voffA);
            PG8_WAIT_V(8); PG8_WAIT_L(0); PG8_BAR; PG8_MMA(1, 0, At, B0); PG8_MMA(1, 1, At, B1); PG8_BAR; PG8_SCHED;
        }
        if (wr == 0) PG8_BAR;
        E(acc, cur, wr, wc, fr, fq);
        if (!has_next) break;
        if (!keep_acc(E, cur, 0)) {
#pragma unroll
        for (int a = 0; a < 2; ++a)
#pragma unroll
            for (int b = 0; b < 2; ++b)
#pragma unroll
                for (int m = 0; m < 4; ++m)
#pragma unroll
                    for (int n = 0; n < 2; ++n) acc[a][b][m][n] = (f32x4){0.f, 0.f, 0.f, 0.f};
        }
        cur = nxt; cA = nA; cB = nB; ++ui;
        if (wr == 1) PG8_BAR;
    }
    PG8_WAIT_V(0);
    PG8_BAR;
#undef PG8_SA
#undef PG8_SB
#undef PG8_STAGE
#undef PG8_LDA
#undef PG8_LDB
#undef PG8_MMA
#undef PG8_WAIT_V
#undef PG8_WAIT_L
#undef PG8_BAR
#undef PG8_SCHED
}
typedef f32x4 Acc[2][2][4][2];
DI void st16(bf16_t* p, f32x4 a, f32x4 b) { u32x4 w; w.x = pk2(a[0], a[1]); w.y = pk2(a[2], a[3]); w.z = pk2(b[0], b[1]); w.w = pk2(b[2], b[3]); *(u32x4*)p = w; }

struct EpiSwiGLU {
    bf16_t* ACT; const float* ss;
    DI void operator()(const Acc& acc, const Unit& u, int wr, int wc, int fr, int fq) const {
        float ssv[8];
#pragma unroll
        for (int i = 0; i < 8; ++i) ssv[i] = ss[u.pm * BM + (i >> 2) * HALF + wr * 64 + (i & 3) * 16 + fr];
        __builtin_amdgcn_sched_barrier(0);
#pragma unroll
        for (int ai = 0; ai < 2; ++ai)
#pragma unroll
            for (int m = 0; m < 4; ++m) {
                const int row = u.pm * BM + ai * HALF + wr * 64 + m * 16 + fr;
                const float rs = rsqrtf(ssv[ai * 4 + m] * (1.f / DM) + EPS);
                f32x4 o[2];
#pragma unroll
                for (int n = 0; n < 2; ++n)
#pragma unroll
                    for (int j = 0; j < 4; ++j) { const float gv = acc[ai][0][m][n][j] * rs, uv = acc[ai][1][m][n][j] * rs; o[n][j] = gv * sigmoidf_(gv) * uv; }
                st16(ACT + (size_t)row * FF + u.pn * 128 + wc * 32 + fq * 8, o[0], o[1]);
            }
    }
};
template <bool IN16, bool OUT32, bool OUT16, bool SS> struct EpiResid {
    const float* xin32; const bf16_t* xin16; float* xout; bf16_t* xb; float* ss; float scale;
    DI void operator()(const Acc& acc, const Unit& u, int wr, int wc, int fr, int fq) const {
#pragma unroll
        for (int ai = 0; ai < 2; ++ai) {
            f32x4 xv[4][2][2]; u32x4 xw[4][2];
#pragma unroll
            for (int m = 0; m < 4; ++m)
#pragma unroll
                for (int bj = 0; bj < 2; ++bj) { const size_t off = (size_t)(u.pm * BM + ai * HALF + wr * 64 + m * 16 + fr) * DM + u.pn * BM + bj * HALF + wc * 32 + fq * 8;
                    if (IN16) xw[m][bj] = *(const u32x4*)(xin16 + off);
                    else { xv[m][bj][0] = *(const f32x4*)(xin32 + off); xv[m][bj][1] = *(const f32x4*)(xin32 + off + 4); } }
            __builtin_amdgcn_sched_barrier(0);
#pragma unroll
            for (int m = 0; m < 4; ++m) {
                const int row = u.pm * BM + ai * HALF + wr * 64 + m * 16 + fr;
                float sq = 0.f;
#pragma unroll
                for (int bj = 0; bj < 2; ++bj) {
                    const size_t off = (size_t)row * DM + u.pn * BM + bj * HALF + wc * 32 + fq * 8;
                    f32x4 x0, x1;
                    if (IN16) { const u32x4 w = xw[m][bj]; x0 = (f32x4){bflo(w.x), bfhi(w.x), bflo(w.y), bfhi(w.y)}; x1 = (f32x4){bflo(w.z), bfhi(w.z), bflo(w.w), bfhi(w.w)}; }
                    else { x0 = xv[m][bj][0]; x1 = xv[m][bj][1]; }
                    x0 = x0 + acc[ai][bj][m][0] * scale; x1 = x1 + acc[ai][bj][m][1] * scale;
                    if (OUT32) { *(f32x4*)(xout + off) = x0; *(f32x4*)(xout + off + 4) = x1; }
                    if (OUT16) st16(xb + off, x0, x1);
                    if (SS) sq += (x0[0] * x0[0] + x0[1] * x0[1]) + (x0[2] * x0[2] + x0[3] * x0[3]) + (x1[0] * x1[0] + x1[1] * x1[1]) + (x1[2] * x1[2] + x1[3] * x1[3]);
                }
                if (SS) { sq += __shfl_xor(sq, 16); sq += __shfl_xor(sq, 32); if (fq == 0) atomicAdd(ss + row, sq); }
            }
        }
    }
};
struct EpiProj {
    bf16_t *QA, *KV, *QKR, *VR, *GR; const float* ss; const float *cosN, *sinN, *cosR, *sinR;
    DI void operator()(const Acc& acc, const Unit& u, int wr, int wc, int fr, int fq) const {
        asm volatile("" : "+v"(fr));
        const int t = u.pn;
#pragma unroll
        for (int ai = 0; ai < 2; ++ai)
#pragma unroll
          for (int mp = 0; mp < 2; ++mp) {
            float ssv[8];
            ssv[ai * 4 + 2 * mp] = ss[u.pm * BM + ai * HALF + wr * 64 + (2 * mp) * 16 + fr]; ssv[ai * 4 + 2 * mp + 1] = ss[u.pm * BM + ai * HALF + wr * 64 + (2 * mp + 1) * 16 + fr];
            f32x4 csv[2][2], snv[2][2];
            if (t <= 4) { if (fq == 0) {
#pragma unroll
                for (int r2 = 0; r2 < 2; ++r2)
#pragma unroll
                    for (int n = 0; n < 2; ++n) { const int pos2 = (u.pm * BM + ai * HALF + wr * 64 + (2 * mp + r2) * 16 + fr) & (SEQ - 1); csv[r2][n] = *(const f32x4*)(cosN + pos2 * 8 + 4 * n); snv[r2][n] = *(const f32x4*)(sinN + pos2 * 8 + 4 * n); } }
            } else if (t >= 7 && t < 11) {
#pragma unroll
                for (int r2 = 0; r2 < 2; ++r2)
#pragma unroll
                    for (int n = 0; n < 2; ++n) { const int pos2 = (u.pm * BM + ai * HALF + wr * 64 + (2 * mp + r2) * 16 + fr) & (SEQ - 1); csv[r2][n] = *(const f32x4*)(cosR + pos2 * 32 + 8 * fq + 4 * n); snv[r2][n] = *(const f32x4*)(sinR + pos2 * 32 + 8 * fq + 4 * n); }
            }
            __builtin_amdgcn_sched_barrier(0);
#pragma unroll
            for (int r2 = 0; r2 < 2; ++r2) {
                const int m = 2 * mp + r2;
                const int row = u.pm * BM + ai * HALF + wr * 64 + m * 16 + fr;
                const float rs = rsqrtf(ssv[ai * 4 + m] * (1.f / DM) + EPS);
                const int pos = row & (SEQ - 1);
                f32x4 v[2][2];
#pragma unroll
                for (int bj = 0; bj < 2; ++bj)
#pragma unroll
                    for (int n = 0; n < 2; ++n) v[bj][n] = acc[ai][bj][m][n] * rs;
                bf16_t* dst; int c0, c1;
                if (t <= 4) {
                    if (fq == 0) {
#pragma unroll
                        for (int n = 0; n < 2; ++n) { const f32x4 cs = csv[r2][n], sn = snv[r2][n];
                            const f32x4 lo = v[0][n], hi = v[1][n]; v[0][n] = lo * cs - hi * sn; v[1][n] = hi * cs + lo * sn; }
                    }
                    if (t < 4) {
#pragma unroll
                        for (int bj = 0; bj < 2; ++bj)
#pragma unroll
                            for (int n = 0; n < 2; ++n) v[bj][n] = v[bj][n] * C2;
                        dst = QA; c0 = 256 * t + 64 * wc + 8 * fq; c1 = c0 + 32;
                    } else { dst = KV; c0 = 64 * wc + 8 * fq; c1 = c0 + 32; }
                } else if (t >= 7 && t < 11) {
                    const bool isq = t < 9; const int head = 4 * ((t - 7) & 1) + wc; const int c = pos & 127;
                    const float lg = __log2f(1.f - exp2f(-5.f - (float)head));
                    const float f = isq ? 0.125f * exp2f((float)c * lg) : exp2f(-(float)c * lg);
#pragma unroll
                    for (int n = 0; n < 2; ++n) { const f32x4 cs = csv[r2][n], sn = snv[r2][n];
                        const f32x4 lo = v[0][n], hi = v[1][n]; v[0][n] = (lo * cs - hi * sn) * f; v[1][n] = (hi * cs + lo * sn) * f; }
                    dst = QKR; c0 = (isq ? 0 : 512) + 256 * ((t - 7) & 1) + 64 * wc + 8 * fq; c1 = c0 + 32;
                } else {
                    const int cc = 32 * wc + 8 * fq;
                    if (t == 5 || t == 6) { dst = KV; c0 = 256 * (t - 4) + cc; }
                    else if (t < 15) { dst = VR; c0 = 256 * (t - 11) + cc; }
                    else if (t < 19) { dst = GR; c0 = 256 * (t - 15) + cc;
#pragma unroll
                        for (int bj = 0; bj < 2; ++bj)
#pragma unroll
                            for (int n = 0; n < 2; ++n)
#pragma unroll
                                for (int j = 0; j < 4; ++j) { const float x = v[bj][n][j]; v[bj][n][j] = x * sigmoidf_(x); }
                    } else { dst = KV; c0 = 768 + cc;
#pragma unroll
                        for (int bj = 0; bj < 2; ++bj)
#pragma unroll
                            for (int n = 0; n < 2; ++n)
#pragma unroll
                                for (int j = 0; j < 4; ++j) v[bj][n][j] = sigmoidf_(v[bj][n][j]);
                    }
                    c1 = c0 + 128;
                }
                st16(dst + (size_t)row * DM + c0, v[0][0], v[0][1]);
                st16(dst + (size_t)row * DM + c1, v[1][0], v[1][1]);
            }
          }
    }
};
struct EpiGate {
    bf16_t *GA_, *GR_; const float* ss;
    DI void operator()(const Acc& acc, const Unit& u, int wr, int wc, int fr, int fq) const {
        bf16_t* dst = u.pn < 4 ? GA_ : GR_; const int ct = (u.pn & 3) * BM;
        float ssv[8];
#pragma unroll
        for (int i = 0; i < 8; ++i) ssv[i] = ss[u.pm * BM + (i >> 2) * HALF + wr * 64 + (i & 3) * 16 + fr];
        __builtin_amdgcn_sched_barrier(0);
#pragma unroll
        for (int ai = 0; ai < 2; ++ai)
#pragma unroll
            for (int m = 0; m < 4; ++m) {
                const int row = u.pm * BM + ai * HALF + wr * 64 + m * 16 + fr;
                const float rs = rsqrtf(ssv[ai * 4 + m] * (1.f / DM) + EPS);
#pragma unroll
                for (int bj = 0; bj < 2; ++bj) { f32x4 o[2];
#pragma unroll
                    for (int n = 0; n < 2; ++n)
#pragma unroll
                        for (int j = 0; j < 4; ++j) o[n][j] = sigmoidf_(acc[ai][bj][m][n][j] * rs);
                    st16(dst + (size_t)row * DM + ct + bj * HALF + wc * 32 + fq * 8, o[0], o[1]); }
            }
    }
};
template <bool ADD> struct EpiMix {
    const bf16_t* G_; bf16_t* MIX;
    DI void operator()(const Acc& acc, const Unit& u, int wr, int wc, int fr, int fq) const {
#pragma unroll
        for (int ai = 0; ai < 2; ++ai) {
            u32x4 gv[4][2], pv[4][2];
#pragma unroll
            for (int m = 0; m < 4; ++m)
#pragma unroll
                for (int bj = 0; bj < 2; ++bj) { const size_t off = (size_t)(u.pm * BM + ai * HALF + wr * 64 + m * 16 + fr) * DM + u.pn * BM + bj * HALF + wc * 32 + fq * 8;
                    gv[m][bj] = *(const u32x4*)(G_ + off); pv[m][bj] = (u32x4){0u, 0u, 0u, 0u}; if (ADD) pv[m][bj] = *(const u32x4*)(MIX + off); }
            __builtin_amdgcn_sched_barrier(0);
#pragma unroll
            for (int m = 0; m < 4; ++m) {
                const int row = u.pm * BM + ai * HALF + wr * 64 + m * 16 + fr;
#pragma unroll
                for (int bj = 0; bj < 2; ++bj) {
                    const size_t off = (size_t)row * DM + u.pn * BM + bj * HALF + wc * 32 + fq * 8;
                    const u32x4 gw = gv[m][bj];
                    const u32x4 pw = pv[m][bj];
                    f32x4 o0, o1;
                    o0[0] = bflo(gw.x) * acc[ai][bj][m][0][0]; o0[1] = bfhi(gw.x) * acc[ai][bj][m][0][1]; o0[2] = bflo(gw.y) * acc[ai][bj][m][0][2]; o0[3] = bfhi(gw.y) * acc[ai][bj][m][0][3];
                    o1[0] = bflo(gw.z) * acc[ai][bj][m][1][0]; o1[1] = bfhi(gw.z) * acc[ai][bj][m][1][1]; o1[2] = bflo(gw.w) * acc[ai][bj][m][1][2]; o1[3] = bfhi(gw.w) * acc[ai][bj][m][1][3];
                    if (ADD) { o0[0] += bflo(pw.x); o0[1] += bfhi(pw.x); o0[2] += bflo(pw.y); o0[3] += bfhi(pw.y); o1[0] += bflo(pw.z); o1[1] += bfhi(pw.z); o1[2] += bflo(pw.w); o1[3] += bfhi(pw.w); }
                    st16(MIX + off, o0, o1);
                }
            }
        }
    }
};
struct EpiMixFused {
    const bf16_t *GA_, *GR_; bf16_t* MIX;
    DI bool keep(const Unit& u) const { return u.sel == 0; }
    DI void operator()(Acc& acc, const Unit& u, int wr, int wc, int fr, int fq) const {
#pragma unroll
        for (int ai = 0; ai < 2; ++ai)
#pragma unroll
          for (int mp = 0; mp < 2; ++mp) {
            u32x4 gv[2][2], hv[2][2];
#pragma unroll
            for (int r2 = 0; r2 < 2; ++r2)
#pragma unroll
                for (int bj = 0; bj < 2; ++bj) { const size_t off = (size_t)(u.pm * BM + ai * HALF + wr * 64 + (2 * mp + r2) * 16 + fr) * DM + u.pn * BM + bj * HALF + wc * 32 + fq * 8;
                    hv[r2][bj] = *(const u32x4*)(GR_ + off); if (u.sel == 0) gv[r2][bj] = *(const u32x4*)(GA_ + off); }
            __builtin_amdgcn_sched_barrier(0);
#pragma unroll
            for (int r2 = 0; r2 < 2; ++r2)
#pragma unroll
                for (int bj = 0; bj < 2; ++bj) {
                    const int m = 2 * mp + r2;
                    const u32x4 h = hv[r2][bj];
                    f32x4 r0 = (f32x4){bflo(h.x), bfhi(h.x), bflo(h.y), bfhi(h.y)}, r1 = (f32x4){bflo(h.z), bfhi(h.z), bflo(h.w), bfhi(h.w)};
#pragma unroll
                    for (int j = 0; j < 4; ++j) { r0[j] = fmaxf(r0[j], 1e-30f); r1[j] = fmaxf(r1[j], 1e-30f); }
                    if (u.sel == 0) {
                        const u32x4 g = gv[r2][bj];
                        const f32x4 a0 = (f32x4){bflo(g.x), bfhi(g.x), bflo(g.y), bfhi(g.y)}, a1 = (f32x4){bflo(g.z), bfhi(g.z), bflo(g.w), bfhi(g.w)};
#pragma unroll
                        for (int j = 0; j < 4; ++j) { acc[ai][bj][m][0][j] *= a0[j] * __builtin_amdgcn_rcpf(r0[j]); acc[ai][bj][m][1][j] *= a1[j] * __builtin_amdgcn_rcpf(r1[j]); }
                    } else {
                        const size_t off = (size_t)(u.pm * BM + ai * HALF + wr * 64 + m * 16 + fr) * DM + u.pn * BM + bj * HALF + wc * 32 + fq * 8;
                        st16(MIX + off, acc[ai][bj][m][0] * r0, acc[ai][bj][m][1] * r1);
                    }
                }
          }
    }
};
}

struct Args { const float* in[21]; float* out; unsigned char* ws; int ph_lo, ph_hi; };

DI void tr_item(const float* W, int ldw, int K, bf16_t* WT, int drow0, int scol4, const float* ksc, int k0, LAS float* scr, int lane) {
    const int kq = lane >> 4, n4 = 4 * (lane & 15);
    f32x4 v[16];
#pragma unroll
    for (int i = 0; i < 16; ++i) v[i] = scol4 >= 0 ? *(const f32x4*)(W + (size_t)(k0 + 4 * i + kq) * ldw + scol4) : (f32x4){0.f, 0.f, 0.f, 0.f};
#pragma unroll
    for (int i = 0; i < 16; ++i) { LAS float* d = scr + (4 * i + kq) * 65 + n4; d[0] = v[i].x; d[1] = v[i].y; d[2] = v[i].z; d[3] = v[i].w; }
    asm volatile("s_waitcnt lgkmcnt(0)" ::: "memory");
    const int c = lane & 7, nl = lane >> 3;
    f32x4 s0 = (f32x4){1.f, 1.f, 1.f, 1.f}, s1 = s0;
    if (ksc) { s0 = *(const f32x4*)(ksc + k0 + 8 * c); s1 = *(const f32x4*)(ksc + k0 + 8 * c + 4); }
#pragma unroll
    for (int j = 0; j < 8; ++j) { const int n = nl + 8 * j; const LAS float* p = scr + (8 * c) * 65 + n;
        u32x4 o; o.x = pk2(p[0 * 65] * s0.x, p[1 * 65] * s0.y); o.y = pk2(p[2 * 65] * s0.z, p[3 * 65] * s0.w); o.z = pk2(p[4 * 65] * s1.x, p[5 * 65] * s1.y); o.w = pk2(p[6 * 65] * s1.z, p[7 * 65] * s1.w);
        *(u32x4*)(WT + (size_t)(drow0 + n) * K + k0 + 8 * c) = o; }
    asm volatile("s_waitcnt lgkmcnt(0)" ::: "memory");
}
DI int win_src(int nrow) {
    const int t = nrow >> 8, rr = nrow & 255, bj = rr >> 7, wc = (rr >> 5) & 3, c = rr & 31;
    if (t < 4) return (4 * t + wc) * 64 + ldim(32 * bj + c);
    if (t == 4) return (wc < 2 ? 1280 + wc * 64 : 1536 + (wc - 2) * 64) + ldim(32 * bj + c);
    if (t == 5) return rr < 128 ? 1024 + rr : 1152 + rr - 128;
    if (t == 6) return rr < 128 ? 1408 + rr : 1664 + rr - 128;
    if (t < 9) return 1840 + (4 * (t - 7) + wc) * 64 + 32 * bj + c;
    if (t < 11) return 2352 + (4 * (t - 9) + wc) * 64 + 32 * bj + c;
    if (t < 15) return 2864 + (t - 11) * 256 + rr;
    if (t < 19) return 3888 + (t - 15) * 256 + rr;
    return rr < 48 ? 1792 + rr : -1;
}
template <int SET>
DI void prep_transposes(const Args& a, LAS unsigned char* lds, int gw, int NGW, int wave, int lane) {
    unsigned char* ws = a.ws;
    LAS float* scr = (LAS float*)(lds + wave * 18432);
    constexpr int I0 = (5632 / 64) * 16, I1 = (1024 / 64) * (2816 / 64), I2 = (5120 / 64) * 16, I3 = (2048 / 64) * 16, I4 = 16 * 16, I9 = 4 * 32, I11 = 4;
    constexpr int NIT = SET == 0 ? I0 + I1 + I2 + I3 + 2 * I9 + 2 * I11 : I0 + I1 + 3 * I4;
    constexpr int L = SET;
    const int l4 = 4 * (lane & 15);
    for (int it = gw; it < NIT; it += NGW) {
        int r = it;
        if (r < I0) { const int nb = r / 16, kb = r % 16, nrow = nb * 64 + l4; const int tile = nrow >> 8, rr = nrow & 255;
            tr_item(a.in[(rr >> 7) ? (L ? 18 : 3) : (L ? 17 : 2)], FF, DM, (bf16_t*)(ws + (L ? WS_WGU2 : WS_WGU1)), nb * 64, 128 * tile + (rr & 127), a.in[L ? 16 : 1], kb * 64, scr, lane); continue; } r -= I0;
        if (r < I1) { const int nb = r / 44, kb = r % 44;
            tr_item(a.in[L ? 19 : 4], DM, FF, (bf16_t*)(ws + (L ? WS_WD2 : WS_WD1)), nb * 64, nb * 64 + l4, nullptr, kb * 64, scr, lane); continue; } r -= I1;
        if (SET == 1) { const int w = r / I4; r -= w * I4; const int nb = r / 16, kb = r % 16;
            tr_item(a.in[13 + w], DM, DM, (bf16_t*)(ws + (w == 0 ? WS_WN : (w == 1 ? WS_WR : WS_WO))), nb * 64, nb * 64 + l4, nullptr, kb * 64, scr, lane); continue; }
        if (r < I2) { const int nb = r / 16, kb = r % 16; tr_item(a.in[6], DIN, DM, (bf16_t*)(ws + WS_WIN), nb * 64, win_src(nb * 64 + l4), a.in[5], kb * 64, scr, lane); continue; } r -= I2;
        if (r < I3) { const int nb = r / 16, kb = r % 16; tr_item(a.in[6], DIN, DM, (bf16_t*)(ws + WS_WGM), nb * 64, 4912 + nb * 64 + l4, a.in[5], kb * 64, scr, lane); continue; } r -= I3;
        if (r < 2 * I9) { const int w = r / I9; r -= w * I9; const int nb = r / 32, kb = r % 32;
            tr_item(a.in[w ? 10 : 8], 256, 2048, (bf16_t*)(ws + (w ? WS_W1V : WS_W1K)), nb * 64, nb * 64 + l4, nullptr, kb * 64, scr, lane); continue; } r -= 2 * I9;
        { const int w = r / I11; r -= w * I11; const int kb = r;
            tr_item(a.in[w ? 11 : 9], 64, 256, (bf16_t*)(ws + (w ? WS_W2V : WS_W2K)), 0, w ? l4 : ldim(l4), nullptr, kb * 64, scr, lane); }
    }
}
DI void phase_prep(const Args& a, LAS unsigned char* lds, int gw, int NGW, int wave, int lane) {
    unsigned char* ws = a.ws;
    prep_transposes<0>(a, lds, gw, NGW, wave, lane);
    const float* x = a.in[0]; bf16_t* xb = (bf16_t*)(ws + WS_XB); float* ss1 = (float*)(ws + WS_SS1);
    for (int m0 = gw; m0 < T; m0 += 2 * NGW) {
        const int m1 = m0 + NGW;
        const bool two = m1 < T;
        const f32x4* xr0 = (const f32x4*)(x + (size_t)m0 * DM) + lane; const f32x4* xr1 = (const f32x4*)(x + (size_t)(two ? m1 : m0) * DM) + lane;
        f32x4 v0[4], v1[4]; float s0 = 0.f, s1 = 0.f;
#pragma unroll
        for (int j = 0; j < 4; ++j) { v0[j] = xr0[64 * j]; v1[j] = xr1[64 * j]; }
#pragma unroll
        for (int j = 0; j < 4; ++j) { s0 += (v0[j].x * v0[j].x + v0[j].y * v0[j].y) + (v0[j].z * v0[j].z + v0[j].w * v0[j].w); s1 += (v1[j].x * v1[j].x + v1[j].y * v1[j].y) + (v1[j].z * v1[j].z + v1[j].w * v1[j].w); }
        s0 = wave_sum(s0); s1 = wave_sum(s1);
        u32x2* o0 = (u32x2*)(xb + (size_t)m0 * DM) + lane; u32x2* o1 = (u32x2*)(xb + (size_t)m1 * DM) + lane;
#pragma unroll
        for (int j = 0; j < 4; ++j) { o0[64 * j] = (u32x2){pk2(v0[j].x, v0[j].y), pk2(v0[j].z, v0[j].w)}; if (two) o1[64 * j] = (u32x2){pk2(v1[j].x, v1[j].y), pk2(v1[j].z, v1[j].w)}; }
        if (lane == 0) { ss1[m0] = s0; ((float*)(ws + WS_SS2))[m0] = 0.f; ((float*)(ws + WS_SS3))[m0] = 0.f;
            if (two) { ss1[m1] = s1; ((float*)(ws + WS_SS2))[m1] = 0.f; ((float*)(ws + WS_SS3))[m1] = 0.f; } }
    }
    const int gt = gw * 64 + lane, NGT = NGW * 64;
    for (int e = gt; e < SEQ * 8; e += NGT) { const int pos = e >> 3, i = e & 7; const float fr = powf(500000.0f, -(float)i * 2.0f / 16.0f); const float ang = (float)pos * fr;
        ((float*)(ws + WS_COSN))[e] = cosf(ang); ((float*)(ws + WS_SINN))[e] = sinf(ang); }
    for (int e = gt; e < SEQ * 32; e += NGT) { const int pos = e >> 5, i = e & 31; const float fr = powf(10000.0f, -(float)i * 2.0f / 64.0f); const float ang = (float)pos * fr;
        ((float*)(ws + WS_COSR))[e] = cosf(ang); ((float*)(ws + WS_SINR))[e] = sinf(ang); }
    for (int o = gw; o < 256; o += NGW) { const int w = o >> 7, jg = (o >> 5) & 3, kc = o & 31; const float* W1 = a.in[w ? 10 : 8]; const float* pe = a.in[7]; float s = 0.f;
#pragma unroll 16
        for (int k = 0; k < 64; ++k) s += pe[kc * 64 + k] * W1[(size_t)(kc * 64 + k) * 256 + jg * 64 + lane];
        ((float*)(ws + WS_BPART))[(w * 32 + kc) * 256 + jg * 64 + lane] = s; }
    for (int e = gt; e < 2 * 8 * 64; e += NGT) { const int w = e >> 9, bg = (e >> 6) & 7, d = e & 63; ((bf16_t*)(ws + (w ? WS_VC : WS_KC)))[(bg * 256 + 255) * 64 + d] = 0; }
}

DI float gelu_tanh(float x) { const float u = 0.7978845608028654f * (x + 0.044715f * x * x * x); const float e = __expf(2.f * u); const float th = 1.f - 2.f * __builtin_amdgcn_rcpf(e + 1.f); return 0.5f * x * (1.f + th); }
DI void compress_item(const Args& a, LAS unsigned char* lds, int item, int tid, int wave, int lane) {
    unsigned char* ws = a.ws; const int r32 = lane & 31, hi = lane >> 5;
    const int mt = item & 63, kv = item >> 6;
    const bf16_t* KV = (const bf16_t*)(ws + WS_KV);
    const bf16_t* W1T = (const bf16_t*)(ws + (kv ? WS_W1V : WS_W1K)); const bf16_t* W2T = (const bf16_t*)(ws + (kv ? WS_W2V : WS_W2K));
    int m = mt * 32 + r32; if (m > 2039) m = 2039;
    const int bg = m / 255, nc = m % 255, b = bg >> 1, g = bg & 1;
    __syncthreads();
#pragma unroll
    for (int i = 0; i < 16; ++i) {
        const int e = i * 512 + tid, seg = e >> 3, ch = e & 7, mrow = seg >> 5, l = seg & 31;
        int m3 = mt * 32 + mrow; if (m3 > 2039) m3 = 2039;
        const int bg3 = m3 / 255, nc3 = m3 % 255;
        const u32x4 v = *(const u32x4*)(KV + (size_t)((bg3 >> 1) * SEQ + nc3 * 16 + l) * DM + 256 + kv * 128 + (bg3 & 1) * 64 + 8 * ch);
        *(LAS u32x4*)(lds + mrow * 4112 + l * 128 + ch * 16) = v;
    }
    const bf16_t* wsrc = W1T + (size_t)(32 * wave + r32) * 2048 + 8 * hi;
    const LAS unsigned char* bsrc = lds + r32 * 4112 + 16 * hi;
    __syncthreads();
    f32x16 h = {};
#pragma unroll 1
    for (int s0 = 0; s0 < 128; s0 += 16) {
        bf16x8 af[16], bfr[16];
#pragma unroll
        for (int j = 0; j < 16; ++j) af[j] = *(const bf16x8*)(wsrc + 16 * (s0 + j));
#pragma unroll
        for (int j = 0; j < 16; ++j) bfr[j] = *(const LAS bf16x8*)(bsrc + 32 * (s0 + j));
        __builtin_amdgcn_sched_barrier(0);
#pragma unroll
        for (int j = 0; j < 16; ++j) h = MFMA32(af[j], bfr[j], h);
    }
    LAS float* red = (LAS float*)lds;
    LAS float* biasL = (LAS float*)(lds + 65536);
    __syncthreads();
    if (tid < 256) { const float* bp = (const float*)(ws + WS_BPART) + kv * 32 * 256 + tid; float b = 0.f;
#pragma unroll
        for (int c = 0; c < 32; ++c) b += bp[c * 256];
        biasL[tid] = b; }
    __syncthreads();
#pragma unroll
    for (int i = 0; i < 16; ++i) h[i] = gelu_tanh(h[i] + biasL[32 * wave + crow(i, hi)]);
#pragma unroll
    for (int dt = 0; dt < 2; ++dt) {
        f32x16 o = {};
#pragma unroll
        for (int ks = 0; ks < 2; ++ks) {
            const bf16_t* wp = W2T + (size_t)(32 * dt + r32) * 256 + 32 * wave + 16 * ks + 4 * hi;
            const s16x4 lo = *(const s16x4*)wp, hh = *(const s16x4*)(wp + 8);
            o = MFMA32(cat8(lo, hh), pack8(h, ks), o);
        }
#pragma unroll
        for (int i = 0; i < 16; ++i) red[(wave * 64 + 32 * dt + crow(i, hi)) * 32 + r32] = o[i];
    }
    __syncthreads();
    {
        const int mm = tid & 31, dq = tid >> 5; const int d0 = 4 * dq;
        float s[4] = {0.f, 0.f, 0.f, 0.f}, ps[4] = {0.f, 0.f, 0.f, 0.f};
        const bool rot = (kv == 0) && (dq < 2 || dq == 8 || dq == 9);
#pragma unroll
        for (int w = 0; w < 8; ++w)
#pragma unroll
            for (int j = 0; j < 4; ++j) { s[j] += red[(w * 64 + d0 + j) * 32 + mm]; ps[j] += red[(w * 64 + ((d0 + j) ^ 32)) * 32 + mm]; }
        const int m2 = mt * 32 + mm;
        if (m2 < 2040) {
            const int bg2 = m2 / 255, nc2 = m2 % 255;
            if (rot) { const int pos = 16 * nc2 + 31; const float* cs = (const float*)(ws + WS_COSN) + pos * 8; const float* sn = (const float*)(ws + WS_SINN) + pos * 8;
#pragma unroll
                for (int j = 0; j < 4; ++j) { const int i = (d0 + j) & 7; s[j] = (d0 < 8) ? s[j] * cs[i] - ps[j] * sn[i] : s[j] * cs[i] + ps[j] * sn[i]; } }
            bf16_t* dst = (bf16_t*)(ws + (kv ? WS_VC : WS_KC)) + (size_t)(bg2 * 256 + nc2) * 64 + d0;
            *(u32x2*)dst = (u32x2){pk2(s[0], s[1]), pk2(s[2], s[3])};
        }
    }
    __syncthreads();
}

DI void retstate_item(const Args& a, LAS unsigned char* lds, int item, int tid, int wave, int lane) {
    unsigned char* ws = a.ws; const int r32 = lane & 31, hi = lane >> 5;
    const int bh = item >> 2, dvs = item & 3, b = bh >> 3, h = bh & 7;
    const bf16_t* Kp = (const bf16_t*)(ws + WS_QKR) + (size_t)b * SEQ * DM + 512 + 64 * h;
    const bf16_t* Vp = (const bf16_t*)(ws + WS_VR) + (size_t)b * SEQ * DM + 128 * h + 32 * dvs;
    bf16_t* Rp = (bf16_t*)(ws + WS_RP) + (size_t)bh * 32 * 8192;
    const float lg = __log2f(1.f - exp2f(-5.f - (float)h));
    const float g127 = exp2f(127.f * lg), g128 = exp2f(128.f * lg);
    struct RS { u32x4 k0, k1, v; };
    auto gload = [&](RS& r, int n) __attribute__((always_inline)) {
        { const int e = tid, row = e >> 3, ch = e & 7; r.k0 = *(const u32x4*)(Kp + (size_t)(n * 128 + row) * DM + 8 * ch); }
        { const int e = tid + 512, row = e >> 3, ch = e & 7; r.k1 = *(const u32x4*)(Kp + (size_t)(n * 128 + row) * DM + 8 * ch); }
        { const int row = tid >> 2, ch = tid & 3; r.v = *(const u32x4*)(Vp + (size_t)(n * 128 + row) * DM + 8 * ch); }
    };
    auto lwrite = [&](const RS& r, int buf) __attribute__((always_inline)) {
        LAS unsigned char* kb = lds + buf * 24576; LAS unsigned char* vb = kb + 16384;
        { const int e = tid, row = e >> 3, ch = e & 7; *(LAS u32x4*)(kb + ((ch >> 2) * 8 + (row >> 4)) * 1024 + (row & 15) * 64 + (ch & 3) * 16) = r.k0; }
        { const int e = tid + 512, row = e >> 3, ch = e & 7; *(LAS u32x4*)(kb + ((ch >> 2) * 8 + (row >> 4)) * 1024 + (row & 15) * 64 + (ch & 3) * 16) = r.k1; }
        { const int row = tid >> 2, ch = tid & 3; *(LAS u32x4*)(vb + (row >> 4) * 1024 + (row & 15) * 64 + ch * 16) = r.v; }
    };
    f32x16 R = {};
    const int troff = ((lane >> 4) & 1) * 32 + (lane & 3) * 8 + (4 * hi + ((lane & 15) >> 2)) * 64;
    auto body = [&](RS& r, const int n) __attribute__((always_inline)) {
        const int buf = n & 1;
        lwrite(r, buf);
        if (n + 4 < 32) gload(r, n + 4);
        __syncthreads();
        if (wave < 2) {
            bf16_t* rp = Rp + (size_t)n * 8192 + (size_t)(32 * dvs + r32) * 64 + 32 * wave + 4 * hi;
#pragma unroll
            for (int q = 0; q < 4; ++q) *(u32x2*)(rp + 8 * q) = (u32x2){pk2(R[4 * q], R[4 * q + 1]), pk2(R[4 * q + 2], R[4 * q + 3])};
            const LAS char* kb = (const LAS char*)(lds + buf * 24576) + troff; const LAS char* vb = (const LAS char*)(lds + buf * 24576 + 16384) + troff;
            f32x16 kvn = {};
#pragma unroll
            for (int ks = 0; ks < 8; ++ks) {
                const bf16x8 af = cat8(vtr(kb + (wave * 8 + ks) * 1024), vtr(kb + (wave * 8 + ks) * 1024 + 512));
                const bf16x8 bfv = cat8(vtr(vb + ks * 1024), vtr(vb + ks * 1024 + 512));
                kvn = MFMA32(af, bfv, kvn);
            }
#pragma unroll
            for (int i = 0; i < 16; ++i) R[i] = g128 * R[i] + g127 * kvn[i];
        }
    };
    RS r0, r1, r2, r3;
    __syncthreads();
    gload(r0, 0); gload(r1, 1); gload(r2, 2); gload(r3, 3);
#pragma unroll 1
    for (int n = 0; n < 32; n += 4) { body(r0, n); body(r1, n + 1); body(r2, n + 2); body(r3, n + 3); }
    __syncthreads();
}

constexpr int AT_K = 0, AT_V = 16384, AT_IMP = 32768, AT_SLAB = 64 * 33, AT_SEL = 32768 + 8 * AT_SLAB * 4;
struct TileRegs { u32x4 k, v; };
DI void at_gload(TileRegs& r, const bf16_t* Kb, const bf16_t* Vb, int pitch, int kt, int wave, int lane) {
    r.k = *(const u32x4*)(Kb + (size_t)(kt * 64 + lane) * pitch + wave * 8);
    r.v = *(const u32x4*)(Vb + (size_t)(kt * 64 + 16 * (wave & 3) + (lane >> 2)) * pitch + (wave >> 2) * 32 + (lane & 3) * 8);
}
DI void at_lwrite(const TileRegs& r, LAS unsigned char* lds, int buf, int wave, int lane) {
    *(LAS u32x4*)(lds + AT_K + buf * 8192 + wave * 1024 + lane * 16) = r.k;
    *(LAS u32x4*)(lds + AT_V + buf * 8192 + wave * 1024 + lane * 16) = r.v;
}
DI void at_qk(f32x16& p0, f32x16& p1, const LAS unsigned char* kslot, const bf16x8* qr, const f32x16& cinit, int r32, int hi) {
    const LAS unsigned char* kb = kslot + hi * 1024 + r32 * 16;
#pragma unroll
    for (int d0 = 0; d0 < 4; ++d0) {
        const bf16x8 b0 = *(const LAS bf16x8*)(kb + d0 * 2048), b1 = *(const LAS bf16x8*)(kb + d0 * 2048 + 512);
        if (d0 == 0) { p0 = MFMA32(b0, qr[0], cinit); p1 = MFMA32(b1, qr[0], cinit); }
        else { p0 = MFMA32(b0, qr[d0], p0); p1 = MFMA32(b1, qr[d0], p1); }
    }
}
DI void at_pv(f32x16* o, const LAS unsigned char* vslot, const f32x16& p0, const f32x16& p1, int lane, int hi) {
    const LAS char* vp = (const LAS char*)vslot + ((lane >> 4) & 1) * 32 + (lane & 3) * 8 + (4 * hi + ((lane & 15) >> 2)) * 64;
    const bf16x8 pa[4] = {pack8(p0, 0), pack8(p0, 1), pack8(p1, 0), pack8(p1, 1)};
#pragma unroll
    for (int dt = 0; dt < 2; ++dt)
#pragma unroll
        for (int ks = 0; ks < 4; ++ks) {
            const bf16x8 vf = cat8(vtr(vp + dt * 4096 + ks * 1024), vtr(vp + dt * 4096 + ks * 1024 + 512));
            o[dt] = MFMA32(vf, pa[ks], o[dt]);
        }
}
DI void at_pv2(f32x16* o, const s16x4* vl, const s16x4* vh, const f32x16& p0, const f32x16& p1) {
    const bf16x8 pa[4] = {pack8(p0, 0), pack8(p0, 1), pack8(p1, 0), pack8(p1, 1)};
    __builtin_amdgcn_sched_barrier(0);
#pragma unroll
    for (int ks = 0; ks < 4; ++ks) { o[0] = MFMA32(cat8(vl[ks], vh[ks]), pa[ks], o[0]); o[1] = MFMA32(cat8(vl[4 + ks], vh[4 + ks]), pa[ks], o[1]); }
}
DI float max32(const f32x16& p0, const f32x16& p1) {
    float a = fmaxf(fmaxf(p0[0], p0[1]), p1[0]), b = fmaxf(fmaxf(p0[2], p0[3]), p1[1]); a = fmaxf(fmaxf(a, p1[2]), p1[3]);
#pragma unroll
    for (int i = 4; i < 16; i += 4) { a = fmaxf(fmaxf(a, p0[i]), p0[i + 1]); b = fmaxf(fmaxf(b, p0[i + 2]), p0[i + 3]); a = fmaxf(fmaxf(a, p1[i]), p1[i + 1]); b = fmaxf(fmaxf(b, p1[i + 2]), p1[i + 3]); }
    const float mx = fmaxf(a, b);
    return xmax(mx);
}
DI float sum32(const f32x16& p0, const f32x16& p1) {
    const f32x16 sv = p0 + p1;
    const float a = (sv[0] + sv[1]) + (sv[2] + sv[3]), b = (sv[4] + sv[5]) + (sv[6] + sv[7]), c = (sv[8] + sv[9]) + (sv[10] + sv[11]), d = (sv[12] + sv[13]) + (sv[14] + sv[15]);
    const float t = (a + b) + (c + d);
    return xsum(t);
}
#ifndef PEXP
#define PEXP 7
#endif
template <int MODE, int EXP = 0>
DI void at_loop(LAS unsigned char* lds, const bf16_t* Kb, const bf16_t* Vb, int pitch, int first, int last, const bf16x8* qr, f32x16* o, float& mrun, float& lrun,
                int t0, unsigned long long selm, int tid, int wave, int lane, TileRegs& trA) {
    const int r32 = lane & 31, hi = lane >> 5; const int t = t0 + r32;
    const float NINF = -__builtin_inff(); constexpr float THR = 8.f;
    __syncthreads();
    float cref = -mrun; if (MODE == 1) cref = lrun > 0.f ? -(mrun + __log2f(lrun)) : 0.f;
    float carry = 0.f;
    auto step = [&](const int kt, TileRegs& tr, const int buf) __attribute__((always_inline)) {
        if (EXP != 3) at_lwrite(tr, lds, buf, wave, lane);
        if (kt + 1 <= last) at_gload(tr, Kb, Vb, pitch, kt + 1, wave, lane);
        if (EXP != 3) __syncthreads();
        f32x16 p0, p1;
        {
            float c = cref; if (MODE == 2) { const bool sel = (selm >> kt) & 1ull; c = sel ? cref : NINF; }
            f32x16 ci;
#pragma unroll
            for (int i = 0; i < 16; ++i) ci[i] = c;
            const LAS unsigned char* kb = lds + AT_K + buf * 8192 + hi * 1024 + r32 * 16;
            bf16x8 kf[8];
#pragma unroll
            for (int d0 = 0; d0 < 4; ++d0) { kf[2 * d0] = *(const LAS bf16x8*)(kb + d0 * 2048); kf[2 * d0 + 1] = *(const LAS bf16x8*)(kb + d0 * 2048 + 512); }
            __builtin_amdgcn_sched_barrier(0);
            if (EXP == 4) { p0 = ci; p1 = ci; p0[0] += __builtin_bit_cast(float, (int)kf[0][0] + (int)kf[7][3]); } else {
            p0 = MFMA32(kf[0], qr[0], ci); p1 = MFMA32(kf[1], qr[0], ci);
#pragma unroll
            for (int d0 = 1; d0 < 4; ++d0) { p0 = MFMA32(kf[2 * d0], qr[d0], p0); p1 = MFMA32(kf[2 * d0 + 1], qr[d0], p1); } }
            __builtin_amdgcn_sched_barrier(0);
        }
        s16x4 vl[8], vh[8];
        if (MODE != 0 && EXP != 2) {
            const LAS char* vp = (const LAS char*)(lds + AT_V + buf * 8192) + ((lane >> 4) & 1) * 32 + (lane & 3) * 8 + (4 * hi + ((lane & 15) >> 2)) * 64;
#pragma unroll
            for (int i = 0; i < 8; ++i) { vl[i] = vtr(vp + (i >> 2) * 4096 + (i & 3) * 1024); vh[i] = vtr(vp + (i >> 2) * 4096 + (i & 3) * 1024 + 512); }
            __builtin_amdgcn_sched_barrier(0);
        }
        if (MODE <= 1) {
            if (16 * (64 * kt + 63) + 31 > t0) {
#pragma unroll
                for (int i = 0; i < 16; ++i) { const int n0 = 64 * kt + crow(i, hi); if (16 * n0 + 31 > t) p0[i] = NINF; if (16 * (n0 + 32) + 31 > t) p1[i] = NINF; }
            }
        } else if (MODE == 2) {
            if (kt == last) {
#pragma unroll
                for (int i = 0; i < 16; ++i) { const int k0 = 64 * kt + crow(i, hi); if (k0 > t) p0[i] = NINF; if (k0 + 32 > t) p1[i] = NINF; }
            }
        } else {
            if (kt == last || 64 * kt + 512 <= t0 + 31) {
#pragma unroll
                for (int i = 0; i < 16; ++i) { const int k0 = 64 * kt + crow(i, hi); if (k0 > t || t - k0 >= 512) p0[i] = NINF; if (k0 + 32 > t || t - k0 - 32 >= 512) p1[i] = NINF; }
            }
        }
        if (MODE == 1) {
#pragma unroll
            for (int i = 0; i < 16; ++i) { p0[i] = __builtin_amdgcn_exp2f(p0[i]); p1[i] = __builtin_amdgcn_exp2f(p1[i]); }
            LAS float* slab = (LAS float*)(lds + AT_IMP) + wave * AT_SLAB + r32;
            float av[2][4], rb[2][4];
#pragma unroll
            for (int hf = 0; hf < 2; ++hf)
#pragma unroll
                for (int gq = 0; gq < 4; ++gq) {
                    const f32x16& x = hf ? p1 : p0;
                    const float bb = 0.5f * x[4 * gq + 3]; av[hf][gq] = x[4 * gq] + x[4 * gq + 1] + x[4 * gq + 2] + bb; rb[hf][gq] = xhalf(bb);
                }
#pragma unroll
            for (int hf = 0; hf < 2; ++hf)
#pragma unroll
                for (int gq = 0; gq < 4; ++gq) {
                    const float prevrb = gq > 0 ? rb[hf][gq - 1] : (hf == 1 ? rb[0][3] : carry);
                    const int s = 16 * kt + 8 * hf + 2 * gq + hi;
                    slab[s * 33] = av[hf][gq] + (hi ? rb[hf][gq] : prevrb);
                }
            carry = rb[1][3];
            at_pv2(o, vl, vh, p0, p1);
        } else {
            const float tm = max32(p0, p1);
            const bool mv = (tm > THR) || (lrun == 0.f && tm > NINF);
            if (__any(mv)) {
                const float d = mv ? tm : 0.f;
                const float alpha = (lrun == 0.f) ? 1.f : __builtin_amdgcn_exp2f(-d);
                mrun += d; lrun *= alpha;
#pragma unroll
                for (int i = 0; i < 16; ++i) { p0[i] -= d; p1[i] -= d; }
                cref = -mrun;
                if (MODE != 0) {
#pragma unroll
                    for (int i = 0; i < 16; ++i) { o[0][i] *= alpha; o[1][i] *= alpha; }
                }
            }
            if (MODE == 0) {
#pragma unroll
                for (int i = 0; i < 16; ++i) { p0[i] = __builtin_amdgcn_exp2f(p0[i]); p1[i] = __builtin_amdgcn_exp2f(p1[i]); }
                lrun += sum32(p0, p1);
            } else {
                float ls[4];
#pragma unroll
                for (int ks = 0; ks < 4; ++ks) {
                    f32x16& x = (ks < 2) ? p0 : p1; const int r0 = 8 * (ks & 1);
#pragma unroll
                    for (int i = 0; i < 8; ++i) x[r0 + i] = __builtin_amdgcn_exp2f(x[r0 + i]);
                    ls[ks] = ((x[r0] + x[r0 + 1]) + (x[r0 + 2] + x[r0 + 3])) + ((x[r0 + 4] + x[r0 + 5]) + (x[r0 + 6] + x[r0 + 7]));
                    const bf16x8 pa = pack8(x, ks & 1);
                    o[0] = MFMA32(cat8(vl[ks], vh[ks]), pa, o[0]); o[1] = MFMA32(cat8(vl[4 + ks], vh[4 + ks]), pa, o[1]);
                }
                lrun += xsum((ls[0] + ls[1]) + (ls[2] + ls[3]));
            }
        }
    };
    for (int kt = first; kt <= last; kt += 2) {
        step(kt, trA, 0);
        if (kt + 1 <= last) step(kt + 1, trA, 1);
    }
}
template <bool ADD> DI void nsa_accum(bf16_t* aout, const f32x16* o, float f) {
    u32x2 wv[8];
    if (ADD) {
#pragma unroll
        for (int i = 0; i < 8; ++i) wv[i] = *(const u32x2*)(aout + 32 * (i >> 2) + 8 * (i & 3));
        __builtin_amdgcn_sched_barrier(0);
    }
#pragma unroll
    for (int dt = 0; dt < 2; ++dt)
#pragma unroll
        for (int q = 0; q < 4; ++q) {
            u32x2* p = (u32x2*)(aout + 32 * dt + 8 * q);
            float v0 = f * o[dt][4 * q], v1 = f * o[dt][4 * q + 1], v2 = f * o[dt][4 * q + 2], v3 = f * o[dt][4 * q + 3];
            if (ADD) { const u32x2 w = wv[dt * 4 + q]; v0 += bflo(w.x); v1 += bfhi(w.x); v2 += bflo(w.y); v3 += bfhi(w.y); }
            *p = (u32x2){pk2(v0, v1), pk2(v2, v3)};
        }
}
template <int EXP = 0> DI void nsa_item(const Args& a, LAS unsigned char* lds, int item, int tid, int wave, int lane, bool dry = false) {
    unsigned char* ws = a.ws; const int r32 = lane & 31, hi = lane >> 5;
    const int bg = item >> 7, qt = item & 127, b = bg >> 1, g = bg & 1; const int t0 = qt * 32, cur = t0 >> 6;
    bf16_t* QA = (bf16_t*)(ws + WS_QA); const bf16_t* KV = (const bf16_t*)(ws + WS_KV);
    const size_t tokrow = (size_t)(b * SEQ + t0 + r32) * DM; const int head = g * 8 + wave;
    bf16x8 qr[4];
#pragma unroll
    for (int d0 = 0; d0 < 4; ++d0) qr[d0] = *(const bf16x8*)(QA + tokrow + head * 64 + 16 * d0 + 8 * hi);
    float gate[3];
#pragma unroll
    for (int j = 0; j < 3; ++j) gate[j] = bf2f(KV[tokrow + 768 + head * 3 + j]);
    { LAS float* z = (LAS float*)(lds + AT_IMP) + wave * AT_SLAB;
#pragma unroll
      for (int i = 0; i < 33; ++i) z[lane + 64 * i] = 0.f; }
    f32x16 o[2];
    bf16_t* aout = QA + tokrow + head * 64 + 4 * hi;
    const bf16_t* KC = (const bf16_t*)(ws + WS_KC) + (size_t)bg * 256 * 64; const bf16_t* VC = (const bf16_t*)(ws + WS_VC) + (size_t)bg * 256 * 64;
    const int lastc = (t0 >> 4) >> 6;
    float mrun = 0.f, lrun = 0.f;
    TileRegs tr0;
    at_gload(tr0, KC, VC, 64, 0, wave, lane);
    if (EXP != 7) at_loop<0>(lds, KC, VC, 64, 0, lastc, qr, o, mrun, lrun, t0, 0ull, tid, wave, lane, tr0);
    o[0] = (f32x16){}; o[1] = (f32x16){};
    at_gload(tr0, KC, VC, 64, 0, wave, lane);
    if (EXP != 7 && EXP != 8) at_loop<1>(lds, KC, VC, 64, 0, lastc, qr, o, mrun, lrun, t0, 0ull, tid, wave, lane, tr0);
    const bf16_t* Ks = KV + (size_t)b * SEQ * DM + 64 * g; const bf16_t* Vs = KV + (size_t)b * SEQ * DM + 512 + 64 * g;
    at_gload(tr0, Ks, Vs, DM, 0, wave, lane);
    if (!(dry && a.ph_lo != 12345)) nsa_accum<false>(aout, o, gate[0]);
    __syncthreads();
    if (EXP >= 6) { if (lane == 0) { for (int qi = 0; qi < 4; ++qi) *(LAS unsigned long long*)(lds + AT_SEL + (4 * wave + qi) * 8) = ~0ull; } }
    else {
        const LAS float* imp = (const LAS float*)(lds + AT_IMP);
#pragma unroll 1
        for (int qi = 0; qi < 4; ++qi) {
            const int q = 4 * wave + qi; float v = 0.f;
#pragma unroll
            for (int w = 0; w < 8; ++w) v += imp[w * AT_SLAB + lane * 33 + q];
            const int s = lane;
            if (s == 0 || s == cur || s == cur - 1) v = 1.0e4f; else if (s > cur) v = -1.0e4f;
            typedef unsigned long long u64x2_t __attribute__((ext_vector_type(2)));
            const unsigned vb = __builtin_bit_cast(unsigned, v); const unsigned key = (vb >> 31) ? ~vb : (vb | 0x80000000u);
            const unsigned long long K = ((unsigned long long)key << 32) | (unsigned)(63 - lane);
            LAS unsigned long long* tk = (LAS unsigned long long*)(lds + AT_SEL + 256) + wave * 64;
            tk[lane] = K;
            u64x2_t rr[32];
#pragma unroll
            for (int j = 0; j < 32; ++j) rr[j] = *(const LAS u64x2_t*)(tk + 2 * j);
            int rank = 0;
#pragma unroll
            for (int j = 0; j < 32; ++j) { rank += (rr[j].x > K) ? 1 : 0; rank += (rr[j].y > K) ? 1 : 0; }
            const unsigned long long mk = __ballot(rank < 16 && s <= cur);
            if (lane == 0) *(LAS unsigned long long*)(lds + AT_SEL + q * 8) = mk;
        }
    }
    __syncthreads();
    const unsigned long long selm = *(const LAS unsigned long long*)(lds + AT_SEL + r32 * 8);
    const bf16_t* Kw = KV + (size_t)b * SEQ * DM + 128 + 64 * g; const bf16_t* Vw = KV + (size_t)b * SEQ * DM + 640 + 64 * g;
    const int firstw = t0 >= 511 ? (t0 - 511) >> 6 : 0;
    {
        mrun = 0.f; lrun = 0.f; o[0] = (f32x16){}; o[1] = (f32x16){};
        if (EXP < 5) at_loop<2, EXP>(lds, Ks, Vs, DM, 0, cur, qr, o, mrun, lrun, t0, selm, tid, wave, lane, tr0);
        const float f = gate[1] * (lrun > 0.f ? 1.f / lrun : 0.f);
        at_gload(tr0, Kw, Vw, DM, firstw, wave, lane);
        if (!(dry && a.ph_lo != 12345)) nsa_accum<true>(aout, o, f);
    }
    {
        mrun = 0.f; lrun = 0.f; o[0] = (f32x16){}; o[1] = (f32x16){};
        if (EXP < 5) at_loop<3, EXP>(lds, Kw, Vw, DM, firstw, cur, qr, o, mrun, lrun, t0, 0ull, tid, wave, lane, tr0);
        const float f = gate[2] * (lrun > 0.f ? 1.f / lrun : 0.f);
        if (!(dry && a.ph_lo != 12345)) nsa_accum<true>(aout, o, f);
    }
}

DI void retout_item(const Args& a, LAS unsigned char* lds, int item, int tid, int wave, int lane, bool dry = false) {
    unsigned char* ws = a.ws; const int r32 = lane & 31, hi = lane >> 5;
    const int half = wave >> 2, ww = wave & 3, tl = tid & 255;
    const int chunk = item * 2 + half;
    const int bh = chunk >> 5, n = chunk & 31, b = bh >> 3, h = bh & 7;
    const size_t row0 = (size_t)b * SEQ + n * 128;
    const bf16_t* QKR = (const bf16_t*)(ws + WS_QKR); bf16_t* VR = (bf16_t*)(ws + WS_VR); const bf16_t* GR = (const bf16_t*)(ws + WS_GR);
    const bf16_t* Rp = (const bf16_t*)(ws + WS_RP) + (size_t)chunk * 8192;
    LAS unsigned char* vimg = lds + half * 32768;
    __syncthreads();
    { u32x4 vv[8];
#pragma unroll
      for (int it = 0; it < 8; ++it) { const int e = it * 256 + tl, key = e >> 4, ch = e & 15; vv[it] = *(const u32x4*)(VR + (row0 + key) * DM + 128 * h + 8 * ch); }
      __builtin_amdgcn_sched_barrier(0);
#pragma unroll
      for (int it = 0; it < 8; ++it) { const int e = it * 256 + tl, key = e >> 4, ch = e & 15;
        *(LAS u32x4*)(vimg + ((ch >> 2) * 8 + (key >> 4)) * 1024 + (key & 15) * 64 + (ch & 3) * 16) = vv[it]; } }
    const float lg = __log2f(1.f - exp2f(-5.f - (float)h)); const float gam = exp2f(lg);
    bf16x8 qr[4];
    const bf16_t* qp = QKR + (row0 + 32 * ww + r32) * DM + 64 * h + 8 * hi;
#pragma unroll
    for (int d0 = 0; d0 < 4; ++d0) qr[d0] = *(const bf16x8*)(qp + 16 * d0);
    f32x16 o[4];
#pragma unroll
    for (int dh = 0; dh < 2; ++dh) { bf16x8 rf[8];
#pragma unroll
      for (int i = 0; i < 8; ++i) rf[i] = *(const bf16x8*)(Rp + (size_t)(32 * (2 * dh + (i >> 2)) + r32) * 64 + 8 * hi + 16 * (i & 3));
      __builtin_amdgcn_sched_barrier(0);
#pragma unroll
      for (int d2 = 0; d2 < 2; ++d2) { const int dt = 2 * dh + d2; o[dt] = (f32x16){};
#pragma unroll
        for (int d0 = 0; d0 < 4; ++d0) o[dt] = MFMA32(rf[d2 * 4 + d0], qr[d0], o[dt]);
#pragma unroll
        for (int i = 0; i < 16; ++i) o[dt][i] *= gam; } }
    __syncthreads();
    const LAS char* vp = (const LAS char*)vimg + ((lane >> 4) & 1) * 32 + (lane & 3) * 8 + (4 * hi + ((lane & 15) >> 2)) * 64;
    for (int jt = 0; jt <= ww; ++jt) {
        f32x16 p = {};
        const bf16_t* kp = QKR + (row0 + 32 * jt + r32) * DM + 512 + 64 * h + 8 * hi;
        bf16x8 kfr[4];
#pragma unroll
        for (int d0 = 0; d0 < 4; ++d0) kfr[d0] = *(const bf16x8*)(kp + 16 * d0);
        __builtin_amdgcn_sched_barrier(0);
#pragma unroll
        for (int d0 = 0; d0 < 4; ++d0) p = MFMA32(kfr[d0], qr[d0], p);
        if (jt == ww) {
#pragma unroll
            for (int i = 0; i < 16; ++i) if (crow(i, hi) > r32) p[i] = 0.f;
        }
        const bf16x8 pa0 = pack8(p, 0), pa1 = pack8(p, 1);
#pragma unroll
        for (int dt = 0; dt < 4; ++dt) {
            const LAS char* v0 = vp + (dt * 8 + 2 * jt) * 1024;
            o[dt] = MFMA32(cat8(vtr(v0), vtr(v0 + 512)), pa0, o[dt]);
            o[dt] = MFMA32(cat8(vtr(v0 + 1024), vtr(v0 + 1536)), pa1, o[dt]);
        }
    }
    float s = 0.f;
#pragma unroll
    for (int dt = 0; dt < 4; ++dt)
#pragma unroll
        for (int i = 0; i < 16; ++i) s += o[dt][i];
    s = xsum(s); const float mu = s * (1.f / 128.f); float q2 = 0.f;
#pragma unroll
    for (int dt = 0; dt < 4; ++dt)
#pragma unroll
        for (int i = 0; i < 16; ++i) { const float d = o[dt][i] - mu; q2 += d * d; }
    q2 = xsum(q2); const float rstd = rsqrtf(q2 * (1.f / 128.f) + GN_EPS);
    const float* gn = a.in[12] + 128 * h;
    const size_t orow = (row0 + 32 * ww + r32) * DM + 128 * h;
    __syncthreads();
    if (dry && a.ph_lo != 12345) return;
#pragma unroll
    for (int dh = 0; dh < 2; ++dh) {
        f32x4 ggv[8]; u32x2 gwv[8];
#pragma unroll
        for (int i = 0; i < 8; ++i) { const int dv = 32 * (2 * dh + (i >> 2)) + 8 * (i & 3) + 4 * hi; ggv[i] = *(const f32x4*)(gn + dv); gwv[i] = *(const u32x2*)(GR + orow + dv); }
        __builtin_amdgcn_sched_barrier(0);
#pragma unroll
        for (int d2 = 0; d2 < 2; ++d2)
#pragma unroll
            for (int q = 0; q < 4; ++q) {
                const int dt = 2 * dh + d2; const int dv = 32 * dt + 8 * q + 4 * hi;
                const f32x4 gg = ggv[d2 * 4 + q]; const u32x2 gw = gwv[d2 * 4 + q];
                const float r0 = (o[dt][4 * q] - mu) * rstd * gg[0] * bflo(gw.x), r1 = (o[dt][4 * q + 1] - mu) * rstd * gg[1] * bfhi(gw.x);
                const float r2 = (o[dt][4 * q + 2] - mu) * rstd * gg[2] * bflo(gw.y), r3 = (o[dt][4 * q + 3] - mu) * rstd * gg[3] * bfhi(gw.y);
                *(u32x2*)(VR + orow + dv) = (u32x2){pk2(r0, r1), pk2(r2, r3)};
            }
    }
}

#define XB_TMO      128
#define XB_XCNT(j)  (256  + 64 * (j))
#define XB_XSUB(j)  (1280 + 64 * (j))
#define XB_XGEN(j)  (2304 + 64 * (j))
#define XB_TOP      3328
#define XB_TOPGEN   3392
#define XCD_BAR_WORDS 3456
#define XB_SPIN_CAP (1u << 22)
DI unsigned xb_ld(unsigned* p)              { return __hip_atomic_load(p, __ATOMIC_RELAXED, __HIP_MEMORY_SCOPE_AGENT); }
DI unsigned xb_add(unsigned* p, unsigned v) { return __hip_atomic_fetch_add(p, v, __ATOMIC_RELAXED, __HIP_MEMORY_SCOPE_AGENT); }
DI unsigned xb_xcc_id() { return (unsigned)__builtin_amdgcn_s_getreg((3 << 11) | 20) & 0xFu; }
#define XB_SPIN(cond, bar) do { unsigned _sp = 0; while (cond) { __builtin_amdgcn_s_sleep(1); \
    if ((++_sp & 255u) == 0u) { if (xb_ld(&(bar)[XB_TMO])) break; if (_sp > XB_SPIN_CAP) { atomicAdd(&(bar)[XB_TMO], 1u); break; } } } } while (0)
struct XcdBarrier { unsigned* bar; unsigned x; volatile LAS unsigned* st; };
DI XcdBarrier xcd_barrier_post(unsigned* bar, volatile LAS unsigned* st) {
    XcdBarrier b; b.bar = bar; b.x = xb_xcc_id(); b.st = st;
    if (threadIdx.x == 0) (void)xb_add(&bar[XB_XCNT(b.x)], 1u);
    return b;
}
DI void xcd_barrier_complete(unsigned* bar, unsigned x, unsigned& nloc, unsigned& nx) {
    const unsigned G = gridDim.x * gridDim.y * gridDim.z;
    unsigned sum, cnt, mine, sp = 0u;
    for (;;) {
        sum = 0u; cnt = 0u; mine = 0u;
#pragma unroll
        for (unsigned j = 0; j < 16; ++j) { const unsigned c = xb_ld(&bar[XB_XCNT(j)]); sum += c; cnt += (c > 0u) ? 1u : 0u; mine = (j == x) ? c : mine; }
        if (sum == G) break;
        __builtin_amdgcn_s_sleep(1);
        if ((++sp & 255u) == 0u) { if (xb_ld(&bar[XB_TMO])) break; if (sp > XB_SPIN_CAP) { atomicAdd(&bar[XB_TMO], 1u); break; } }
    }
    nloc = mine > 0u ? mine : 1u; nx = cnt > 0u ? cnt : 1u;
}
DI void xcd_barrier(const XcdBarrier& b) {
    asm volatile("s_waitcnt vmcnt(0)" ::: "memory");
    __syncthreads();
    if (threadIdx.x == 0) {
        unsigned* bar = b.bar;
        __builtin_amdgcn_s_waitcnt(0);
        unsigned nloc = b.st[0], nx = b.st[1];
        if (nloc == 0u) { xcd_barrier_complete(bar, b.x, nloc, nx); b.st[0] = nloc; b.st[1] = nx; }
        const unsigned old = xb_add(&bar[XB_XSUB(b.x)], 1u);
        const unsigned gen = old / nloc;
        if (old + 1u == (gen + 1u) * nloc) {
            __builtin_amdgcn_fence(__ATOMIC_RELEASE, "agent");
            asm volatile("s_waitcnt vmcnt(0)" ::: "memory");
            const unsigned og = xb_add(&bar[XB_TOP], 1u);
            const unsigned tg = og / nx;
            if (og + 1u == (tg + 1u) * nx) xb_add(&bar[XB_TOPGEN], 1u);
            else XB_SPIN(xb_ld(&bar[XB_TOPGEN]) == tg, bar);
            __builtin_amdgcn_fence(__ATOMIC_ACQUIRE, "agent");
            xb_add(&bar[XB_XGEN(b.x)], 1u);
            asm volatile("s_waitcnt vmcnt(0)" ::: "memory");
        } else {
            XB_SPIN(xb_ld(&bar[XB_XGEN(b.x)]) == gen, bar);
            __builtin_amdgcn_fence(__ATOMIC_ACQUIRE, "agent");
            asm volatile("s_waitcnt vmcnt(0)" ::: "memory");
        }
    }
    __syncthreads();
}

__global__ void __launch_bounds__(512, 2) fwd_mega(Args args) {
    extern __shared__ __attribute__((aligned(16))) unsigned char lds_raw[];
    LAS unsigned char* lds = (LAS unsigned char*)lds_raw;
    cg::grid_group grid = cg::this_grid();
    const int tid = threadIdx.x, lane = tid & 63, wave = __builtin_amdgcn_readfirstlane(tid >> 6);
    const int G = gridDim.x, bx = blockIdx.x;
    const int gw = bx * 8 + wave, NGW = G * 8;
    unsigned char* ws = args.ws;
    const int lo = args.ph_lo, hi_ = args.ph_hi;
#define IN(k) (lo <= (k) && (k) < hi_)
    volatile LAS unsigned* bst = (volatile LAS unsigned*)(lds + LDS_BYTES - 64);
    if (tid < 16) bst[tid] = 0u;
    __syncthreads();
    XcdBarrier xbar = xcd_barrier_post((unsigned*)(ws + WS_BAR), bst);
    if (args.ph_lo == 12345) grid.sync();
#define SEAM(k) do { if (IN(k) && IN((k) + 1)) xcd_barrier(xbar); } while (0)
    float* ss1 = (float*)(ws + WS_SS1); float* ss2 = (float*)(ws + WS_SS2); float* ss3 = (float*)(ws + WS_SS3);
    bf16_t* XB = (bf16_t*)(ws + WS_XB); bf16_t* ACT = (bf16_t*)(ws + WS_ACT);

#ifndef PROBE
#define PROBE 0
#endif
    if (IN(0)) phase_prep(args, lds, gw, NGW, wave, lane);
    if (PROBE == 5) { xcd_barrier(xbar); phase_prep(args, lds, gw, NGW, wave, lane); }
    if (PROBE == 4) { for (int i = 0; i < 10; ++i) xcd_barrier(xbar); }
    SEAM(0);

    if (IN(1)) {
#pragma unroll 1
        for (int rep = 0; rep < (PROBE == 1 ? 2 : 1); ++rep) {
        pg8::Gemm g{XB, (const bf16_t*)(ws + WS_WGU1), DM, DM, nullptr, nullptr}; pg8::StaticOrder S; S.init(T, 2 * FF, G, bx);
        pg8::EpiSwiGLU E{ACT, ss1}; pg8::gemm_phase(lds, g, S, E);
        }
        { const int nfull = (22 * 64) % G;
          if (nfull > 0 && nfull < G) { if (bx >= nfull) prep_transposes<1>(args, lds, (bx - nfull) * 8 + wave, (G - nfull) * 8, wave, lane); }
          else prep_transposes<1>(args, lds, gw, NGW, wave, lane); }
    }
    SEAM(1);
    if (IN(2)) {
        pg8::Gemm g{ACT, (const bf16_t*)(ws + WS_WD1), FF, FF, nullptr, nullptr}; pg8::StaticOrder S; S.init(T, DM, G, bx);
        pg8::EpiResid<true, false, true, true> E{nullptr, XB, nullptr, XB, ss2, 0.5f}; pg8::gemm_phase(lds, g, S, E);
    }
    SEAM(2);
    if (IN(3)) {
        pg8::Gemm g{XB, (const bf16_t*)(ws + WS_WIN), DM, DM, nullptr, nullptr}; pg8::StaticOrder S; S.init(T, 5120, G, bx);
        pg8::EpiProj E{(bf16_t*)(ws + WS_QA), (bf16_t*)(ws + WS_KV), (bf16_t*)(ws + WS_QKR), (bf16_t*)(ws + WS_VR), (bf16_t*)(ws + WS_GR), ss2,
                       (const float*)(ws + WS_COSN), (const float*)(ws + WS_SINN), (const float*)(ws + WS_COSR), (const float*)(ws + WS_SINR)};
        pg8::gemm_phase(lds, g, S, E);
    }
    SEAM(3);
    if (IN(4)) {
        if (PROBE == 2) { for (int it = bx; it < 256; it += G) { if (it < 128) compress_item(args, lds, it, tid, wave, lane); else retstate_item(args, lds, it - 128, tid, wave, lane); } }
        for (int it = bx; it < 256; it += G) { if (it < 128) compress_item(args, lds, it, tid, wave, lane); else retstate_item(args, lds, it - 128, tid, wave, lane); }
    }
    SEAM(4);
    if (IN(5)) {
        for (int vc = bx; vc < 256; vc += G) {
            const int bg = vc >> 5, j = vc & 31;
            const int qts[4] = {127 - j, 64 + j, 63 - j, j};
            if (PROBE == 3) {
#pragma unroll 1
                for (int i = 0; i < 4; ++i) nsa_item<PEXP>(args, lds, bg * 128 + qts[i], tid, wave, lane, true);
            }
#pragma unroll 1
            for (int i = 0; i < 4; ++i) nsa_item(args, lds, bg * 128 + qts[i], tid, wave, lane);
            if (PROBE == 6) {
#pragma unroll 1
                for (int i = 0; i < 2; ++i) retout_item(args, lds, vc * 2 + i, tid, wave, lane, true);
            }
#pragma unroll 1
            for (int i = 0; i < 2; ++i) retout_item(args, lds, vc * 2 + i, tid, wave, lane);
        }
    }
    SEAM(5);
    if (IN(6)) {
        { pg8::Gemm g{XB, (const bf16_t*)(ws + WS_WGM), DM, DM, nullptr, nullptr}; pg8::GateOrder S; S.S.init(T, DM, G, bx);
          pg8::EpiGate E{(bf16_t*)(ws + WS_GATEA), (bf16_t*)(ws + WS_GATER), ss2}; pg8::gemm_phase(lds, g, S, E); }
        { pg8::Gemm g{(const bf16_t*)(ws + WS_QA), (const bf16_t*)(ws + WS_WN), DM, DM, (const bf16_t*)(ws + WS_VR), (const bf16_t*)(ws + WS_WR)};
          pg8::PairOrder S; S.S.init(T, DM, G, bx);
          pg8::EpiMixFused E{(const bf16_t*)(ws + WS_GATEA), (const bf16_t*)(ws + WS_GATER), (bf16_t*)(ws + WS_MIX)}; pg8::gemm_phase(lds, g, S, E); }
    }
    SEAM(6);
    if (IN(7)) {
        pg8::Gemm g{(const bf16_t*)(ws + WS_MIX), (const bf16_t*)(ws + WS_WO), DM, DM, nullptr, nullptr}; pg8::StaticOrder S; S.init(T, DM, G, bx);
        pg8::EpiResid<true, false, true, true> E{nullptr, XB, nullptr, XB, ss3, 1.0f}; pg8::gemm_phase(lds, g, S, E);
    }
    SEAM(7);
    if (IN(8)) {
        pg8::Gemm g{XB, (const bf16_t*)(ws + WS_WGU2), DM, DM, nullptr, nullptr}; pg8::StaticOrder S; S.init(T, 2 * FF, G, bx);
        pg8::EpiSwiGLU E{ACT, ss3}; pg8::gemm_phase(lds, g, S, E);
    }
    SEAM(8);
    if (IN(9)) {
        pg8::Gemm g{ACT, (const bf16_t*)(ws + WS_WD2), FF, FF, nullptr, nullptr}; pg8::StaticOrder S; S.init(T, DM, G, bx);
        pg8::EpiResid<true, false, true, false> E{nullptr, XB, nullptr, XB, nullptr, 0.5f}; pg8::gemm_phase(lds, g, S, E);
    }
    SEAM(9);
    if (IN(10)) {
        const float* gf = args.in[20];
        f32x4 gg[2][2];
#pragma unroll
        for (int j = 0; j < 2; ++j) { gg[j][0] = *(const f32x4*)(gf + 512 * j + 8 * lane); gg[j][1] = *(const f32x4*)(gf + 512 * j + 8 * lane + 4); }
        for (int m0 = gw; m0 < T; m0 += 2 * NGW) {
            const int m1 = (m0 + NGW < T) ? m0 + NGW : m0;
            u32x4 w0[2], w1[2];
#pragma unroll
            for (int j = 0; j < 2; ++j) { w0[j] = *(const u32x4*)(XB + (size_t)m0 * DM + 512 * j + 8 * lane); w1[j] = *(const u32x4*)(XB + (size_t)m1 * DM + 512 * j + 8 * lane); }
            f32x4 a0[2][2], a1[2][2]; float s0 = 0.f, s1 = 0.f;
#pragma unroll
            for (int j = 0; j < 2; ++j) {
                a0[j][0] = (f32x4){bflo(w0[j].x), bfhi(w0[j].x), bflo(w0[j].y), bfhi(w0[j].y)}; a0[j][1] = (f32x4){bflo(w0[j].z), bfhi(w0[j].z), bflo(w0[j].w), bfhi(w0[j].w)};
                a1[j][0] = (f32x4){bflo(w1[j].x), bfhi(w1[j].x), bflo(w1[j].y), bfhi(w1[j].y)}; a1[j][1] = (f32x4){bflo(w1[j].z), bfhi(w1[j].z), bflo(w1[j].w), bfhi(w1[j].w)};
#pragma unroll
                for (int h = 0; h < 2; ++h) { s0 += (a0[j][h].x * a0[j][h].x + a0[j][h].y * a0[j][h].y) + (a0[j][h].z * a0[j][h].z + a0[j][h].w * a0[j][h].w);
                                              s1 += (a1[j][h].x * a1[j][h].x + a1[j][h].y * a1[j][h].y) + (a1[j][h].z * a1[j][h].z + a1[j][h].w * a1[j][h].w); }
            }
            const float rs0 = rsqrtf(wave_sum(s0) * (1.f / DM) + EPS), rs1 = rsqrtf(wave_sum(s1) * (1.f / DM) + EPS);
#pragma unroll
            for (int j = 0; j < 2; ++j)
#pragma unroll
                for (int h = 0; h < 2; ++h) {
                    *(f32x4*)(args.out + (size_t)m0 * DM + 512 * j + 8 * lane + 4 * h) = a0[j][h] * rs0 * gg[j][h];
                    if (m1 != m0) *(f32x4*)(args.out + (size_t)m1 * DM + 512 * j + 8 * lane + 4 * h) = a1[j][h] * rs1 * gg[j][h];
                }
        }
    }
#undef IN
#undef SEAM
}

#ifndef N_LAUNCH_SPLIT
#define N_LAUNCH_SPLIT 0
#endif
extern "C" void kernel_launch(void* const* d_in, const int* in_sizes, int n_in, void* d_out, int out_size, void* d_ws, size_t ws_size, hipStream_t stream) {
    static int grid = 0;
    if (grid == 0) {
        int dev = 0, cus = 0, per_cu = 0;
        if (n_in != 21 || ws_size < WS_END) { fprintf(stderr, "kernel_launch: unexpected inputs (n_in %d, ws %zu)\n", n_in, ws_size); grid = -1; return; }
        hipGetDevice(&dev); hipDeviceGetAttribute(&cus, hipDeviceAttributeMultiprocessorCount, dev);
        if (hipFuncSetAttribute((const void*)fwd_mega, hipFuncAttributeMaxDynamicSharedMemorySize, LDS_BYTES) != hipSuccess) { fprintf(stderr, "hipFuncSetAttribute failed\n"); grid = -1; return; }
        if (hipOccupancyMaxActiveBlocksPerMultiprocessor(&per_cu, (const void*)fwd_mega, 512, LDS_BYTES) != hipSuccess || per_cu < 1) { fprintf(stderr, "occupancy query: %d\n", per_cu); per_cu = 1; }
        (void)hipGetLastError();
        grid = cus * 1;
    }
    if (grid < 0) return;
    Args a{};
    for (int i = 0; i < 21; ++i) a.in[i] = (const float*)d_in[i];
    a.out = (float*)d_out; a.ws = (unsigned char*)d_ws;
#if N_LAUNCH_SPLIT
    for (int p = 0; p < 11; ++p) { a.ph_lo = p; a.ph_hi = p + 1; hipLaunchKernelGGL(fwd_mega, dim3(grid), dim3(512), LDS_BYTES, stream, a); }
#else
    a.ph_lo = 0; a.ph_hi = 11;
    if (hipMemsetAsync((char*)d_ws + WS_BAR, 0, XCD_BAR_WORDS * 4, stream) != hipSuccess) { fprintf(stderr, "memset of barrier words failed\n"); return; }
    void* kargs[] = {&a};
    hipError_t e = hipLaunchCooperativeKernel((const void*)fwd_mega, dim3(grid), dim3(512), kargs, LDS_BYTES, stream);
    if (e != hipSuccess) fprintf(stderr, "cooperative launch failed: %s (grid %d)\n", hipGetErrorString(e), grid);
#endif
}
```

```cpp
#include <hip/hip_runtime.h>
#include <hip/hip_cooperative_groups.h>
#include <cstdio>
#include <cstdint>
namespace cg = cooperative_groups;

#define LAS __attribute__((address_space(3)))
#define DI __device__ __forceinline__
typedef unsigned short bf16_t;
typedef short bf16x8 __attribute__((ext_vector_type(8)));
typedef short s16x4 __attribute__((ext_vector_type(4)));
typedef float f32x4 __attribute__((ext_vector_type(4)));
typedef float f32x16 __attribute__((ext_vector_type(16)));
typedef unsigned u32x4 __attribute__((ext_vector_type(4)));
typedef unsigned u32x2 __attribute__((ext_vector_type(2)));

constexpr int T = 16384, SEQ = 4096, DM = 1024, FF = 2816, DIN = 6960;
constexpr float EPS = 1e-6f, GN_EPS = 1e-5f;
constexpr float C2 = 0.125f * 1.4426950408889634f;

constexpr size_t MiB = 1u << 20, KiB = 1u << 10;
constexpr size_t WS_SS1 = 0, WS_SS2 = 64 * KiB, WS_SS3 = 128 * KiB, WS_CBIAS = 192 * KiB;
constexpr size_t WS_BAR = 208 * KiB;
constexpr size_t WS_COSN = 256 * KiB, WS_SINN = 384 * KiB, WS_COSR = 512 * KiB, WS_SINR = 1024 * KiB;
constexpr size_t WS_KC = 1536 * KiB, WS_VC = 1792 * KiB;
constexpr size_t WS_BPART = 2 * MiB + 128 * KiB;
constexpr size_t WS_W2K = 2 * MiB, WS_W2V = 2 * MiB + 32 * KiB, WS_W1K = 3 * MiB, WS_W1V = 4 * MiB;
constexpr size_t WS_WGU1 = 5 * MiB, WS_WD1 = 16 * MiB, WS_RP = 5 * MiB;
constexpr size_t WS_WIN = 22 * MiB, WS_WGM = 32 * MiB, WS_WN = 36 * MiB, WS_WR = 38 * MiB, WS_WO = 40 * MiB;
constexpr size_t WS_WGU2 = 42 * MiB, WS_WD2 = 53 * MiB;
constexpr size_t WS_XB = 59 * MiB;
constexpr size_t WS_QA = 91 * MiB, WS_KV = 123 * MiB, WS_QKR = 155 * MiB, WS_VR = 187 * MiB, WS_GR = 219 * MiB, WS_END = 251 * MiB;
constexpr size_t WS_ACT = WS_QA, WS_GATEA = WS_QKR, WS_GATER = WS_GR, WS_MIX = WS_KV;

constexpr int LDS_BYTES = 147456;

DI unsigned f2bf(float f) { unsigned u = __builtin_bit_cast(unsigned, f); return (u + 0x7fffu + ((u >> 16) & 1u)) >> 16; }
typedef float f32x2_t __attribute__((ext_vector_type(2))); typedef __bf16 bf16x2_t __attribute__((ext_vector_type(2)));
DI unsigned pk2(float lo, float hi) { f32x2_t v = {lo, hi}; bf16x2_t b = __builtin_convertvector(v, bf16x2_t); return __builtin_bit_cast(unsigned, b); }
DI float bf2f(unsigned short h) { return __builtin_bit_cast(float, (unsigned)h << 16); }
DI float bflo(unsigned w) { return __builtin_bit_cast(float, w << 16); }
DI float bfhi(unsigned w) { return __builtin_bit_cast(float, w & 0xffff0000u); }
DI int lane_id() { return (int)__builtin_amdgcn_mbcnt_hi(~0u, __builtin_amdgcn_mbcnt_lo(~0u, 0u)); }
DI int crow(int r, int hi) { return (r & 3) + 8 * (r >> 2) + 4 * hi; }
DI float wave_sum(float v) {
#pragma unroll
    for (int o = 1; o < 64; o <<= 1) v += __shfl_xor(v, o);
    return v;
}
DI float xhalf(float v) {
    unsigned w = __builtin_bit_cast(unsigned, v); asm volatile("" : "+v"(w));
    const auto rr = __builtin_amdgcn_permlane32_swap(__builtin_bit_cast(unsigned, v), w, false, false);
    return __builtin_bit_cast(float, (threadIdx.x & 32) ? rr[0] : rr[1]);
}
DI bf16x8 pack8(const f32x16& x, int s) {
    u32x4 p; p.x = pk2(x[8 * s], x[8 * s + 1]); p.y = pk2(x[8 * s + 2], x[8 * s + 3]); p.z = pk2(x[8 * s + 4], x[8 * s + 5]); p.w = pk2(x[8 * s + 6], x[8 * s + 7]);
    return __builtin_bit_cast(bf16x8, p);
}
#define MFMA32(a, b, c) __builtin_amdgcn_mfma_f32_32x32x16_bf16((a), (b), (c), 0, 0, 0)
typedef short v4i16_t __attribute__((ext_vector_type(4)));
DI s16x4 vtr(const LAS char* p) { return __builtin_bit_cast(s16x4, __builtin_amdgcn_ds_read_tr16_b64_v4i16((LAS v4i16_t*)p)); }
DI bf16x8 cat8(s16x4 lo, s16x4 hi) { return (bf16x8){lo[0], lo[1], lo[2], lo[3], hi[0], hi[1], hi[2], hi[3]}; }
DI float sigmoidf_(float x) { return __builtin_amdgcn_rcpf(1.f + __expf(-x)); }
DI float xsum(float v) { return v + xhalf(v); }
DI float xmax(float v) { return fmaxf(v, xhalf(v)); }
DI int ldim(int p) { return p < 8 ? p : (p < 32 ? p + 8 : (p < 40 ? p - 24 : p)); }

namespace pg8 {
constexpr int BM = 256, BK = 64, HALF = 128, HTB = HALF * BK * 2, STAGE_BYTES = 8 * HTB, NXCD = 8, WGM = 8;
__host__ __device__ __forceinline__ int lds_byte(int r, int c) { const int st = (r >> 4) * 2 + (c >> 5), rr = r & 15, cc = c & 31, ob = rr * 64 + cc * 2; return st * 1024 + (ob ^ (((ob >> 9) & 1) << 5)); }
__host__ __device__ __forceinline__ void stage_rc(int b, int& R, int& C) { const int st = b / 1024, sb = b % 1024, swz = sb ^ (((sb >> 9) & 1) << 5); R = (st >> 1) * 16 + swz / 64; C = (st & 1) * 32 + (swz % 64) / 2; }
__host__ __device__ __forceinline__ int perm32(int rho) { const int n = rho >> 4, i = rho & 15; return 8 * (i >> 2) + 4 * n + (i & 3); }
struct Unit { int pm, pn, sel; };
struct Gemm { const bf16_t* A; const bf16_t* Bt; int lda, K; const bf16_t* A2; const bf16_t* Bt2; };
struct StaticOrder {
    int nM, nN, nwg, G, c;
    DI void init(int M, int N, int G_, int c_) { nM = M / BM; nN = N / BM; nwg = nM * nN; G = G_; c = c_; }
    DI bool map(long L, Unit& u) const {
        if (L >= nwg) return false;
        int wgid = (int)L; { const int q = nwg / NXCD, r = nwg % NXCD, xcd = wgid % NXCD, off = wgid / NXCD; wgid = (xcd < r ? xcd * (q + 1) : r * (q + 1) + (xcd - r) * q) + off; }
        const int nig = WGM * nN, gid = wgid / nig, fm = gid * WGM, gsz = (nM - fm) < WGM ? (nM - fm) : WGM;
        u.pm = fm + ((wgid % nig) % gsz); u.pn = (wgid % nig) / gsz; u.sel = 0; return true;
    }
    DI bool next(int i, Unit& u) const { return map((long)i * G + c, u); }
};
struct GateOrder {
    StaticOrder S;
    DI bool next(int i, Unit& u) const { if (!S.map((long)(i >> 1) * S.G + S.c, u)) return false; u.pn += 4 * (i & 1); return true; }
};

struct PairOrder {
    StaticOrder S;
    DI bool next(int i, Unit& u) const { if (!S.map((long)(i >> 1) * S.G + S.c, u)) return false; u.sel = i & 1; return true; }
};
template <class E> DI auto keep_acc(const E& e, const Unit& u, int) -> decltype(e.keep(u)) { return e.keep(u); }
template <class E> DI bool keep_acc(const E&, const Unit&, long) { return false; }
template <class Epi, class Sched>
__device__ __forceinline__ void gemm_phase(LAS unsigned char* lds, const Gemm g, const Sched& S, const Epi& E) {
    const int tid = threadIdx.x, wid = __builtin_amdgcn_readfirstlane(tid >> 6), lane = tid & 63, wr = wid >> 2, wc = wid & 3, fr = lane & 15, fq = lane >> 4;
    const int K = g.K, nt = K / BK, lda = g.lda;
    unsigned voffA[2], voffB[2];
#pragma unroll
    for (int i = 0; i < 2; ++i) { int R, C; stage_rc(tid * 16 + i * 8192, R, C); const int Rb = (R & ~31) + perm32(R & 31);
        voffA[i] = (unsigned)(R * lda + C) * 2u; voffB[i] = (unsigned)(Rb * K + C) * 2u; }
    const size_t kstep = (size_t)(BK * 2);
    const size_t hstepA = (size_t)HALF * lda * 2, hstepB = (size_t)HALF * K * 2;
    const size_t tstepA = 2 * hstepA, tstepB = 2 * hstepB;
    const unsigned ldsw = (unsigned)wid * 1024u;
    const int aoff = lds_byte(wr * 64 + fr, fq * 8), boff = lds_byte(wc * 32 + fr, fq * 8);
#define PG8_SA(b, h) (((b) * 2 + (h)) * HTB)
#define PG8_SB(b, h) ((4 + (b) * 2 + (h)) * HTB)
#define PG8_STAGE(bufoff, gbase, voff) do { _Pragma("unroll") for (int _i = 0; _i < 2; ++_i) \
        __builtin_amdgcn_global_load_lds((const unsigned*)((const char*)(gbase) + (voff)[_i]), (LAS unsigned*)(lds + (bufoff) + ldsw + _i * 8192), 16, 0, 0); } while (0)
#define PG8_LDA(dst, b, h) do { _Pragma("unroll") for (int m = 0; m < 4; ++m) _Pragma("unroll") for (int k = 0; k < 2; ++k) dst[m][k] = *(const LAS bf16x8*)(lds + PG8_SA(b, h) + aoff + m * 2048 + k * 1024); } while (0)
#define PG8_LDB(dst, b, h) do { _Pragma("unroll") for (int n = 0; n < 2; ++n) _Pragma("unroll") for (int k = 0; k < 2; ++k) dst[n][k] = *(const LAS bf16x8*)(lds + PG8_SB(b, h) + boff + n * 2048 + k * 1024); } while (0)
#define PG8_MMA(ai, bj, At, Bt) do { __builtin_amdgcn_s_setprio(1); _Pragma("unroll") for (int m = 0; m < 4; ++m) _Pragma("unroll") for (int n = 0; n < 2; ++n) _Pragma("unroll") for (int k = 0; k < 2; ++k) \
        acc[ai][bj][m][n] = __builtin_amdgcn_mfma_f32_16x16x32_bf16(Bt[n][k], At[m][k], acc[ai][bj][m][n], 0, 0, 0); __builtin_amdgcn_s_setprio(0); } while (0)
#define PG8_WAIT_V(n) asm volatile("s_waitcnt vmcnt(" #n ")" ::: "memory")
#define PG8_WAIT_L(n) asm volatile("s_waitcnt lgkmcnt(" #n ")" ::: "memory")
#define PG8_BAR __builtin_amdgcn_s_barrier()
#define PG8_SCHED __builtin_amdgcn_sched_barrier(0)
    Unit cur, nxt; int ui = 0;
    if (!S.next(0, cur)) return;
    f32x4 acc[2][2][4][2];
#pragma unroll
    for (int a = 0; a < 2; ++a)
#pragma unroll
        for (int b = 0; b < 2; ++b)
#pragma unroll
            for (int m = 0; m < 4; ++m)
#pragma unroll
                for (int n = 0; n < 2; ++n) acc[a][b][m][n] = (f32x4){0.f, 0.f, 0.f, 0.f};
    bf16x8 At[4][2], B0[2][2], B1[2][2];
    const char* cA = (const char*)(cur.sel ? g.A2 : g.A) + (size_t)cur.pm * tstepA; const char* cB = (const char*)(cur.sel ? g.Bt2 : g.Bt) + (size_t)cur.pn * tstepB;
    PG8_STAGE(PG8_SB(0, 0), cB, voffB); PG8_STAGE(PG8_SB(0, 1), cB + hstepB, voffB); PG8_STAGE(PG8_SA(0, 0), cA, voffA); PG8_STAGE(PG8_SA(0, 1), cA + hstepA, voffA);
    if (wr == 1) PG8_BAR;
    PG8_WAIT_V(2); PG8_BAR;
    PG8_STAGE(PG8_SB(1, 0), cB + kstep, voffB); PG8_STAGE(PG8_SA(1, 0), cA + kstep, voffA); PG8_STAGE(PG8_SB(1, 1), cB + hstepB + kstep, voffB);
    PG8_WAIT_V(6); PG8_BAR;
    for (;;) {
        const bool has_next = S.next(ui + 1, nxt);
        const char* nA = has_next ? (const char*)(nxt.sel ? g.A2 : g.A) + (size_t)nxt.pm * tstepA : cA; const char* nB = has_next ? (const char*)(nxt.sel ? g.Bt2 : g.Bt) + (size_t)nxt.pn * tstepB : cB;
        for (int t = 0; t < nt; t += 2) {
            const bool last = (t == nt - 2);
            const char* a1 = cA + (size_t)(t + 1) * kstep;
            const char* a2 = last ? nA : cA + (size_t)(t + 2) * kstep; const char* b2 = last ? nB : cB + (size_t)(t + 2) * kstep;
            const char* a3 = a2 + kstep; const char* b3 = b2 + kstep;
            PG8_LDB(B0, 0, 0); PG8_LDB(B1, 0, 1); PG8_SCHED; PG8_LDA(At, 0, 0); PG8_STAGE(PG8_SA(1, 1), a1 + hstepA, voffA);
            PG8_WAIT_V(8); PG8_WAIT_L(0); PG8_BAR; PG8_MMA(0, 0, At, B0); PG8_MMA(0, 1, At, B1); PG8_BAR; PG8_SCHED;
            PG8_LDA(At, 0, 1); PG8_STAGE(PG8_SB(0, 0), b2, voffB); PG8_STAGE(PG8_SB(0, 1), b2 + hstepB, voffB); PG8_STAGE(PG8_SA(0, 0), a2, voffA);
            PG8_WAIT_V(8); PG8_WAIT_L(0); PG8_BAR; PG8_MMA(1, 0, At, B0); PG8_MMA(1, 1, At, B1); PG8_BAR; PG8_SCHED;
            PG8_LDB(B0, 1, 0); PG8_LDB(B1, 1, 1); PG8_SCHED; PG8_LDA(At, 1, 0); PG8_STAGE(PG8_SA(0, 1), a2 + hstepA, voffA);
            PG8_WAIT_V(8); PG8_WAIT_L(0); PG8_BAR; PG8_MMA(0, 0, At, B0); PG8_MMA(0, 1, At, B1); PG8_BAR; PG8_SCHED;
            PG8_LDA(At, 1, 1); PG8_STAGE(PG8_SB(1, 0), b3, voffB); PG8_STAGE(PG8_SB(1, 1), b3 + hstepB, voffB); PG8_STAGE(PG8_SA(1, 0), a3, voffA);
            PG8_WAIT_V(8); PG8_WAIT_L(0); PG8_BAR; PG8_MMA(1, 0, At, B0); PG8_MMA(1, 1, At, B1); PG8_BAR; PG8_SCHED;
        }
        if (wr == 0) PG8_BAR;
        E(acc, cur, wr, wc, fr, fq);
        if (!has_next) break;
        if (!keep_acc(E, cur, 0)) {
#pragma unroll
        for (int a = 0; a < 2; ++a)
#pragma unroll
            for (int b = 0; b < 2; ++b)
#pragma unroll
                for (int m = 0; m < 4; ++m)
#pragma unroll
                    for (int n = 0; n < 2; ++n) acc[a][b][m][n] = (f32x4){0.f, 0.f, 0.f, 0.f};
        }
        cur = nxt; cA = nA; cB = nB; ++ui;
        if (wr == 1) PG8_BAR;
    }
    PG8_WAIT_V(0);
    PG8_BAR;
#undef PG8_SA
#undef PG8_SB
#undef PG8_STAGE
#undef PG8_LDA
#undef PG8_LDB
#undef PG8_MMA
#undef PG8_WAIT_V
#undef PG8_WAIT_L
#undef PG8_BAR
#undef PG8_SCHED
}
typedef f32x4 Acc[2][2][4][2];
DI void st16(bf16_t* p, f32x4 a, f32x4 b) { u32x4 w; w.x = pk2(a[0], a[1]); w.y = pk2(a[2], a[3]); w.z = pk2(b[0], b[1]); w.w = pk2(b[2], b[3]); *(u32x4*)p = w; }

struct EpiSwiGLU {
    bf16_t* ACT; const float* ss;
    DI void operator()(const Acc& acc, const Unit& u, int wr, int wc, int fr, int fq) const {
        float ssv[8];
#pragma unroll
        for (int i = 0; i < 8; ++i) ssv[i] = ss[u.pm * BM + (i >> 2) * HALF + wr * 64 + (i & 3) * 16 + fr];
        __builtin_amdgcn_sched_barrier(0);
#pragma unroll
        for (int ai = 0; ai < 2; ++ai)
#pragma unroll
            for (int m = 0; m < 4; ++m) {
                const int row = u.pm * BM + ai * HALF + wr * 64 + m * 16 + fr;
                const float rs = rsqrtf(ssv[ai * 4 + m] * (1.f / DM) + EPS);
                f32x4 o[2];
#pragma unroll
                for (int n = 0; n < 2; ++n)
#pragma unroll
                    for (int j = 0; j < 4; ++j) { const float gv = acc[ai][0][m][n][j] * rs, uv = acc[ai][1][m][n][j] * rs; o[n][j] = gv * sigmoidf_(gv) * uv; }
                st16(ACT + (size_t)row * FF + u.pn * 128 + wc * 32 + fq * 8, o[0], o[1]);
            }
    }
};
template <bool IN16, bool OUT32, bool OUT16, bool SS> struct EpiResid {
    const float* xin32; const bf16_t* xin16; float* xout; bf16_t* xb; float* ss; float scale;
    DI void operator()(const Acc& acc, const Unit& u, int wr, int wc, int fr, int fq) const {
#pragma unroll
        for (int ai = 0; ai < 2; ++ai) {
            f32x4 xv[4][2][2]; u32x4 xw[4][2];
#pragma unroll
            for (int m = 0; m < 4; ++m)
#pragma unroll
                for (int bj = 0; bj < 2; ++bj) { const size_t off = (size_t)(u.pm * BM + ai * HALF + wr * 64 + m * 16 + fr) * DM + u.pn * BM + bj * HALF + wc * 32 + fq * 8;
                    if (IN16) xw[m][bj] = *(const u32x4*)(xin16 + off);
                    else { xv[m][bj][0] = *(const f32x4*)(xin32 + off); xv[m][bj][1] = *(const f32x4*)(xin32 + off + 4); } }
            __builtin_amdgcn_sched_barrier(0);
#pragma unroll
            for (int m = 0; m < 4; ++m) {
                const int row = u.pm * BM + ai * HALF + wr * 64 + m * 16 + fr;
                float sq = 0.f;
#pragma unroll
                for (int bj = 0; bj < 2; ++bj) {
                    const size_t off = (size_t)row * DM + u.pn * BM + bj * HALF + wc * 32 + fq * 8;
                    f32x4 x0, x1;
                    if (IN16) { const u32x4 w = xw[m][bj]; x0 = (f32x4){bflo(w.x), bfhi(w.x), bflo(w.y), bfhi(w.y)}; x1 = (f32x4){bflo(w.z), bfhi(w.z), bflo(w.w), bfhi(w.w)}; }
                    else { x0 = xv[m][bj][0]; x1 = xv[m][bj][1]; }
                    x0 = x0 + acc[ai][bj][m][0] * scale; x1 = x1 + acc[ai][bj][m][1] * scale;
                    if (OUT32) { *(f32x4*)(xout + off) = x0; *(f32x4*)(xout + off + 4) = x1; }
                    if (OUT16) st16(xb + off, x0, x1);
                    if (SS) sq += (x0[0] * x0[0] + x0[1] * x0[1]) + (x0[2] * x0[2] + x0[3] * x0[3]) + (x1[0] * x1[0] + x1[1] * x1[1]) + (x1[2] * x1[2] + x1[3] * x1[3]);
                }
                if (SS) { sq += __shfl_xor(sq, 16); sq += __shfl_xor(sq, 32); if (fq == 0) atomicAdd(ss + row, sq); }
            }
        }
    }
};
struct EpiProj {
    bf16_t *QA, *KV, *QKR, *VR, *GR; const float* ss; const float *cosN, *sinN, *cosR, *sinR;
    DI void operator()(const Acc& acc, const Unit& u, int wr, int wc, int fr, int fq) const {
        asm volatile("" : "+v"(fr));
        const int t = u.pn;
#pragma unroll
        for (int ai = 0; ai < 2; ++ai)
#pragma unroll
          for (int mp = 0; mp < 2; ++mp) {
            float ssv[8];
            ssv[ai * 4 + 2 * mp] = ss[u.pm * BM + ai * HALF + wr * 64 + (2 * mp) * 16 + fr]; ssv[ai * 4 + 2 * mp + 1] = ss[u.pm * BM + ai * HALF + wr * 64 + (2 * mp + 1) * 16 + fr];
            f32x4 csv[2][2], snv[2][2];
            if (t <= 4) { if (fq == 0) {
#pragma unroll
                for (int r2 = 0; r2 < 2; ++r2)
#pragma unroll
                    for (int n = 0; n < 2; ++n) { const int pos2 = (u.pm * BM + ai * HALF + wr * 64 + (2 * mp + r2) * 16 + fr) & (SEQ - 1); csv[r2][n] = *(const f32x4*)(cosN + pos2 * 8 + 4 * n); snv[r2][n] = *(const f32x4*)(sinN + pos2 * 8 + 4 * n); } }
            } else if (t >= 7 && t < 11) {
#pragma unroll
                for (int r2 = 0; r2 < 2; ++r2)
#pragma unroll
                    for (int n = 0; n < 2; ++n) { const int pos2 = (u.pm * BM + ai * HALF + wr * 64 + (2 * mp + r2) * 16 + fr) & (SEQ - 1); csv[r2][n] = *(const f32x4*)(cosR + pos2 * 32 + 8 * fq + 4 * n); snv[r2][n] = *(const f32x4*)(sinR + pos2 * 32 + 8 * fq + 4 * n); }
            }
            __builtin_amdgcn_sched_barrier(0);
#pragma unroll
            for (int r2 = 0; r2 < 2; ++r2) {
                const int m = 2 * mp + r2;
                const int row = u.pm * BM + ai * HALF + wr * 64 + m * 16 + fr;
                const float rs = rsqrtf(ssv[ai * 4 + m] * (1.f / DM) + EPS);
                const int pos = row & (SEQ - 1);
                f32x4 v[2][2];
#pragma unroll
                for (int bj = 0; bj < 2; ++bj)
#pragma unroll
                    for (int n = 0; n < 2; ++n) v[bj][n] = acc[ai][bj][m][n] * rs;
                bf16_t* dst; int c0, c1;
                if (t <= 4) {
                    if (fq == 0) {
#pragma unroll
                        for (int n = 0; n < 2; ++n) { const f32x4 cs = csv[r2][n], sn = snv[r2][n];
                            const f32x4 lo = v[0][n], hi = v[1][n]; v[0][n] = lo * cs - hi * sn; v[1][n] = hi * cs + lo * sn; }
                    }
                    if (t < 4) {
#pragma unroll
                        for (int bj = 0; bj < 2; ++bj)
#pragma unroll
                            for (int n = 0; n < 2; ++n) v[bj][n] = v[bj][n] * C2;
                        dst = QA; c0 = 256 * t + 64 * wc + 8 * fq; c1 = c0 + 32;
                    } else { dst = KV; c0 = 64 * wc + 8 * fq; c1 = c0 + 32; }
                } else if (t >= 7 && t < 11) {
                    const bool isq = t < 9; const int head = 4 * ((t - 7) & 1) + wc; const int c = pos & 127;
                    const float lg = __log2f(1.f - exp2f(-5.f - (float)head));
                    const float f = isq ? 0.125f * exp2f((float)c * lg) : exp2f(-(float)c * lg);
#pragma unroll
                    for (int n = 0; n < 2; ++n) { const f32x4 cs = csv[r2][n], sn = snv[r2][n];
                        const f32x4 lo = v[0][n], hi = v[1][n]; v[0][n] = (lo * cs - hi * sn) * f; v[1][n] = (hi * cs + lo * sn) * f; }
                    dst = QKR; c0 = (isq ? 0 : 512) + 256 * ((t - 7) & 1) + 64 * wc + 8 * fq; c1 = c0 + 32;
                } else {
                    const int cc = 32 * wc + 8 * fq;
                    if (t == 5 || t == 6) { dst = KV; c0 = 256 * (t - 4) + cc; }
                    else if (t < 15) { dst = VR; c0 = 256 * (t - 11) + cc; }
                    else if (t < 19) { dst = GR; c0 = 256 * (t - 15) + cc;
#pragma unroll
                        for (int bj = 0; bj < 2; ++bj)
#pragma unroll
                            for (int n = 0; n < 2; ++n)
#pragma unroll
                                for (int j = 0; j < 4; ++j) { const float x = v[bj][n][j]; v[bj][n][j] = x * sigmoidf_(x); }
                    } else { dst = KV; c0 = 768 + cc;
#pragma unroll
                        for (int bj = 0; bj < 2; ++bj)
#pragma unroll
                            for (int n = 0; n < 2; ++n)
#pragma unroll
                                for (int j = 0; j < 4; ++j) v[bj][n][j] = sigmoidf_(v[bj][n][j]);
                    }
                    c1 = c0 + 128;
                }
                st16(dst + (size_t)row * DM + c0, v[0][0], v[0][1]);
                st16(dst + (size_t)row * DM + c1, v[1][0], v[1][1]);
            }
          }
    }
};
struct EpiGate {
    bf16_t *GA_, *GR_; const float* ss;
    DI void operator()(const Acc& acc, const Unit& u, int wr, int wc, int fr, int fq) const {
        bf16_t* dst = u.pn < 4 ? GA_ : GR_; const int ct = (u.pn & 3) * BM;
        float ssv[8];
#pragma unroll
        for (int i = 0; i < 8; ++i) ssv[i] = ss[u.pm * BM + (i >> 2) * HALF + wr * 64 + (i & 3) * 16 + fr];
        __builtin_amdgcn_sched_barrier(0);
#pragma unroll
        for (int ai = 0; ai < 2; ++ai)
#pragma unroll
            for (int m = 0; m < 4; ++m) {
                const int row = u.pm * BM + ai * HALF + wr * 64 + m * 16 + fr;
                const float rs = rsqrtf(ssv[ai * 4 + m] * (1.f / DM) + EPS);
#pragma unroll
                for (int bj = 0; bj < 2; ++bj) { f32x4 o[2];
#pragma unroll
                    for (int n = 0; n < 2; ++n)
#pragma unroll
                        for (int j = 0; j < 4; ++j) o[n][j] = sigmoidf_(acc[ai][bj][m][n][j] * rs);
                    st16(dst + (size_t)row * DM + ct + bj * HALF + wc * 32 + fq * 8, o[0], o[1]); }
            }
    }
};
template <bool ADD> struct EpiMix {
    const bf16_t* G_; bf16_t* MIX;
    DI void operator()(const Acc& acc, const Unit& u, int wr, int wc, int fr, int fq) const {
#pragma unroll
        for (int ai = 0; ai < 2; ++ai) {
            u32x4 gv[4][2], pv[4][2];
#pragma unroll
            for (int m = 0; m < 4; ++m)
#pragma unroll
                for (int bj = 0; bj < 2; ++bj) { const size_t off = (size_t)(u.pm * BM + ai * HALF + wr * 64 + m * 16 + fr) * DM + u.pn * BM + bj * HALF + wc * 32 + fq * 8;
                    gv[m][bj] = *(const u32x4*)(G_ + off); pv[m][bj] = (u32x4){0u, 0u, 0u, 0u}; if (ADD) pv[m][bj] = *(const u32x4*)(MIX + off); }
            __builtin_amdgcn_sched_barrier(0);
#pragma unroll
            for (int m = 0; m < 4; ++m) {
                const int row = u.pm * BM + ai * HALF + wr * 64 + m * 16 + fr;
#pragma unroll
                for (int bj = 0; bj < 2; ++bj) {
                    const size_t off = (size_t)row * DM + u.pn * BM + bj * HALF + wc * 32 + fq * 8;
                    const u32x4 gw = gv[m][bj];
                    const u32x4 pw = pv[m][bj];
                    f32x4 o0, o1;
                    o0[0] = bflo(gw.x) * acc[ai][bj][m][0][0]; o0[1] = bfhi(gw.x) * acc[ai][bj][m][0][1]; o0[2] = bflo(gw.y) * acc[ai][bj][m][0][2]; o0[3] = bfhi(gw.y) * acc[ai][bj][m][0][3];
                    o1[0] = bflo(gw.z) * acc[ai][bj][m][1][0]; o1[1] = bfhi(gw.z) * acc[ai][bj][m][1][1]; o1[2] = bflo(gw.w) * acc[ai][bj][m][1][2]; o1[3] = bfhi(gw.w) * acc[ai][bj][m][1][3];
                    if (ADD) { o0[0] += bflo(pw.x); o0[1] += bfhi(pw.x); o0[2] += bflo(pw.y); o0[3] += bfhi(pw.y); o1[0] += bflo(pw.z); o1[1] += bfhi(pw.z); o1[2] += bflo(pw.w); o1[3] += bfhi(pw.w); }
                    st16(MIX + off, o0, o1);
                }
            }
        }
    }
};
struct EpiMixFused {
    const bf16_t *GA_, *GR_; bf16_t* MIX;
    DI bool keep(const Unit& u) const { return u.sel == 0; }
    DI void operator()(Acc& acc, const Unit& u, int wr, int wc, int fr, int fq) const {
#pragma unroll
        for (int ai = 0; ai < 2; ++ai)
#pragma unroll
          for (int mp = 0; mp < 2; ++mp) {
            u32x4 gv[2][2], hv[2][2];
#pragma unroll
            for (int r2 = 0; r2 < 2; ++r2)
#pragma unroll
                for (int bj = 0; bj < 2; ++bj) { const size_t off = (size_t)(u.pm * BM + ai * HALF + wr * 64 + (2 * mp + r2) * 16 + fr) * DM + u.pn * BM + bj * HALF + wc * 32 + fq * 8;
                    hv[r2][bj] = *(const u32x4*)(GR_ + off); if (u.sel == 0) gv[r2][bj] = *(const u32x4*)(GA_ + off); }
            __builtin_amdgcn_sched_barrier(0);
#pragma unroll
            for (int r2 = 0; r2 < 2; ++r2)
#pragma unroll
                for (int bj = 0; bj < 2; ++bj) {
                    const int m = 2 * mp + r2;
                    const u32x4 h = hv[r2][bj];
                    f32x4 r0 = (f32x4){bflo(h.x), bfhi(h.x), bflo(h.y), bfhi(h.y)}, r1 = (f32x4){bflo(h.z), bfhi(h.z), bflo(h.w), bfhi(h.w)};
#pragma unroll
                    for (int j = 0; j < 4; ++j) { r0[j] = fmaxf(r0[j], 1e-30f); r1[j] = fmaxf(r1[j], 1e-30f); }
                    if (u.sel == 0) {
                        const u32x4 g = gv[r2][bj];
                        const f32x4 a0 = (f32x4){bflo(g.x), bfhi(g.x), bflo(g.y), bfhi(g.y)}, a1 = (f32x4){bflo(g.z), bfhi(g.z), bflo(g.w), bfhi(g.w)};
#pragma unroll
                        for (int j = 0; j < 4; ++j) { acc[ai][bj][m][0][j] *= a0[j] * __builtin_amdgcn_rcpf(r0[j]); acc[ai][bj][m][1][j] *= a1[j] * __builtin_amdgcn_rcpf(r1[j]); }
                    } else {
                        const size_t off = (size_t)(u.pm * BM + ai * HALF + wr * 64 + m * 16 + fr) * DM + u.pn * BM + bj * HALF + wc * 32 + fq * 8;
                        st16(MIX + off, acc[ai][bj][m][0] * r0, acc[ai][bj][m][1] * r1);
                    }
                }
          }
    }
};
}

struct Args { const float* in[21]; float* out; unsigned char* ws; int ph_lo, ph_hi; };

DI void tr_item(const float* W, int ldw, int K, bf16_t* WT, int drow0, int scol4, const float* ksc, int k0, LAS float* scr, int lane) {
    const int kq = lane >> 4, n4 = 4 * (lane & 15);
    f32x4 v[16];
#pragma unroll
    for (int i = 0; i < 16; ++i) v[i] = scol4 >= 0 ? __builtin_nontemporal_load((const f32x4*)(W + (size_t)(k0 + 4 * i + kq) * ldw + scol4)) : (f32x4){0.f, 0.f, 0.f, 0.f};
#pragma unroll
    for (int i = 0; i < 16; ++i) { LAS float* d = scr + (4 * i + kq) * 65 + n4; d[0] = v[i].x; d[1] = v[i].y; d[2] = v[i].z; d[3] = v[i].w; }
    asm volatile("s_waitcnt lgkmcnt(0)" ::: "memory");
    const int c = lane & 7, nl = lane >> 3;
    f32x4 s0 = (f32x4){1.f, 1.f, 1.f, 1.f}, s1 = s0;
    if (ksc) { s0 = *(const f32x4*)(ksc + k0 + 8 * c); s1 = *(const f32x4*)(ksc + k0 + 8 * c + 4); }
#pragma unroll
    for (int j = 0; j < 8; ++j) { const int n = nl + 8 * j; const LAS float* p = scr + (8 * c) * 65 + n;
        u32x4 o; o.x = pk2(p[0 * 65] * s0.x, p[1 * 65] * s0.y); o.y = pk2(p[2 * 65] * s0.z, p[3 * 65] * s0.w); o.z = pk2(p[4 * 65] * s1.x, p[5 * 65] * s1.y); o.w = pk2(p[6 * 65] * s1.z, p[7 * 65] * s1.w);
        *(u32x4*)(WT + (size_t)(drow0 + n) * K + k0 + 8 * c) = o; }
    asm volatile("s_waitcnt lgkmcnt(0)" ::: "memory");
}
DI int win_src(int nrow) {
    const int t = nrow >> 8, rr = nrow & 255, bj = rr >> 7, wc = (rr >> 5) & 3, c = rr & 31;
    if (t < 4) return (4 * t + wc) * 64 + ldim(32 * bj + c);
    if (t == 4) return (wc < 2 ? 1280 + wc * 64 : 1536 + (wc - 2) * 64) + ldim(32 * bj + c);
    if (t == 5) return rr < 128 ? 1024 + rr : 1152 + rr - 128;
    if (t == 6) return rr < 128 ? 1408 + rr : 1664 + rr - 128;
    if (t < 9) return 1840 + (4 * (t - 7) + wc) * 64 + 32 * bj + c;
    if (t < 11) return 2352 + (4 * (t - 9) + wc) * 64 + 32 * bj + c;
    if (t < 15) return 2864 + (t - 11) * 256 + rr;
    if (t < 19) return 3888 + (t - 15) * 256 + rr;
    return rr < 48 ? 1792 + rr : -1;
}
template <int SET>
DI void prep_transposes(const Args& a, LAS unsigned char* lds, int gw, int NGW, int wave, int lane) {
    unsigned char* ws = a.ws;
    LAS float* scr = (LAS float*)(lds + wave * 18432);
    constexpr int I0 = (5632 / 64) * 16, I1 = (1024 / 64) * (2816 / 64), I2 = (5120 / 64) * 16, I3 = (2048 / 64) * 16, I4 = 16 * 16, I9 = 4 * 32, I11 = 4;
    constexpr int NIT = SET == 0 ? I0 + I1 + I2 + I3 + 2 * I9 + 2 * I11 : I0 + I1 + 3 * I4;
    constexpr int L = SET;
    const int l4 = 4 * (lane & 15);
    for (int it = gw; it < NIT; it += NGW) {
        int r = it;
        if (r < I0) { const int nb = r / 16, kb = r % 16, nrow = nb * 64 + l4; const int tile = nrow >> 8, rr = nrow & 255;
            tr_item(a.in[(rr >> 7) ? (L ? 18 : 3) : (L ? 17 : 2)], FF, DM, (bf16_t*)(ws + (L ? WS_WGU2 : WS_WGU1)), nb * 64, 128 * tile + (rr & 127), a.in[L ? 16 : 1], kb * 64, scr, lane); continue; } r -= I0;
        if (r < I1) { const int nb = r / 44, kb = r % 44;
            tr_item(a.in[L ? 19 : 4], DM, FF, (bf16_t*)(ws + (L ? WS_WD2 : WS_WD1)), nb * 64, nb * 64 + l4, nullptr, kb * 64, scr, lane); continue; } r -= I1;
        if (SET == 1) { const int w = r / I4; r -= w * I4; const int nb = r / 16, kb = r % 16;
            tr_item(a.in[13 + w], DM, DM, (bf16_t*)(ws + (w == 0 ? WS_WN : (w == 1 ? WS_WR : WS_WO))), nb * 64, nb * 64 + l4, nullptr, kb * 64, scr, lane); continue; }
        if (r < I2) { const int nb = r / 16, kb = r % 16; tr_item(a.in[6], DIN, DM, (bf16_t*)(ws + WS_WIN), nb * 64, win_src(nb * 64 + l4), a.in[5], kb * 64, scr, lane); continue; } r -= I2;
        if (r < I3) { const int nb = r / 16, kb = r % 16; tr_item(a.in[6], DIN, DM, (bf16_t*)(ws + WS_WGM), nb * 64, 4912 + nb * 64 + l4, a.in[5], kb * 64, scr, lane); continue; } r -= I3;
        if (r < 2 * I9) { const int w = r / I9; r -= w * I9; const int nb = r / 32, kb = r % 32;
            tr_item(a.in[w ? 10 : 8], 256, 2048, (bf16_t*)(ws + (w ? WS_W1V : WS_W1K)), nb * 64, nb * 64 + l4, nullptr, kb * 64, scr, lane); continue; } r -= 2 * I9;
        { const int w = r / I11; r -= w * I11; const int kb = r;
            tr_item(a.in[w ? 11 : 9], 64, 256, (bf16_t*)(ws + (w ? WS_W2V : WS_W2K)), 0, w ? l4 : ldim(l4), nullptr, kb * 64, scr, lane); }
    }
}
DI void phase_prep(const Args& a, LAS unsigned char* lds, int gw, int NGW, int wave, int lane) {
    unsigned char* ws = a.ws;
    prep_transposes<0>(a, lds, gw, NGW, wave, lane);
    const float* x = a.in[0]; bf16_t* xb = (bf16_t*)(ws + WS_XB); float* ss1 = (float*)(ws + WS_SS1);
    for (int m0 = gw; m0 < T; m0 += 2 * NGW) {
        const int m1 = m0 + NGW;
        const bool two = m1 < T;
        const f32x4* xr0 = (const f32x4*)(x + (size_t)m0 * DM) + lane; const f32x4* xr1 = (const f32x4*)(x + (size_t)(two ? m1 : m0) * DM) + lane;
        f32x4 v0[4], v1[4]; float s0 = 0.f, s1 = 0.f;
#pragma unroll
        for (int j = 0; j < 4; ++j) { v0[j] = __builtin_nontemporal_load(xr0 + 64 * j); v1[j] = __builtin_nontemporal_load(xr1 + 64 * j); }
#pragma unroll
        for (int j = 0; j < 4; ++j) { s0 += (v0[j].x * v0[j].x + v0[j].y * v0[j].y) + (v0[j].z * v0[j].z + v0[j].w * v0[j].w); s1 += (v1[j].x * v1[j].x + v1[j].y * v1[j].y) + (v1[j].z * v1[j].z + v1[j].w * v1[j].w); }
        s0 = wave_sum(s0); s1 = wave_sum(s1);
        u32x2* o0 = (u32x2*)(xb + (size_t)m0 * DM) + lane; u32x2* o1 = (u32x2*)(xb + (size_t)m1 * DM) + lane;
#pragma unroll
        for (int j = 0; j < 4; ++j) { o0[64 * j] = (u32x2){pk2(v0[j].x, v0[j].y), pk2(v0[j].z, v0[j].w)}; if (two) o1[64 * j] = (u32x2){pk2(v1[j].x, v1[j].y), pk2(v1[j].z, v1[j].w)}; }
        if (lane == 0) { ss1[m0] = s0; ((float*)(ws + WS_SS2))[m0] = 0.f; ((float*)(ws + WS_SS3))[m0] = 0.f;
            if (two) { ss1[m1] = s1; ((float*)(ws + WS_SS2))[m1] = 0.f; ((float*)(ws + WS_SS3))[m1] = 0.f; } }
    }
    const int gt = gw * 64 + lane, NGT = NGW * 64;
    for (int e = gt; e < SEQ * 8; e += NGT) { const int pos = e >> 3, i = e & 7; const float fr = powf(500000.0f, -(float)i * 2.0f / 16.0f); const float ang = (float)pos * fr;
        ((float*)(ws + WS_COSN))[e] = cosf(ang); ((float*)(ws + WS_SINN))[e] = sinf(ang); }
    for (int e = gt; e < SEQ * 32; e += NGT) { const int pos = e >> 5, i = e & 31; const float fr = powf(10000.0f, -(float)i * 2.0f / 64.0f); const float ang = (float)pos * fr;
        ((float*)(ws + WS_COSR))[e] = cosf(ang); ((float*)(ws + WS_SINR))[e] = sinf(ang); }
    for (int o = gw; o < 256; o += NGW) { const int w = o >> 7, jg = (o >> 5) & 3, kc = o & 31; const float* W1 = a.in[w ? 10 : 8]; const float* pe = a.in[7]; float s = 0.f;
#pragma unroll 16
        for (int k = 0; k < 64; ++k) s += pe[kc * 64 + k] * W1[(size_t)(kc * 64 + k) * 256 + jg * 64 + lane];
        ((float*)(ws + WS_BPART))[(w * 32 + kc) * 256 + jg * 64 + lane] = s; }
    for (int e = gt; e < 2 * 8 * 64; e += NGT) { const int w = e >> 9, bg = (e >> 6) & 7, d = e & 63; ((bf16_t*)(ws + (w ? WS_VC : WS_KC)))[(bg * 256 + 255) * 64 + d] = 0; }
}

DI float gelu_tanh(float x) { const float u = 0.7978845608028654f * (x + 0.044715f * x * x * x); const float e = __expf(2.f * u); const float th = 1.f - 2.f * __builtin_amdgcn_rcpf(e + 1.f); return 0.5f * x * (1.f + th); }
DI void compress_item(const Args& a, LAS unsigned char* lds, int item, int tid, int wave, int lane) {
    unsigned char* ws = a.ws; const int r32 = lane & 31, hi = lane >> 5;
    const int mt = item & 63, kv = item >> 6;
    const bf16_t* KV = (const bf16_t*)(ws + WS_KV);
    const bf16_t* W1T = (const bf16_t*)(ws + (kv ? WS_W1V : WS_W1K)); const bf16_t* W2T = (const bf16_t*)(ws + (kv ? WS_W2V : WS_W2K));
    int m = mt * 32 + r32; if (m > 2039) m = 2039;
    const int bg = m / 255, nc = m % 255, b = bg >> 1, g = bg & 1;
    __syncthreads();
#pragma unroll
    for (int i = 0; i < 16; ++i) {
        const int e = i * 512 + tid, seg = e >> 3, ch = e & 7, mrow = seg >> 5, l = seg & 31;
        int m3 = mt * 32 + mrow; if (m3 > 2039) m3 = 2039;
        const int bg3 = m3 / 255, nc3 = m3 % 255;
        const u32x4 v = *(const u32x4*)(KV + (size_t)((bg3 >> 1) * SEQ + nc3 * 16 + l) * DM + 256 + kv * 128 + (bg3 & 1) * 64 + 8 * ch);
        *(LAS u32x4*)(lds + mrow * 4112 + l * 128 + ch * 16) = v;
    }
    const bf16_t* wsrc = W1T + (size_t)(32 * wave + r32) * 2048 + 8 * hi;
    const LAS unsigned char* bsrc = lds + r32 * 4112 + 16 * hi;
    __syncthreads();
    f32x16 h = {};
#pragma unroll 1
    for (int s0 = 0; s0 < 128; s0 += 16) {
        bf16x8 af[16], bfr[16];
#pragma unroll
        for (int j = 0; j < 16; ++j) af[j] = *(const bf16x8*)(wsrc + 16 * (s0 + j));
#pragma unroll
        for (int j = 0; j < 16; ++j) bfr[j] = *(const LAS bf16x8*)(bsrc + 32 * (s0 + j));
        __builtin_amdgcn_sched_barrier(0);
#pragma unroll
        for (int j = 0; j < 16; ++j) h = MFMA32(af[j], bfr[j], h);
    }
    LAS float* red = (LAS float*)lds;
    LAS float* biasL = (LAS float*)(lds + 65536);
    __syncthreads();
    if (tid < 256) { const float* bp = (const float*)(ws + WS_BPART) + kv * 32 * 256 + tid; float b = 0.f;
#pragma unroll
        for (int c = 0; c < 32; ++c) b += bp[c * 256];
        biasL[tid] = b; }
    __syncthreads();
#pragma unroll
    for (int i = 0; i < 16; ++i) h[i] = gelu_tanh(h[i] + biasL[32 * wave + crow(i, hi)]);
#pragma unroll
    for (int dt = 0; dt < 2; ++dt) {
        f32x16 o = {};
#pragma unroll
        for (int ks = 0; ks < 2; ++ks) {
            const bf16_t* wp = W2T + (size_t)(32 * dt + r32) * 256 + 32 * wave + 16 * ks + 4 * hi;
            const s16x4 lo = *(const s16x4*)wp, hh = *(const s16x4*)(wp + 8);
            o = MFMA32(cat8(lo, hh), pack8(h, ks), o);
        }
#pragma unroll
        for (int i = 0; i < 16; ++i) red[(wave * 64 + 32 * dt + crow(i, hi)) * 32 + r32] = o[i];
    }
    __syncthreads();
    {
        const int mm = tid & 31, dq = tid >> 5; const int d0 = 4 * dq;
        float s[4] = {0.f, 0.f, 0.f, 0.f}, ps[4] = {0.f, 0.f, 0.f, 0.f};
        const bool rot = (kv == 0) && (dq < 2 || dq == 8 || dq == 9);
#pragma unroll
        for (int w = 0; w < 8; ++w)
#pragma unroll
            for (int j = 0; j < 4; ++j) { s[j] += red[(w * 64 + d0 + j) * 32 + mm]; ps[j] += red[(w * 64 + ((d0 + j) ^ 32)) * 32 + mm]; }
        const int m2 = mt * 32 + mm;
        if (m2 < 2040) {
            const int bg2 = m2 / 255, nc2 = m2 % 255;
            if (rot) { const int pos = 16 * nc2 + 31; const float* cs = (const float*)(ws + WS_COSN) + pos * 8; const float* sn = (const float*)(ws + WS_SINN) + pos * 8;
#pragma unroll
                for (int j = 0; j < 4; ++j) { const int i = (d0 + j) & 7; s[j] = (d0 < 8) ? s[j] * cs[i] - ps[j] * sn[i] : s[j] * cs[i] + ps[j] * sn[i]; } }
            bf16_t* dst = (bf16_t*)(ws + (kv ? WS_VC : WS_KC)) + (size_t)(bg2 * 256 + nc2) * 64 + d0;
            *(u32x2*)dst = (u32x2){pk2(s[0], s[1]), pk2(s[2], s[3])};
        }
    }
    __syncthreads();
}

DI void retstate_item(const Args& a, LAS unsigned char* lds, int item, int tid, int wave, int lane) {
    unsigned char* ws = a.ws; const int r32 = lane & 31, hi = lane >> 5;
    const int bh = item >> 2, dvs = item & 3, b = bh >> 3, h = bh & 7;
    const bf16_t* Kp = (const bf16_t*)(ws + WS_QKR) + (size_t)b * SEQ * DM + 512 + 64 * h;
    const bf16_t* Vp = (const bf16_t*)(ws + WS_VR) + (size_t)b * SEQ * DM + 128 * h + 32 * dvs;
    bf16_t* Rp = (bf16_t*)(ws + WS_RP) + (size_t)bh * 32 * 8192;
    const float lg = __log2f(1.f - exp2f(-5.f - (float)h));
    const float g127 = exp2f(127.f * lg), g128 = exp2f(128.f * lg);
    struct RS { u32x4 k0, k1, v; };
    auto gload = [&](RS& r, int n) __attribute__((always_inline)) {
        { const int e = tid, row = e >> 3, ch = e & 7; r.k0 = *(const u32x4*)(Kp + (size_t)(n * 128 + row) * DM + 8 * ch); }
        { const int e = tid + 512, row = e >> 3, ch = e & 7; r.k1 = *(const u32x4*)(Kp + (size_t)(n * 128 + row) * DM + 8 * ch); }
        { const int row = tid >> 2, ch = tid & 3; r.v = *(const u32x4*)(Vp + (size_t)(n * 128 + row) * DM + 8 * ch); }
    };
    auto lwrite = [&](const RS& r, int buf) __attribute__((always_inline)) {
        LAS unsigned char* kb = lds + buf * 24576; LAS unsigned char* vb = kb + 16384;
        { const int e = tid, row = e >> 3, ch = e & 7; *(LAS u32x4*)(kb + ((ch >> 2) * 8 + (row >> 4)) * 1024 + (row & 15) * 64 + (ch & 3) * 16) = r.k0; }
        { const int e = tid + 512, row = e >> 3, ch = e & 7; *(LAS u32x4*)(kb + ((ch >> 2) * 8 + (row >> 4)) * 1024 + (row & 15) * 64 + (ch & 3) * 16) = r.k1; }
        { const int row = tid >> 2, ch = tid & 3; *(LAS u32x4*)(vb + (row >> 4) * 1024 + (row & 15) * 64 + ch * 16) = r.v; }
    };
    f32x16 R = {};
    const int troff = ((lane >> 4) & 1) * 32 + (lane & 3) * 8 + (4 * hi + ((lane & 15) >> 2)) * 64;
    auto body = [&](RS& r, const int n) __attribute__((always_inline)) {
        const int buf = n & 1;
        lwrite(r, buf);
        if (n + 4 < 32) gload(r, n + 4);
        __syncthreads();
        if (wave < 2) {
            bf16_t* rp = Rp + (size_t)n * 8192 + (size_t)(32 * dvs + r32) * 64 + 32 * wave + 4 * hi;
#pragma unroll
            for (int q = 0; q < 4; ++q) *(u32x2*)(rp + 8 * q) = (u32x2){pk2(R[4 * q], R[4 * q + 1]), pk2(R[4 * q + 2], R[4 * q + 3])};
            const LAS char* kb = (const LAS char*)(lds + buf * 24576) + troff; const LAS char* vb = (const LAS char*)(lds + buf * 24576 + 16384) + troff;
            f32x16 kvn = {};
#pragma unroll
            for (int ks = 0; ks < 8; ++ks) {
                const bf16x8 af = cat8(vtr(kb + (wave * 8 + ks) * 1024), vtr(kb + (wave * 8 + ks) * 1024 + 512));
                const bf16x8 bfv = cat8(vtr(vb + ks * 1024), vtr(vb + ks * 1024 + 512));
                kvn = MFMA32(af, bfv, kvn);
            }
#pragma unroll
            for (int i = 0; i < 16; ++i) R[i] = g128 * R[i] + g127 * kvn[i];
        }
    };
    RS r0, r1, r2, r3;
    __syncthreads();
    gload(r0, 0); gload(r1, 1); gload(r2, 2); gload(r3, 3);
#pragma unroll 1
    for (int n = 0; n < 32; n += 4) { body(r0, n); body(r1, n + 1); body(r2, n + 2); body(r3, n + 3); }
    __syncthreads();
}

constexpr int AT_K = 0, AT_V = 16384, AT_IMP = 32768, AT_SLAB = 64 * 33, AT_SEL = 32768 + 8 * AT_SLAB * 4;
struct TileRegs { u32x4 k, v; };
DI void at_gload(TileRegs& r, const bf16_t* Kb, const bf16_t* Vb, int pitch, int kt, int wave, int lane) {
    r.k = *(const u32x4*)(Kb + (size_t)(kt * 64 + lane) * pitch + wave * 8);
    r.v = *(const u32x4*)(Vb + (size_t)(kt * 64 + 16 * (wave & 3) + (lane >> 2)) * pitch + (wave >> 2) * 32 + (lane & 3) * 8);
}
DI void at_lwrite(const TileRegs& r, LAS unsigned char* lds, int buf, int wave, int lane) {
    *(LAS u32x4*)(lds + AT_K + buf * 8192 + wave * 1024 + lane * 16) = r.k;
    *(LAS u32x4*)(lds + AT_V + buf * 8192 + wave * 1024 + lane * 16) = r.v;
}
DI void at_qk(f32x16& p0, f32x16& p1, const LAS unsigned char* kslot, const bf16x8* qr, const f32x16& cinit, int r32, int hi) {
    const LAS unsigned char* kb = kslot + hi * 1024 + r32 * 16;
#pragma unroll
    for (int d0 = 0; d0 < 4; ++d0) {
        const bf16x8 b0 = *(const LAS bf16x8*)(kb + d0 * 2048), b1 = *(const LAS bf16x8*)(kb + d0 * 2048 + 512);
        if (d0 == 0) { p0 = MFMA32(b0, qr[0], cinit); p1 = MFMA32(b1, qr[0], cinit); }
        else { p0 = MFMA32(b0, qr[d0], p0); p1 = MFMA32(b1, qr[d0], p1); }
    }
}
DI void at_pv(f32x16* o, const LAS unsigned char* vslot, const f32x16& p0, const f32x16& p1, int lane, int hi) {
    const LAS char* vp = (const LAS char*)vslot + ((lane >> 4) & 1) * 32 + (lane & 3) * 8 + (4 * hi + ((lane & 15) >> 2)) * 64;
    const bf16x8 pa[4] = {pack8(p0, 0), pack8(p0, 1), pack8(p1, 0), pack8(p1, 1)};
#pragma unroll
    for (int dt = 0; dt < 2; ++dt)
#pragma unroll
        for (int ks = 0; ks < 4; ++ks) {
            const bf16x8 vf = cat8(vtr(vp + dt * 4096 + ks * 1024), vtr(vp + dt * 4096 + ks * 1024 + 512));
            o[dt] = MFMA32(vf, pa[ks], o[dt]);
        }
}
DI void at_pv2(f32x16* o, const s16x4* vl, const s16x4* vh, const f32x16& p0, const f32x16& p1) {
    const bf16x8 pa[4] = {pack8(p0, 0), pack8(p0, 1), pack8(p1, 0), pack8(p1, 1)};
    __builtin_amdgcn_sched_barrier(0);
#pragma unroll
    for (int ks = 0; ks < 4; ++ks) { o[0] = MFMA32(cat8(vl[ks], vh[ks]), pa[ks], o[0]); o[1] = MFMA32(cat8(vl[4 + ks], vh[4 + ks]), pa[ks], o[1]); }
}
DI float max32(const f32x16& p0, const f32x16& p1) {
    float a = fmaxf(fmaxf(p0[0], p0[1]), p1[0]), b = fmaxf(fmaxf(p0[2], p0[3]), p1[1]); a = fmaxf(fmaxf(a, p1[2]), p1[3]);
#pragma unroll
    for (int i = 4; i < 16; i += 4) { a = fmaxf(fmaxf(a, p0[i]), p0[i + 1]); b = fmaxf(fmaxf(b, p0[i + 2]), p0[i + 3]); a = fmaxf(fmaxf(a, p1[i]), p1[i + 1]); b = fmaxf(fmaxf(b, p1[i + 2]), p1[i + 3]); }
    const float mx = fmaxf(a, b);
    return xmax(mx);
}
DI float sum32(const f32x16& p0, const f32x16& p1) {
    const f32x16 sv = p0 + p1;
    const float a = (sv[0] + sv[1]) + (sv[2] + sv[3]), b = (sv[4] + sv[5]) + (sv[6] + sv[7]), c = (sv[8] + sv[9]) + (sv[10] + sv[11]), d = (sv[12] + sv[13]) + (sv[14] + sv[15]);
    const float t = (a + b) + (c + d);
    return xsum(t);
}
#ifndef PEXP
#define PEXP 7
#endif
template <int MODE, int EXP = 0>
DI void at_loop(LAS unsigned char* lds, const bf16_t* Kb, const bf16_t* Vb, int pitch, int first, int last, const bf16x8* qr, f32x16* o, float& mrun, float& lrun,
                int t0, unsigned long long selm, int tid, int wave, int lane, TileRegs& trA) {
    const int r32 = lane & 31, hi = lane >> 5; const int t = t0 + r32;
    const float NINF = -__builtin_inff(); constexpr float THR = 8.f;
    __syncthreads();
    float cref = -mrun; if (MODE == 1) cref = lrun > 0.f ? -(mrun + __log2f(lrun)) : 0.f;
    float carry = 0.f;
    auto step = [&](const int kt, TileRegs& tr, const int buf) __attribute__((always_inline)) {
        if (EXP != 3) at_lwrite(tr, lds, buf, wave, lane);
        if (kt + 1 <= last) at_gload(tr, Kb, Vb, pitch, kt + 1, wave, lane);
        if (EXP != 3) __syncthreads();
        f32x16 p0, p1;
        {
            float c = cref; if (MODE == 2) { const bool sel = (selm >> kt) & 1ull; c = sel ? cref : NINF; }
            f32x16 ci;
#pragma unroll
            for (int i = 0; i < 16; ++i) ci[i] = c;
            const LAS unsigned char* kb = lds + AT_K + buf * 8192 + hi * 1024 + r32 * 16;
            bf16x8 kf[8];
#pragma unroll
            for (int d0 = 0; d0 < 4; ++d0) { kf[2 * d0] = *(const LAS bf16x8*)(kb + d0 * 2048); kf[2 * d0 + 1] = *(const LAS bf16x8*)(kb + d0 * 2048 + 512); }
            __builtin_amdgcn_sched_barrier(0);
            if (EXP == 4) { p0 = ci; p1 = ci; p0[0] += __builtin_bit_cast(float, (int)kf[0][0] + (int)kf[7][3]); } else {
            p0 = MFMA32(kf[0], qr[0], ci); p1 = MFMA32(kf[1], qr[0], ci);
#pragma unroll
            for (int d0 = 1; d0 < 4; ++d0) { p0 = MFMA32(kf[2 * d0], qr[d0], p0); p1 = MFMA32(kf[2 * d0 + 1], qr[d0], p1); } }
            __builtin_amdgcn_sched_barrier(0);
        }
        s16x4 vl[8], vh[8];
        if (MODE != 0 && EXP != 2) {
            const LAS char* vp = (const LAS char*)(lds + AT_V + buf * 8192) + ((lane >> 4) & 1) * 32 + (lane & 3) * 8 + (4 * hi + ((lane & 15) >> 2)) * 64;
#pragma unroll
            for (int i = 0; i < 8; ++i) { vl[i] = vtr(vp + (i >> 2) * 4096 + (i & 3) * 1024); vh[i] = vtr(vp + (i >> 2) * 4096 + (i & 3) * 1024 + 512); }
            __builtin_amdgcn_sched_barrier(0);
        }
        if (MODE <= 1) {
            if (16 * (64 * kt + 63) + 31 > t0) {
#pragma unroll
                for (int i = 0; i < 16; ++i) { const int n0 = 64 * kt + crow(i, hi); if (16 * n0 + 31 > t) p0[i] = NINF; if (16 * (n0 + 32) + 31 > t) p1[i] = NINF; }
            }
        } else if (MODE == 2) {
            if (kt == last) {
#pragma unroll
                for (int i = 0; i < 16; ++i) { const int k0 = 64 * kt + crow(i, hi); if (k0 > t) p0[i] = NINF; if (k0 + 32 > t) p1[i] = NINF; }
            }
        } else {
            if (kt == last || 64 * kt + 512 <= t0 + 31) {
#pragma unroll
                for (int i = 0; i < 16; ++i) { const int k0 = 64 * kt + crow(i, hi); if (k0 > t || t - k0 >= 512) p0[i] = NINF; if (k0 + 32 > t || t - k0 - 32 >= 512) p1[i] = NINF; }
            }
        }
        if (MODE == 1) {
#pragma unroll
            for (int i = 0; i < 16; ++i) { p0[i] = __builtin_amdgcn_exp2f(p0[i]); p1[i] = __builtin_amdgcn_exp2f(p1[i]); }
            LAS float* slab = (LAS float*)(lds + AT_IMP) + wave * AT_SLAB + r32;
            float av[2][4], rb[2][4];
#pragma unroll
            for (int hf = 0; hf < 2; ++hf)
#pragma unroll
                for (int gq = 0; gq < 4; ++gq) {
                    const f32x16& x = hf ? p1 : p0;
                    const float bb = 0.5f * x[4 * gq + 3]; av[hf][gq] = x[4 * gq] + x[4 * gq + 1] + x[4 * gq + 2] + bb; rb[hf][gq] = xhalf(bb);
                }
#pragma unroll
            for (int hf = 0; hf < 2; ++hf)
#pragma unroll
                for (int gq = 0; gq < 4; ++gq) {
                    const float prevrb = gq > 0 ? rb[hf][gq - 1] : (hf == 1 ? rb[0][3] : carry);
                    const int s = 16 * kt + 8 * hf + 2 * gq + hi;
                    slab[s * 33] = av[hf][gq] + (hi ? rb[hf][gq] : prevrb);
                }
            carry = rb[1][3];
            at_pv2(o, vl, vh, p0, p1);
        } else {
            const float tm = max32(p0, p1);
            const bool mv = (tm > THR) || (lrun == 0.f && tm > NINF);
            if (__any(mv)) {
                const float d = mv ? tm : 0.f;
                const float alpha = (lrun == 0.f) ? 1.f : __builtin_amdgcn_exp2f(-d);
                mrun += d; lrun *= alpha;
#pragma unroll
                for (int i = 0; i < 16; ++i) { p0[i] -= d; p1[i] -= d; }
                cref = -mrun;
                if (MODE != 0) {
#pragma unroll
                    for (int i = 0; i < 16; ++i) { o[0][i] *= alpha; o[1][i] *= alpha; }
                }
            }
            if (MODE == 0) {
#pragma unroll
                for (int i = 0; i < 16; ++i) { p0[i] = __builtin_amdgcn_exp2f(p0[i]); p1[i] = __builtin_amdgcn_exp2f(p1[i]); }
                lrun += sum32(p0, p1);
            } else {
                float ls[4];
#pragma unroll
                for (int ks = 0; ks < 4; ++ks) {
                    f32x16& x = (ks < 2) ? p0 : p1; const int r0 = 8 * (ks & 1);
#pragma unroll
                    for (int i = 0; i < 8; ++i) x[r0 + i] = __builtin_amdgcn_exp2f(x[r0 + i]);
                    ls[ks] = ((x[r0] + x[r0 + 1]) + (x[r0 + 2] + x[r0 + 3])) + ((x[r0 + 4] + x[r0 + 5]) + (x[r0 + 6] + x[r0 + 7]));
                    const bf16x8 pa = pack8(x, ks & 1);
                    o[0] = MFMA32(cat8(vl[ks], vh[ks]), pa, o[0]); o[1] = MFMA32(cat8(vl[4 + ks], vh[4 + ks]), pa, o[1]);
                }
                lrun += xsum((ls[0] + ls[1]) + (ls[2] + ls[3]));
            }
        }
    };
    for (int kt = first; kt <= last; kt += 2) {
        step(kt, trA, 0);
        if (kt + 1 <= last) step(kt + 1, trA, 1);
    }
}
template <bool ADD> DI void nsa_accum(bf16_t* aout, const f32x16* o, float f) {
    u32x2 wv[8];
    if (ADD) {
#pragma unroll
        for (int i = 0; i < 8; ++i) wv[i] = *(const u32x2*)(aout + 32 * (i >> 2) + 8 * (i & 3));
        __builtin_amdgcn_sched_barrier(0);
    }
#pragma unroll
    for (int dt = 0; dt < 2; ++dt)
#pragma unroll
        for (int q = 0; q < 4; ++q) {
            u32x2* p = (u32x2*)(aout + 32 * dt + 8 * q);
            float v0 = f * o[dt][4 * q], v1 = f * o[dt][4 * q + 1], v2 = f * o[dt][4 * q + 2], v3 = f * o[dt][4 * q + 3];
            if (ADD) { const u32x2 w = wv[dt * 4 + q]; v0 += bflo(w.x); v1 += bfhi(w.x); v2 += bflo(w.y); v3 += bfhi(w.y); }
            *p = (u32x2){pk2(v0, v1), pk2(v2, v3)};
        }
}
template <int EXP = 0> DI void nsa_item(const Args& a, LAS unsigned char* lds, int item, int tid, int wave, int lane, bool dry = false) {
    unsigned char* ws = a.ws; const int r32 = lane & 31, hi = lane >> 5;
    const int bg = item >> 7, qt = item & 127, b = bg >> 1, g = bg & 1; const int t0 = qt * 32, cur = t0 >> 6;
    bf16_t* QA = (bf16_t*)(ws + WS_QA); const bf16_t* KV = (const bf16_t*)(ws + WS_KV);
    const size_t tokrow = (size_t)(b * SEQ + t0 + r32) * DM; const int head = g * 8 + wave;
    bf16x8 qr[4];
#pragma unroll
    for (int d0 = 0; d0 < 4; ++d0) qr[d0] = *(const bf16x8*)(QA + tokrow + head * 64 + 16 * d0 + 8 * hi);
    float gate[3];
#pragma unroll
    for (int j = 0; j < 3; ++j) gate[j] = bf2f(KV[tokrow + 768 + head * 3 + j]);
    { LAS float* z = (LAS float*)(lds + AT_IMP) + wave * AT_SLAB;
#pragma unroll
      for (int i = 0; i < 33; ++i) z[lane + 64 * i] = 0.f; }
    f32x16 o[2];
    bf16_t* aout = QA + tokrow + head * 64 + 4 * hi;
    const bf16_t* KC = (const bf16_t*)(ws + WS_KC) + (size_t)bg * 256 * 64; const bf16_t* VC = (const bf16_t*)(ws + WS_VC) + (size_t)bg * 256 * 64;
    const int lastc = (t0 >> 4) >> 6;
    float mrun = 0.f, lrun = 0.f;
    TileRegs tr0;
    at_gload(tr0, KC, VC, 64, 0, wave, lane);
    if (EXP != 7) at_loop<0>(lds, KC, VC, 64, 0, lastc, qr, o, mrun, lrun, t0, 0ull, tid, wave, lane, tr0);
    o[0] = (f32x16){}; o[1] = (f32x16){};
    at_gload(tr0, KC, VC, 64, 0, wave, lane);
    if (EXP != 7 && EXP != 8) at_loop<1>(lds, KC, VC, 64, 0, lastc, qr, o, mrun, lrun, t0, 0ull, tid, wave, lane, tr0);
    const bf16_t* Ks = KV + (size_t)b * SEQ * DM + 64 * g; const bf16_t* Vs = KV + (size_t)b * SEQ * DM + 512 + 64 * g;
    at_gload(tr0, Ks, Vs, DM, 0, wave, lane);
    if (!(dry && a.ph_lo != 12345)) nsa_accum<false>(aout, o, gate[0]);
    __syncthreads();
    if (EXP >= 6) { if (lane == 0) { for (int qi = 0; qi < 4; ++qi) *(LAS unsigned long long*)(lds + AT_SEL + (4 * wave + qi) * 8) = ~0ull; } }
    else {
        const LAS float* imp = (const LAS float*)(lds + AT_IMP);
#pragma unroll 1
        for (int qi = 0; qi < 4; ++qi) {
            const int q = 4 * wave + qi; float v = 0.f;
#pragma unroll
            for (int w = 0; w < 8; ++w) v += imp[w * AT_SLAB + lane * 33 + q];
            const int s = lane;
            if (s == 0 || s == cur || s == cur - 1) v = 1.0e4f; else if (s > cur) v = -1.0e4f;
            typedef unsigned long long u64x2_t __attribute__((ext_vector_type(2)));
            const unsigned vb = __builtin_bit_cast(unsigned, v); const unsigned key = (vb >> 31) ? ~vb : (vb | 0x80000000u);
            const unsigned long long K = ((unsigned long long)key << 32) | (unsigned)(63 - lane);
            LAS unsigned long long* tk = (LAS unsigned long long*)(lds + AT_SEL + 256) + wave * 64;
            tk[lane] = K;
            u64x2_t rr[32];
#pragma unroll
            for (int j = 0; j < 32; ++j) rr[j] = *(const LAS u64x2_t*)(tk + 2 * j);
            int rank = 0;
#pragma unroll
            for (int j = 0; j < 32; ++j) { rank += (rr[j].x > K) ? 1 : 0; rank += (rr[j].y > K) ? 1 : 0; }
            const unsigned long long mk = __ballot(rank < 16 && s <= cur);
            if (lane == 0) *(LAS unsigned long long*)(lds + AT_SEL + q * 8) = mk;
        }
    }
    __syncthreads();
    const unsigned long long selm = *(const LAS unsigned long long*)(lds + AT_SEL + r32 * 8);
    const bf16_t* Kw = KV + (size_t)b * SEQ * DM + 128 + 64 * g; const bf16_t* Vw = KV + (size_t)b * SEQ * DM + 640 + 64 * g;
    const int firstw = t0 >= 511 ? (t0 - 511) >> 6 : 0;
    {
        mrun = 0.f; lrun = 0.f; o[0] = (f32x16){}; o[1] = (f32x16){};
        if (EXP < 5) at_loop<2, EXP>(lds, Ks, Vs, DM, 0, cur, qr, o, mrun, lrun, t0, selm, tid, wave, lane, tr0);
        const float f = gate[1] * (lrun > 0.f ? 1.f / lrun : 0.f);
        at_gload(tr0, Kw, Vw, DM, firstw, wave, lane);
        if (!(dry && a.ph_lo != 12345)) nsa_accum<true>(aout, o, f);
    }
    {
        mrun = 0.f; lrun = 0.f; o[0] = (f32x16){}; o[1] = (f32x16){};
        if (EXP < 5) at_loop<3, EXP>(lds, Kw, Vw, DM, firstw, cur, qr, o, mrun, lrun, t0, 0ull, tid, wave, lane, tr0);
        const float f = gate[2] * (lrun > 0.f ? 1.f / lrun : 0.f);
        if (!(dry && a.ph_lo != 12345)) nsa_accum<true>(aout, o, f);
    }
}

DI void retout_item(const Args& a, LAS unsigned char* lds, int item, int tid, int wave, int lane, bool dry = false) {
    unsigned char* ws = a.ws; const int r32 = lane & 31, hi = lane >> 5;
    const int half = wave >> 2, ww = wave & 3, tl = tid & 255;
    const int chunk = item * 2 + half;
    const int bh = chunk >> 5, n = chunk & 31, b = bh >> 3, h = bh & 7;
    const size_t row0 = (size_t)b * SEQ + n * 128;
    const bf16_t* QKR = (const bf16_t*)(ws + WS_QKR); bf16_t* VR = (bf16_t*)(ws + WS_VR); const bf16_t* GR = (const bf16_t*)(ws + WS_GR);
    const bf16_t* Rp = (const bf16_t*)(ws + WS_RP) + (size_t)chunk * 8192;
    LAS unsigned char* vimg = lds + half * 32768;
    __syncthreads();
    { u32x4 vv[8];
#pragma unroll
      for (int it = 0; it < 8; ++it) { const int e = it * 256 + tl, key = e >> 4, ch = e & 15; vv[it] = *(const u32x4*)(VR + (row0 + key) * DM + 128 * h + 8 * ch); }
      __builtin_amdgcn_sched_barrier(0);
#pragma unroll
      for (int it = 0; it < 8; ++it) { const int e = it * 256 + tl, key = e >> 4, ch = e & 15;
        *(LAS u32x4*)(vimg + ((ch >> 2) * 8 + (key >> 4)) * 1024 + (key & 15) * 64 + (ch & 3) * 16) = vv[it]; } }
    const float lg = __log2f(1.f - exp2f(-5.f - (float)h)); const float gam = exp2f(lg);
    bf16x8 qr[4];
    const bf16_t* qp = QKR + (row0 + 32 * ww + r32) * DM + 64 * h + 8 * hi;
#pragma unroll
    for (int d0 = 0; d0 < 4; ++d0) qr[d0] = *(const bf16x8*)(qp + 16 * d0);
    f32x16 o[4];
#pragma unroll
    for (int dh = 0; dh < 2; ++dh) { bf16x8 rf[8];
#pragma unroll
      for (int i = 0; i < 8; ++i) rf[i] = *(const bf16x8*)(Rp + (size_t)(32 * (2 * dh + (i >> 2)) + r32) * 64 + 8 * hi + 16 * (i & 3));
      __builtin_amdgcn_sched_barrier(0);
#pragma unroll
      for (int d2 = 0; d2 < 2; ++d2) { const int dt = 2 * dh + d2; o[dt] = (f32x16){};
#pragma unroll
        for (int d0 = 0; d0 < 4; ++d0) o[dt] = MFMA32(rf[d2 * 4 + d0], qr[d0], o[dt]);
#pragma unroll
        for (int i = 0; i < 16; ++i) o[dt][i] *= gam; } }
    __syncthreads();
    const LAS char* vp = (const LAS char*)vimg + ((lane >> 4) & 1) * 32 + (lane & 3) * 8 + (4 * hi + ((lane & 15) >> 2)) * 64;
    for (int jt = 0; jt <= ww; ++jt) {
        f32x16 p = {};
        const bf16_t* kp = QKR + (row0 + 32 * jt + r32) * DM + 512 + 64 * h + 8 * hi;
        bf16x8 kfr[4];
#pragma unroll
        for (int d0 = 0; d0 < 4; ++d0) kfr[d0] = *(const bf16x8*)(kp + 16 * d0);
        __builtin_amdgcn_sched_barrier(0);
#pragma unroll
        for (int d0 = 0; d0 < 4; ++d0) p = MFMA32(kfr[d0], qr[d0], p);
        if (jt == ww) {
#pragma unroll
            for (int i = 0; i < 16; ++i) if (crow(i, hi) > r32) p[i] = 0.f;
        }
        const bf16x8 pa0 = pack8(p, 0), pa1 = pack8(p, 1);
#pragma unroll
        for (int dt = 0; dt < 4; ++dt) {
            const LAS char* v0 = vp + (dt * 8 + 2 * jt) * 1024;
            o[dt] = MFMA32(cat8(vtr(v0), vtr(v0 + 512)), pa0, o[dt]);
            o[dt] = MFMA32(cat8(vtr(v0 + 1024), vtr(v0 + 1536)), pa1, o[dt]);
        }
    }
    float s = 0.f;
#pragma unroll
    for (int dt = 0; dt < 4; ++dt)
#pragma unroll
        for (int i = 0; i < 16; ++i) s += o[dt][i];
    s = xsum(s); const float mu = s * (1.f / 128.f); float q2 = 0.f;
#pragma unroll
    for (int dt = 0; dt < 4; ++dt)
#pragma unroll
        for (int i = 0; i < 16; ++i) { const float d = o[dt][i] - mu; q2 += d * d; }
    q2 = xsum(q2); const float rstd = rsqrtf(q2 * (1.f / 128.f) + GN_EPS);
    const float* gn = a.in[12] + 128 * h;
    const size_t orow = (row0 + 32 * ww + r32) * DM + 128 * h;
    __syncthreads();
    if (dry && a.ph_lo != 12345) return;
#pragma unroll
    for (int dh = 0; dh < 2; ++dh) {
        f32x4 ggv[8]; u32x2 gwv[8];
#pragma unroll
        for (int i = 0; i < 8; ++i) { const int dv = 32 * (2 * dh + (i >> 2)) + 8 * (i & 3) + 4 * hi; ggv[i] = *(const f32x4*)(gn + dv); gwv[i] = *(const u32x2*)(GR + orow + dv); }
        __builtin_amdgcn_sched_barrier(0);
#pragma unroll
        for (int d2 = 0; d2 < 2; ++d2)
#pragma unroll
            for (int q = 0; q < 4; ++q) {
                const int dt = 2 * dh + d2; const int dv = 32 * dt + 8 * q + 4 * hi;
                const f32x4 gg = ggv[d2 * 4 + q]; const u32x2 gw = gwv[d2 * 4 + q];
                const float r0 = (o[dt][4 * q] - mu) * rstd * gg[0] * bflo(gw.x), r1 = (o[dt][4 * q + 1] - mu) * rstd * gg[1] * bfhi(gw.x);
                const float r2 = (o[dt][4 * q + 2] - mu) * rstd * gg[2] * bflo(gw.y), r3 = (o[dt][4 * q + 3] - mu) * rstd * gg[3] * bfhi(gw.y);
                *(u32x2*)(VR + orow + dv) = (u32x2){pk2(r0, r1), pk2(r2, r3)};
            }
    }
}

#define XB_TMO      128
#define XB_XCNT(j)  (256  + 64 * (j))
#define XB_XSUB(j)  (1280 + 64 * (j))
#define XB_XGEN(j)  (2304 + 64 * (j))
#define XB_TOP      3328
#define XB_TOPGEN   3392
#define XCD_BAR_WORDS 3456
#define XB_SPIN_CAP (1u << 22)
DI unsigned xb_ld(unsigned* p)              { return __hip_atomic_load(p, __ATOMIC_RELAXED, __HIP_MEMORY_SCOPE_AGENT); }
DI unsigned xb_add(unsigned* p, unsigned v) { return __hip_atomic_fetch_add(p, v, __ATOMIC_RELAXED, __HIP_MEMORY_SCOPE_AGENT); }
DI unsigned xb_xcc_id() { return (unsigned)__builtin_amdgcn_s_getreg((3 << 11) | 20) & 0xFu; }
#define XB_SPIN(cond, bar) do { unsigned _sp = 0; while (cond) { __builtin_amdgcn_s_sleep(1); \
    if ((++_sp & 255u) == 0u) { if (xb_ld(&(bar)[XB_TMO])) break; if (_sp > XB_SPIN_CAP) { atomicAdd(&(bar)[XB_TMO], 1u); break; } } } } while (0)
struct XcdBarrier { unsigned* bar; unsigned x; volatile LAS unsigned* st; };
DI XcdBarrier xcd_barrier_post(unsigned* bar, volatile LAS unsigned* st) {
    XcdBarrier b; b.bar = bar; b.x = xb_xcc_id(); b.st = st;
    if (threadIdx.x == 0) (void)xb_add(&bar[XB_XCNT(b.x)], 1u);
    return b;
}
DI void xcd_barrier_complete(unsigned* bar, unsigned x, unsigned& nloc, unsigned& nx) {
    const unsigned G = gridDim.x * gridDim.y * gridDim.z;
    unsigned sum, cnt, mine, sp = 0u;
    for (;;) {
        sum = 0u; cnt = 0u; mine = 0u;
#pragma unroll
        for (unsigned j = 0; j < 16; ++j) { const unsigned c = xb_ld(&bar[XB_XCNT(j)]); sum += c; cnt += (c > 0u) ? 1u : 0u; mine = (j == x) ? c : mine; }
        if (sum == G) break;
        __builtin_amdgcn_s_sleep(1);
        if ((++sp & 255u) == 0u) { if (xb_ld(&bar[XB_TMO])) break; if (sp > XB_SPIN_CAP) { atomicAdd(&bar[XB_TMO], 1u); break; } }
    }
    nloc = mine > 0u ? mine : 1u; nx = cnt > 0u ? cnt : 1u;
}
DI void xcd_barrier(const XcdBarrier& b) {
    asm volatile("s_waitcnt vmcnt(0)" ::: "memory");
    __syncthreads();
    if (threadIdx.x == 0) {
        unsigned* bar = b.bar;
        __builtin_amdgcn_s_waitcnt(0);
        unsigned nloc = b.st[0], nx = b.st[1];
        if (nloc == 0u) { xcd_barrier_complete(bar, b.x, nloc, nx); b.st[0] = nloc; b.st[1] = nx; }
        const unsigned old = xb_add(&bar[XB_XSUB(b.x)], 1u);
        const unsigned gen = old / nloc;
        if (old + 1u == (gen + 1u) * nloc) {
            __builtin_amdgcn_fence(__ATOMIC_RELEASE, "agent");
            asm volatile("s_waitcnt vmcnt(0)" ::: "memory");
            const unsigned og = xb_add(&bar[XB_TOP], 1u);
            const unsigned tg = og / nx;
            if (og + 1u == (tg + 1u) * nx) xb_add(&bar[XB_TOPGEN], 1u);
            else XB_SPIN(xb_ld(&bar[XB_TOPGEN]) == tg, bar);
            __builtin_amdgcn_fence(__ATOMIC_ACQUIRE, "agent");
            xb_add(&bar[XB_XGEN(b.x)], 1u);
            asm volatile("s_waitcnt vmcnt(0)" ::: "memory");
        } else {
            XB_SPIN(xb_ld(&bar[XB_XGEN(b.x)]) == gen, bar);
            __builtin_amdgcn_fence(__ATOMIC_ACQUIRE, "agent");
            asm volatile("s_waitcnt vmcnt(0)" ::: "memory");
        }
    }
    __syncthreads();
}

__global__ void __launch_bounds__(512, 2) fwd_mega(Args args) {
    extern __shared__ __attribute__((aligned(16))) unsigned char lds_raw[];
    LAS unsigned char* lds = (LAS unsigned char*)lds_raw;
    cg::grid_group grid = cg::this_grid();
    const int tid = threadIdx.x, lane = tid & 63, wave = __builtin_amdgcn_readfirstlane(tid >> 6);
    const int G = gridDim.x, bx = blockIdx.x;
    const int gw = bx * 8 + wave, NGW = G * 8;
    unsigned char* ws = args.ws;
    const int lo = args.ph_lo, hi_ = args.ph_hi;
#define IN(k) (lo <= (k) && (k) < hi_)
    volatile LAS unsigned* bst = (volatile LAS unsigned*)(lds + LDS_BYTES - 64);
    if (tid < 16) bst[tid] = 0u;
    __syncthreads();
    XcdBarrier xbar = xcd_barrier_post((unsigned*)(ws + WS_BAR), bst);
    if (args.ph_lo == 12345) grid.sync();
#define SEAM(k) do { if (IN(k) && IN((k) + 1)) xcd_barrier(xbar); } while (0)
    float* ss1 = (float*)(ws + WS_SS1); float* ss2 = (float*)(ws + WS_SS2); float* ss3 = (float*)(ws + WS_SS3);
    bf16_t* XB = (bf16_t*)(ws + WS_XB); bf16_t* ACT = (bf16_t*)(ws + WS_ACT);

#ifndef PROBE
#define PROBE 0
#endif
    if (IN(0)) phase_prep(args, lds, gw, NGW, wave, lane);
    if (PROBE == 5) { xcd_barrier(xbar); phase_prep(args, lds, gw, NGW, wave, lane); }
    if (PROBE == 4) { for (int i = 0; i < 10; ++i) xcd_barrier(xbar); }
    SEAM(0);

    if (IN(1)) {
#pragma unroll 1
        for (int rep = 0; rep < (PROBE == 1 ? 2 : 1); ++rep) {
        pg8::Gemm g{XB, (const bf16_t*)(ws + WS_WGU1), DM, DM, nullptr, nullptr}; pg8::StaticOrder S; S.init(T, 2 * FF, G, bx);
        pg8::EpiSwiGLU E{ACT, ss1}; pg8::gemm_phase(lds, g, S, E);
        }
        { const int nfull = (22 * 64) % G;
          if (nfull > 0 && nfull < G) { if (bx >= nfull) prep_transposes<1>(args, lds, (bx - nfull) * 8 + wave, (G - nfull) * 8, wave, lane); }
          else prep_transposes<1>(args, lds, gw, NGW, wave, lane); }
    }
    SEAM(1);
    if (IN(2)) {
        pg8::Gemm g{ACT, (const bf16_t*)(ws + WS_WD1), FF, FF, nullptr, nullptr}; pg8::StaticOrder S; S.init(T, DM, G, bx);
        pg8::EpiResid<true, false, true, true> E{nullptr, XB, nullptr, XB, ss2, 0.5f}; pg8::gemm_phase(lds, g, S, E);
    }
    SEAM(2);
    if (IN(3)) {
        pg8::Gemm g{XB, (const bf16_t*)(ws + WS_WIN), DM, DM, nullptr, nullptr}; pg8::StaticOrder S; S.init(T, 5120, G, bx);
        pg8::EpiProj E{(bf16_t*)(ws + WS_QA), (bf16_t*)(ws + WS_KV), (bf16_t*)(ws + WS_QKR), (bf16_t*)(ws + WS_VR), (bf16_t*)(ws + WS_GR), ss2,
                       (const float*)(ws + WS_COSN), (const float*)(ws + WS_SINN), (const float*)(ws + WS_COSR), (const float*)(ws + WS_SINR)};
        pg8::gemm_phase(lds, g, S, E);
    }
    SEAM(3);
    if (IN(4)) {
        if (PROBE == 2) { for (int it = bx; it < 256; it += G) { if (it < 128) compress_item(args, lds, it, tid, wave, lane); else retstate_item(args, lds, it - 128, tid, wave, lane); } }
        for (int it = bx; it < 256; it += G) { if (it < 128) compress_item(args, lds, it, tid, wave, lane); else retstate_item(args, lds, it - 128, tid, wave, lane); }
    }
    SEAM(4);
    if (IN(5)) {
        for (int vc = bx; vc < 256; vc += G) {
            const int bg = vc >> 5, j = vc & 31;
            const int qts[4] = {127 - j, 64 + j, 63 - j, j};
            if (PROBE == 3) {
#pragma unroll 1
                for (int i = 0; i < 4; ++i) nsa_item<PEXP>(args, lds, bg * 128 + qts[i], tid, wave, lane, true);
            }
#pragma unroll 1
            for (int i = 0; i < 4; ++i) nsa_item(args, lds, bg * 128 + qts[i], tid, wave, lane);
            if (PROBE == 6) {
#pragma unroll 1
                for (int i = 0; i < 2; ++i) retout_item(args, lds, vc * 2 + i, tid, wave, lane, true);
            }
#pragma unroll 1
            for (int i = 0; i < 2; ++i) retout_item(args, lds, vc * 2 + i, tid, wave, lane);
        }
    }
    SEAM(5);
    if (IN(6)) {
        { pg8::Gemm g{XB, (const bf16_t*)(ws + WS_WGM), DM, DM, nullptr, nullptr}; pg8::GateOrder S; S.S.init(T, DM, G, bx);
          pg8::EpiGate E{(bf16_t*)(ws + WS_GATEA), (bf16_t*)(ws + WS_GATER), ss2}; pg8::gemm_phase(lds, g, S, E); }
        { pg8::Gemm g{(const bf16_t*)(ws + WS_QA), (const bf16_t*)(ws + WS_WN), DM, DM, (const bf16_t*)(ws + WS_VR), (const bf16_t*)(ws + WS_WR)};
          pg8::PairOrder S; S.S.init(T, DM, G, bx);
          pg8::EpiMixFused E{(const bf16_t*)(ws + WS_GATEA), (const bf16_t*)(ws + WS_GATER), (bf16_t*)(ws + WS_MIX)}; pg8::gemm_phase(lds, g, S, E); }
    }
    SEAM(6);
    if (IN(7)) {
        pg8::Gemm g{(const bf16_t*)(ws + WS_MIX), (const bf16_t*)(ws + WS_WO), DM, DM, nullptr, nullptr}; pg8::StaticOrder S; S.init(T, DM, G, bx);
        pg8::EpiResid<true, false, true, true> E{nullptr, XB, nullptr, XB, ss3, 1.0f}; pg8::gemm_phase(lds, g, S, E);
    }
    SEAM(7);
    if (IN(8)) {
        pg8::Gemm g{XB, (const bf16_t*)(ws + WS_WGU2), DM, DM, nullptr, nullptr}; pg8::StaticOrder S; S.init(T, 2 * FF, G, bx);
        pg8::EpiSwiGLU E{ACT, ss3}; pg8::gemm_phase(lds, g, S, E);
    }
    SEAM(8);
    if (IN(9)) {
        pg8::Gemm g{ACT, (const bf16_t*)(ws + WS_WD2), FF, FF, nullptr, nullptr}; pg8::StaticOrder S; S.init(T, DM, G, bx);
        pg8::EpiResid<true, false, true, false> E{nullptr, XB, nullptr, XB, nullptr, 0.5f}; pg8::gemm_phase(lds, g, S, E);
    }
    SEAM(9);
    if (IN(10)) {
        const float* gf = args.in[20];
        f32x4 gg[2][2];
#pragma unroll
        for (int j = 0; j < 2; ++j) { gg[j][0] = *(const f32x4*)(gf + 512 * j + 8 * lane); gg[j][1] = *(const f32x4*)(gf + 512 * j + 8 * lane + 4); }
        for (int m0 = gw; m0 < T; m0 += 2 * NGW) {
            const int m1 = (m0 + NGW < T) ? m0 + NGW : m0;
            u32x4 w0[2], w1[2];
#pragma unroll
            for (int j = 0; j < 2; ++j) { w0[j] = *(const u32x4*)(XB + (size_t)m0 * DM + 512 * j + 8 * lane); w1[j] = *(const u32x4*)(XB + (size_t)m1 * DM + 512 * j + 8 * lane); }
            f32x4 a0[2][2], a1[2][2]; float s0 = 0.f, s1 = 0.f;
#pragma unroll
            for (int j = 0; j < 2; ++j) {
                a0[j][0] = (f32x4){bflo(w0[j].x), bfhi(w0[j].x), bflo(w0[j].y), bfhi(w0[j].y)}; a0[j][1] = (f32x4){bflo(w0[j].z), bfhi(w0[j].z), bflo(w0[j].w), bfhi(w0[j].w)};
                a1[j][0] = (f32x4){bflo(w1[j].x), bfhi(w1[j].x), bflo(w1[j].y), bfhi(w1[j].y)}; a1[j][1] = (f32x4){bflo(w1[j].z), bfhi(w1[j].z), bflo(w1[j].w), bfhi(w1[j].w)};
#pragma unroll
                for (int h = 0; h < 2; ++h) { s0 += (a0[j][h].x * a0[j][h].x + a0[j][h].y * a0[j][h].y) + (a0[j][h].z * a0[j][h].z + a0[j][h].w * a0[j][h].w);
                                              s1 += (a1[j][h].x * a1[j][h].x + a1[j][h].y * a1[j][h].y) + (a1[j][h].z * a1[j][h].z + a1[j][h].w * a1[j][h].w); }
            }
            const float rs0 = rsqrtf(wave_sum(s0) * (1.f / DM) + EPS), rs1 = rsqrtf(wave_sum(s1) * (1.f / DM) + EPS);
#pragma unroll
            for (int j = 0; j < 2; ++j)
#pragma unroll
                for (int h = 0; h < 2; ++h) {
                    *(f32x4*)(args.out + (size_t)m0 * DM + 512 * j + 8 * lane + 4 * h) = a0[j][h] * rs0 * gg[j][h];
                    if (m1 != m0) *(f32x4*)(args.out + (size_t)m1 * DM + 512 * j + 8 * lane + 4 * h) = a1[j][h] * rs1 * gg[j][h];
                }
        }
    }
#undef IN
#undef SEAM
}

#ifndef N_LAUNCH_SPLIT
#define N_LAUNCH_SPLIT 0
#endif
extern "C" void kernel_launch(void* const* d_in, const int* in_sizes, int n_in, void* d_out, int out_size, void* d_ws, size_t ws_size, hipStream_t stream) {
    static int grid = 0;
    if (grid == 0) {
        int dev = 0, cus = 0, per_cu = 0;
        if (n_in != 21 || ws_size < WS_END) { fprintf(stderr, "kernel_launch: unexpected inputs (n_in %d, ws %zu)\n", n_in, ws_size); grid = -1; return; }
        hipGetDevice(&dev); hipDeviceGetAttribute(&cus, hipDeviceAttributeMultiprocessorCount, dev);
        if (hipFuncSetAttribute((const void*)fwd_mega, hipFuncAttributeMaxDynamicSharedMemorySize, LDS_BYTES) != hipSuccess) { fprintf(stderr, "hipFuncSetAttribute failed\n"); grid = -1; return; }
        if (hipOccupancyMaxActiveBlocksPerMultiprocessor(&per_cu, (const void*)fwd_mega, 512, LDS_BYTES) != hipSuccess || per_cu < 1) { fprintf(stderr, "occupancy query: %d\n", per_cu); per_cu = 1; }
        (void)hipGetLastError();
        grid = cus * 1;
    }
    if (grid < 0) return;
    Args a{};
    for (int i = 0; i < 21; ++i) a.in[i] = (const float*)d_in[i];
    a.out = (float*)d_out; a.ws = (unsigned char*)d_ws;
#if N_LAUNCH_SPLIT
    for (int p = 0; p < 11; ++p) { a.ph_lo = p; a.ph_hi = p + 1; hipLaunchKernelGGL(fwd_mega, dim3(grid), dim3(512), LDS_BYTES, stream, a); }
#else
    a.ph_lo = 0; a.ph_hi = 11;
    if (hipMemsetAsync((char*)d_ws + WS_BAR, 0, XCD_BAR_WORDS * 4, stream) != hipSuccess) { fprintf(stderr, "memset of barrier words failed\n"); return; }
    void* kargs[] = {&a};
    hipError_t e = hipLaunchCooperativeKernel((const void*)fwd_mega, dim3(grid), dim3(512), kargs, LDS_BYTES, stream);
    if (e != hipSuccess) fprintf(stderr, "cooperative launch failed: %s (grid %d)\n", hipGetErrorString(e), grid);
#endif
}
```
